# Optimizing an MI355X kernel written in HIP

```python
import jax, jax.numpy as jnp
from jax import lax
import numpy as np

D_MODEL = 1024
BATCH = 8
SEQ = 2048
DEPTH = 1
DEC_BATCH = 128
DEC_SEQ = 8
PAST_LEN = 16384
PAGE_SIZE = 128

D_MIX = D_MODEL
POOL_WIDTH = D_MIX // 4
POOL_WINDOWS = (2, 4, 8, 16)
POOL_GROUP = POOL_WIDTH // len(POOL_WINDOWS)
POOL_HIST = max(POOL_WINDOWS) - 1
HGRN_WIDTH = D_MIX // 2
HGRN_EXPAND = 128
HGRN_HEADS = HGRN_WIDTH // HGRN_EXPAND
HGRN_DK = HGRN_EXPAND
HGRN_DV = HGRN_WIDTH // HGRN_HEADS
HGRN_FDIM = HGRN_HEADS * HGRN_DK
HGRN_CHUNK = 64
XATTN_WIDTH = D_MIX - POOL_WIDTH - HGRN_WIDTH
XATTN_HEADS = 4
XATTN_DH = XATTN_WIDTH // XATTN_HEADS
N_MEM = 256
D_FF = 2816
CONV_W = 3
EPS = 1e-6
SPLITS = (POOL_WIDTH,
          POOL_WIDTH + HGRN_FDIM,
          POOL_WIDTH + 2 * HGRN_FDIM,
          POOL_WIDTH + 2 * HGRN_FDIM + HGRN_WIDTH,
          POOL_WIDTH + 2 * HGRN_FDIM + 2 * HGRN_WIDTH)
D_IN = POOL_WIDTH + 2 * HGRN_FDIM + 2 * HGRN_WIDTH + XATTN_WIDTH

kernel_name = "hymba_pool_hgrn2_memxattn_convffn_step"


def rmsnorm(x, g):
    xf = x.astype(jnp.float32)
    y = xf * lax.rsqrt(jnp.mean(xf * xf, axis=-1, keepdims=True) + EPS)
    return (y * g.astype(jnp.float32)).astype(x.dtype)


def pool_mixer(u, hist, pos0, pool_w, pool_scale):
    B, L, _ = u.shape
    xp = jnp.concatenate([hist.astype(jnp.float32), u.astype(jnp.float32)], axis=1)
    cs = jnp.concatenate([jnp.zeros((B, 1, POOL_WIDTH), jnp.float32), jnp.cumsum(xp, axis=1)], axis=1)
    pos = (pos0 + jnp.arange(L)).astype(jnp.float32)
    uf = u.astype(jnp.float32)
    outs = []
    for gi, w in enumerate(POOL_WINDOWS):
        sl = slice(gi * POOL_GROUP, (gi + 1) * POOL_GROUP)
        total = cs[:, POOL_HIST + 1:POOL_HIST + 1 + L, sl] - cs[:, POOL_HIST + 1 - w:POOL_HIST + 1 - w + L, sl]
        cnt = jnp.minimum(jnp.float32(w), pos + 1.0)
        mean = total / cnt[None, :, None]
        outs.append(jnp.einsum("blc,cd->bld", mean - uf[..., sl], pool_w[gi].astype(jnp.float32)))
    out = jnp.concatenate(outs, axis=-1) * pool_scale.astype(jnp.float32)
    new_hist = xp[:, -POOL_HIST:].astype(hist.dtype)
    return out.astype(u.dtype), new_hist


def hgrn2_scan(q, k, v, log_f, S0):
    B, L, H, DK = q.shape
    DV = v.shape[-1]
    C = min(HGRN_CHUNK, L)
    n = -(-L // C)
    pad = n * C - L

    def blocks(a):
        a = jnp.pad(a, ((0, 0), (0, pad), (0, 0), (0, 0)))
        return a.reshape(B, n, C, H, a.shape[-1]).transpose(1, 0, 3, 2, 4)

    mask = jnp.tril(jnp.ones((C, C), bool))[:, :, None]

    def step(S, blk):
        qc, kc, vc, gc = blk
        A = jnp.cumsum(gc, axis=2)
        decay = jnp.exp(jnp.where(mask, A[:, :, :, None, :] - A[:, :, None, :, :], -jnp.inf))
        scores = jnp.einsum("bhtd,bhsd,bhtsd->bhts", qc, kc, decay)
        o = jnp.einsum("bhts,bhsv->bhtv", scores, vc) + jnp.einsum("bhtd,bhdv->bhtv", qc * jnp.exp(A), S)
        A_end = A[:, :, -1:, :]
        S = jnp.exp(A_end[:, :, 0, :])[..., None] * S + jnp.einsum("bhsd,bhsv->bhdv", kc * jnp.exp(A_end - A), vc)
        return S, o

    S, o = lax.scan(step, S0, (blocks(q), blocks(k), blocks(v), blocks(log_f)))
    o = o.transpose(1, 0, 3, 2, 4).reshape(B, n * C, H, DV)[:, :L]
    return o, S


def hgrn2_mixer(q, fp, i, g, S0, lb, onorm_g):
    B, L, _ = q.shape
    lbf = lb.astype(jnp.float32)
    fpf = fp.astype(jnp.float32)
    log_f = jnp.log(lbf + (1.0 - lbf) * jax.nn.sigmoid(fpf))
    k = (1.0 - lbf) * jax.nn.sigmoid(-fpf)
    qf = jax.nn.silu(q.astype(jnp.float32))
    heads = lambda a, d: a.reshape(B, L, HGRN_HEADS, d)
    o, S = hgrn2_scan(heads(qf, HGRN_DK), heads(k, HGRN_DK), heads(i.astype(jnp.float32), HGRN_DV),
                      heads(log_f, HGRN_DK), S0.astype(jnp.float32))
    o = o * lax.rsqrt(jnp.mean(o * o, axis=-1, keepdims=True) + EPS)
    o = o.reshape(B, L, HGRN_WIDTH) * onorm_g.astype(jnp.float32) * jax.nn.silu(g.astype(jnp.float32))
    return o.astype(q.dtype), S.astype(S0.dtype)


def cross_attn(qx, mem_k, mem_v):
    B, L, _ = qx.shape
    q = qx.reshape(B, L, XATTN_HEADS, XATTN_DH).astype(jnp.float32)
    s = jnp.einsum("blhd,bmhd->bhlm", q, mem_k.astype(jnp.float32)) * (XATTN_DH ** -0.5)
    p = jax.nn.softmax(s, axis=-1)
    o = jnp.einsum("bhlm,bmhd->blhd", p, mem_v.astype(jnp.float32))
    return o.reshape(B, L, XATTN_WIDTH).astype(qx.dtype)


def conv_ffn(x, hist, ln2_g, w_up, conv_w, conv_b, w_down):
    B, L, _ = x.shape
    h = rmsnorm(x, ln2_g)
    ab = h @ w_up
    a, b = ab[..., :D_FF], ab[..., D_FF:]
    ap = jnp.concatenate([hist.astype(a.dtype), a], axis=1)
    conv = conv_b
    for j in range(CONV_W):
        conv = conv + conv_w[j] * ap[:, j:j + L]
    out = (jax.nn.gelu(conv) * b) @ w_down
    return out, ap[:, -(CONV_W - 1):].astype(hist.dtype)


def trunk_layer(x, mem_k, mem_v, pool_hist, pos0, S0, conv_hist, lb,
                ln1_g, w_in, pool_w, pool_scale, onorm_g, w_out, ln2_g, w_up, conv_w, conv_b, w_down):
    h = rmsnorm(x, ln1_g)
    proj = h @ w_in
    u, q, fp, i, g, qx = jnp.split(proj, SPLITS, axis=-1)
    o_pool, new_pool = pool_mixer(u, pool_hist, pos0, pool_w, pool_scale)
    o_hgrn, new_S = hgrn2_mixer(q, fp, i, g, S0, lb, onorm_g)
    o_x = cross_attn(qx, mem_k, mem_v)
    x = x + jnp.concatenate([o_pool, o_hgrn, o_x], axis=-1) @ w_out
    f_out, new_conv = conv_ffn(x, conv_hist, ln2_g, w_up, conv_w, conv_b, w_down)
    x = x + f_out
    return x, new_pool, new_S, new_conv


def setup_inputs(seed: int = 0) -> dict:
    key = jax.random.key(seed)
    ks = jax.random.split(key, 32)
    nrm = lambda k, shape, s: jax.random.normal(k, shape, jnp.float32) * s
    return {
        "x_prompt": nrm(ks[0], (BATCH, SEQ, D_MODEL), 1.0),
        "x_sample": nrm(ks[1], (DEC_BATCH, DEC_SEQ, D_MODEL), 1.0),
        "mem_prompt": nrm(ks[2], (BATCH, N_MEM, D_MODEL), 1.0),
        "state_pool": nrm(ks[3], (DEPTH, DEC_BATCH, POOL_HIST, POOL_WIDTH), 1.0),
        "state_hgrn": nrm(ks[4], (DEPTH, DEC_BATCH, HGRN_HEADS, HGRN_DK, HGRN_DV), 0.5),
        "state_conv": nrm(ks[5], (DEPTH, DEC_BATCH, CONV_W - 1, D_FF), 1.0),
        "cache_mem_k": nrm(ks[6], (DEPTH, DEC_BATCH, N_MEM, XATTN_HEADS, XATTN_DH), 1.0),
        "cache_mem_v": nrm(ks[7], (DEPTH, DEC_BATCH, N_MEM, XATTN_HEADS, XATTN_DH), 1.0),
        "ln1_g": 1.0 + nrm(ks[8], (DEPTH, D_MODEL), 0.02),
        "w_in": nrm(ks[9], (DEPTH, D_MODEL, D_IN), D_MODEL ** -0.5),
        "pool_w": nrm(ks[10], (DEPTH, len(POOL_WINDOWS), POOL_GROUP, POOL_GROUP), POOL_GROUP ** -0.5),
        "pool_scale": 1.0 + nrm(ks[11], (DEPTH, POOL_WIDTH), 0.02),
        "hgrn_lb_logits": nrm(ks[12], (DEPTH + 1, HGRN_FDIM), 0.1),
        "hgrn_onorm_g": 1.0 + nrm(ks[13], (DEPTH, HGRN_WIDTH), 0.02),
        "mem_norm_g": 1.0 + nrm(ks[14], (DEPTH, D_MODEL), 0.02),
        "w_mem_kv": nrm(ks[15], (DEPTH, D_MODEL, 2 * XATTN_WIDTH), D_MODEL ** -0.5),
        "w_out": nrm(ks[16], (DEPTH, D_MIX, D_MODEL), D_MIX ** -0.5),
        "ln2_g": 1.0 + nrm(ks[17], (DEPTH, D_MODEL), 0.02),
        "w_up": nrm(ks[18], (DEPTH, D_MODEL, 2 * D_FF), D_MODEL ** -0.5),
        "conv_w": nrm(ks[19], (DEPTH, CONV_W, D_FF), CONV_W ** -0.5),
        "conv_b": nrm(ks[20], (DEPTH, D_FF), 0.02),
        "w_down": nrm(ks[21], (DEPTH, D_FF, D_MODEL), D_FF ** -0.5),
        "lnf_g": 1.0 + nrm(ks[22], (D_MODEL,), 0.02),
    }


def reference(x_prompt, x_sample, mem_prompt, state_pool, state_hgrn, state_conv, cache_mem_k, cache_mem_v,
              ln1_g, w_in, pool_w, pool_scale, hgrn_lb_logits, hgrn_onorm_g, mem_norm_g, w_mem_kv, w_out,
              ln2_g, w_up, conv_w, conv_b, w_down, lnf_g):
    lb_all = jnp.cumsum(jax.nn.softmax(hgrn_lb_logits.astype(jnp.float32), axis=0), axis=0)
    yp, ys = x_prompt, x_sample
    pp_l, sp_l, cp_l, mk_l, mv_l, ps_l, ss_l, cs_l = [], [], [], [], [], [], [], []
    dt = x_prompt.dtype
    for l in range(DEPTH):
        weights = (ln1_g[l], w_in[l], pool_w[l], pool_scale[l], hgrn_onorm_g[l], w_out[l],
                   ln2_g[l], w_up[l], conv_w[l], conv_b[l], w_down[l])
        kv = rmsnorm(mem_prompt, mem_norm_g[l]) @ w_mem_kv[l]
        mk = kv[..., :XATTN_WIDTH].reshape(BATCH, N_MEM, XATTN_HEADS, XATTN_DH)
        mv = kv[..., XATTN_WIDTH:].reshape(BATCH, N_MEM, XATTN_HEADS, XATTN_DH)
        yp, pp, sp, cp = trunk_layer(
            yp, mk, mv, jnp.zeros((BATCH, POOL_HIST, POOL_WIDTH), dt), 0,
            jnp.zeros((BATCH, HGRN_HEADS, HGRN_DK, HGRN_DV), dt),
            jnp.zeros((BATCH, CONV_W - 1, D_FF), dt), lb_all[l], *weights)
        ys, ps, ss, cs = trunk_layer(
            ys, cache_mem_k[l], cache_mem_v[l], state_pool[l], PAST_LEN, state_hgrn[l], state_conv[l],
            lb_all[l], *weights)
        pp_l.append(pp); sp_l.append(sp); cp_l.append(cp); mk_l.append(mk); mv_l.append(mv)
        ps_l.append(ps); ss_l.append(ss); cs_l.append(cs)
    y_prompt = rmsnorm(yp, lnf_g)
    y_sample = rmsnorm(ys, lnf_g)
    return (y_prompt, y_sample,
            jnp.stack(pp_l), jnp.stack(sp_l), jnp.stack(cp_l), jnp.stack(mk_l), jnp.stack(mv_l),
            jnp.stack(ps_l), jnp.stack(ss_l), jnp.stack(cs_l))
```

```cpp
#include <hip/hip_runtime.h>
#include <cstdio>
#include <cstdint>

namespace {
constexpr int DM = 1024, SEQ = 2048, NB = 8, DB = 128, DS = 8;
constexpr int DIN = 2560, DFF = 2816, NMEM = 256;
constexpr float EPS = 1e-6f;

__device__ __forceinline__ float wave_sum(float v) {
#pragma unroll
    for (int o = 1; o < 64; o <<= 1) v += __shfl_xor(v, o);
    return v;
}
__device__ __forceinline__ float wave_max(float v) {
#pragma unroll
    for (int o = 1; o < 64; o <<= 1) v = fmaxf(v, __shfl_xor(v, o));
    return v;
}
__device__ __forceinline__ float sigmoidf_(float x) { return 1.f / (1.f + __expf(-x)); }
__device__ __forceinline__ float siluf_(float x) { return x * sigmoidf_(x); }
__device__ __forceinline__ float gelu_tanh(float x) {
    const float u = 0.7978845608028654f * (x + 0.044715f * x * x * x);
    return 0.5f * x * (1.f + tanhf(u));
}

__global__ __launch_bounds__(256) void rmsnorm_k(const float* __restrict__ x, const float* __restrict__ g, float* __restrict__ out, int nrows) {
    const int row = blockIdx.x * 4 + (threadIdx.x >> 6), lane = threadIdx.x & 63;
    if (row >= nrows) return;
    const float4* xr = (const float4*)(x + (size_t)row * DM);
    float4 v[4]; float s = 0.f;
#pragma unroll
    for (int j = 0; j < 4; ++j) { v[j] = xr[lane + 64 * j]; s += v[j].x * v[j].x + v[j].y * v[j].y + v[j].z * v[j].z + v[j].w * v[j].w; }
    s = wave_sum(s);
    const float r = rsqrtf(s * (1.f / DM) + EPS);
    float4* o = (float4*)(out + (size_t)row * DM);
    const float4* g4 = (const float4*)g;
#pragma unroll
    for (int j = 0; j < 4; ++j) { const float4 gg = g4[lane + 64 * j]; float4 w; w.x = v[j].x * r * gg.x; w.y = v[j].y * r * gg.y; w.z = v[j].z * r * gg.z; w.w = v[j].w * r * gg.w; o[lane + 64 * j] = w; }
}

__global__ __launch_bounds__(256) void gemm_k(const float* __restrict__ A, int lda, const float* __restrict__ W, int ldw, float* __restrict__ C, int ldc, int K, const float* __restrict__ R, int ldr) {
    __shared__ float As[16][65];
    __shared__ float Ws[16][64];
    const int tid = threadIdx.x, bm = blockIdx.y * 64, bn = blockIdx.x * 64, tx = tid & 15, ty = tid >> 4;
    float acc[4][4];
#pragma unroll
    for (int i = 0; i < 4; ++i)
#pragma unroll
        for (int j = 0; j < 4; ++j) acc[i][j] = 0.f;
    for (int k0 = 0; k0 < K; k0 += 16) {
#pragma unroll
        for (int i = 0; i < 4; ++i) { const int idx = tid + i * 256, m = idx >> 4, k = idx & 15; As[k][m] = A[(size_t)(bm + m) * lda + k0 + k]; }
#pragma unroll
        for (int i = 0; i < 4; ++i) { const int idx = tid + i * 256, k = idx >> 6, n = idx & 63; Ws[k][n] = W[(size_t)(k0 + k) * ldw + bn + n]; }
        __syncthreads();
#pragma unroll
        for (int k = 0; k < 16; ++k) {
            float a[4], b[4];
#pragma unroll
            for (int i = 0; i < 4; ++i) { a[i] = As[k][ty * 4 + i]; b[i] = Ws[k][tx * 4 + i]; }
#pragma unroll
            for (int i = 0; i < 4; ++i)
#pragma unroll
                for (int j = 0; j < 4; ++j) acc[i][j] += a[i] * b[j];
        }
        __syncthreads();
    }
#pragma unroll
    for (int i = 0; i < 4; ++i)
#pragma unroll
        for (int j = 0; j < 4; ++j) {
            const int m = bm + ty * 4 + i, n = bn + tx * 4 + j;
            float v = acc[i][j];
            if (R) v += R[(size_t)m * ldr + n];
            C[(size_t)m * ldc + n] = v;
        }
}

__global__ void copy_cols_k(const float* __restrict__ src, int lds_, int c0, float* __restrict__ dst, int ncols, int nrows) {
    const size_t i = (size_t)blockIdx.x * blockDim.x + threadIdx.x;
    if (i >= (size_t)nrows * ncols) return;
    const int r = (int)(i / ncols), c = (int)(i % ncols);
    dst[i] = src[(size_t)r * lds_ + c0 + c];
}

__global__ __launch_bounds__(256) void pool_k(const float* __restrict__ proj, const float* __restrict__ hist  , int L, int pos0,
                                              const float* __restrict__ pool_w, const float* __restrict__ pool_scale, float* __restrict__ mix, float* __restrict__ new_pool  ) {
    __shared__ float d[256];
    const int r = blockIdx.x, b = r / L, t = r % L, c = threadIdx.x, g = c >> 6, w = 2 << g;
    auto xp = [&](int tau) -> float {
        if (tau >= 0) return proj[(size_t)(b * L + tau) * DIN + c];
        return hist ? hist[((size_t)b * 15 + (15 + tau)) * 256 + c] : 0.f;
    };
    float s = 0.f;
    for (int j = 0; j < w; ++j) s += xp(t - j);
    const float cnt = fminf((float)w, (float)(pos0 + t) + 1.0f);
    const float ut = xp(t);
    d[c] = s / cnt - ut;
    __syncthreads();
    float o = 0.f;
    const float* pw = pool_w + (size_t)g * 64 * 64 + (c & 63);
    for (int j = 0; j < 64; ++j) o += d[g * 64 + j] * pw[j * 64];
    mix[(size_t)r * DM + c] = o * pool_scale[c];
    if (t == L - 1) {
        for (int i = 0; i < 15; ++i) new_pool[((size_t)b * 15 + i) * 256 + c] = xp(L - 15 + i);
    }
}

__global__ __launch_bounds__(256) void hgrn_k(const float* __restrict__ proj, int L, const float* __restrict__ S0  , const float* __restrict__ lb_logits  ,
                                              const float* __restrict__ onorm_g, float* __restrict__ mix, float* __restrict__ Sout) {
    __shared__ float qs[128], fs[128], ks[128], part[2][128], red[4];
    const int bh = blockIdx.x, b = bh >> 2, h = bh & 3, tid = threadIdx.x, dv = tid & 127, half = tid >> 7, wave = tid >> 6, lane = tid & 63;
    float S[64];
#pragma unroll
    for (int j = 0; j < 64; ++j) S[j] = S0 ? S0[(((size_t)b * 4 + h) * 128 + half * 64 + j) * 128 + dv] : 0.f;
    float lb = 0.f;
    if (tid < 128) { const float l0 = lb_logits[h * 128 + tid], l1 = lb_logits[512 + h * 128 + tid]; const float m = fmaxf(l0, l1); const float e0 = __expf(l0 - m), e1 = __expf(l1 - m); lb = e0 / (e0 + e1); }
    for (int t = 0; t < L; ++t) {
        const float* pr = proj + (size_t)(b * L + t) * DIN;
        if (tid < 128) {
            const float q = pr[256 + h * 128 + tid], fp = pr[768 + h * 128 + tid];
            qs[tid] = siluf_(q);
            fs[tid] = lb + (1.f - lb) * sigmoidf_(fp);
            ks[tid] = (1.f - lb) * sigmoidf_(-fp);
        }
        const float v = pr[1280 + h * 128 + dv];
        __syncthreads();
        float op = 0.f;
#pragma unroll
        for (int j = 0; j < 64; ++j) { const int dk = half * 64 + j; S[j] = fs[dk] * S[j] + ks[dk] * v; op += qs[dk] * S[j]; }
        part[half][dv] = op;
        __syncthreads();
        const float o = part[0][dv] + part[1][dv];
        const float ss = wave_sum(o * o);
        if (lane == 0) red[wave] = ss;
        __syncthreads();
        if (half == 0) {
            const float tot = red[0] + red[1];
            const float gg = pr[1792 + h * 128 + dv];
            mix[(size_t)(b * L + t) * DM + 256 + h * 128 + dv] = o * rsqrtf(tot * (1.f / 128.f) + EPS) * onorm_g[h * 128 + dv] * siluf_(gg);
        }
    }
#pragma unroll
    for (int j = 0; j < 64; ++j) Sout[(((size_t)b * 4 + h) * 128 + half * 64 + j) * 128 + dv] = S[j];
}

__global__ __launch_bounds__(256) void xattn_k(const float* __restrict__ proj, int L, const float* __restrict__ Kp, const float* __restrict__ Vp, int ldkv, float* __restrict__ mix) {
    __shared__ float q[64], p[256], red[4], po[4][64];
    const int r = blockIdx.x >> 2, h = blockIdx.x & 3, b = r / L, tid = threadIdx.x, wave = tid >> 6, lane = tid & 63;
    if (tid < 64) q[tid] = proj[(size_t)r * DIN + 2304 + h * 64 + tid];
    __syncthreads();
    const float* kr = Kp + ((size_t)b * NMEM + tid) * ldkv + h * 64;
    float s = 0.f;
#pragma unroll 8
    for (int d = 0; d < 64; ++d) s += q[d] * kr[d];
    s *= 0.125f;
    float m = wave_max(s);
    if (lane == 0) red[wave] = m;
    __syncthreads();
    m = fmaxf(fmaxf(red[0], red[1]), fmaxf(red[2], red[3]));
    const float e = __expf(s - m);
    p[tid] = e;
    float sum = wave_sum(e);
    __syncthreads();
    if (lane == 0) red[wave] = sum;
    __syncthreads();
    sum = red[0] + red[1] + red[2] + red[3];
    const int d = tid & 63, pt = tid >> 6;
    float o = 0.f;
    for (int mm = pt * 64; mm < pt * 64 + 64; ++mm) o += p[mm] * Vp[((size_t)b * NMEM + mm) * ldkv + h * 64 + d];
    po[pt][d] = o;
    __syncthreads();
    if (tid < 64) mix[(size_t)r * DM + 768 + h * 64 + tid] = (po[0][tid] + po[1][tid] + po[2][tid] + po[3][tid]) / sum;
}

__global__ __launch_bounds__(256) void conv_k(const float* __restrict__ AB, const float* __restrict__ hist  , int L, const float* __restrict__ conv_w, const float* __restrict__ conv_b,
                                              float* __restrict__ hid, float* __restrict__ new_conv  ) {
    const int r = blockIdx.y, j = blockIdx.x * 256 + threadIdx.x, b = r / L, t = r % L;
    auto a = [&](int tau) -> float {
        if (tau >= 0) return AB[(size_t)(b * L + tau) * (2 * DFF) + j];
        return hist ? hist[((size_t)b * 2 + (2 + tau)) * DFF + j] : 0.f;
    };
    const float a0 = a(t), a1 = a(t - 1), a2 = a(t - 2);
    const float c = conv_b[j] + conv_w[j] * a2 + conv_w[DFF + j] * a1 + conv_w[2 * DFF + j] * a0;
    hid[(size_t)r * DFF + j] = gelu_tanh(c) * AB[(size_t)r * (2 * DFF) + DFF + j];
    if (t == L - 1) { new_conv[((size_t)b * 2 + 0) * DFF + j] = a(L - 2); new_conv[((size_t)b * 2 + 1) * DFF + j] = a0; }
}
}

extern "C" void kernel_launch(void* const* d_in, const int* in_sizes, int n_in, void* d_out, int out_size, void* d_ws, size_t ws_size, hipStream_t stream) {
    const float* x_prompt = (const float*)d_in[0];
    const float* x_sample = (const float*)d_in[1];
    const float* mem_prompt = (const float*)d_in[2];
    const float* state_pool = (const float*)d_in[3];
    const float* state_hgrn = (const float*)d_in[4];
    const float* state_conv = (const float*)d_in[5];
    const float* cache_k = (const float*)d_in[6];
    const float* cache_v = (const float*)d_in[7];
    const float* ln1_g = (const float*)d_in[8];
    const float* w_in = (const float*)d_in[9];
    const float* pool_w = (const float*)d_in[10];
    const float* pool_scale = (const float*)d_in[11];
    const float* lb_logits = (const float*)d_in[12];
    const float* onorm_g = (const float*)d_in[13];
    const float* mem_norm_g = (const float*)d_in[14];
    const float* w_mem_kv = (const float*)d_in[15];
    const float* w_out = (const float*)d_in[16];
    const float* ln2_g = (const float*)d_in[17];
    const float* w_up = (const float*)d_in[18];
    const float* conv_w = (const float*)d_in[19];
    const float* conv_b = (const float*)d_in[20];
    const float* w_down = (const float*)d_in[21];
    const float* lnf_g = (const float*)d_in[22];

    float* out = (float*)d_out;
    float* y_prompt = out;
    float* y_sample = y_prompt + (size_t)NB * SEQ * DM;
    float* o_pool_p = y_sample + (size_t)DB * DS * DM;
    float* o_hgrn_p = o_pool_p + (size_t)NB * 15 * 256;
    float* o_conv_p = o_hgrn_p + (size_t)NB * 4 * 128 * 128;
    float* o_mk = o_conv_p + (size_t)NB * 2 * DFF;
    float* o_mv = o_mk + (size_t)NB * NMEM * 256;
    float* o_pool_s = o_mv + (size_t)NB * NMEM * 256;
    float* o_hgrn_s = o_pool_s + (size_t)DB * 15 * 256;
    float* o_conv_s = o_hgrn_s + (size_t)DB * 4 * 128 * 128;

    float* ws = (float*)d_ws;
    const size_t RMAX = 2048;
    float* H = ws;
    float* PROJ = H + RMAX * DM;
    float* MIX = PROJ + RMAX * DIN;
    float* X1 = MIX + RMAX * DM;
    float* AB = X1 + RMAX * DM;
    float* HID = AB + RMAX * 2 * DFF;
    float* X2 = HID + RMAX * DFF;
    float* HM = X2 + RMAX * DM;
    float* KV = HM + RMAX * DM;

    rmsnorm_k<<<2048 / 4, 256, 0, stream>>>(mem_prompt, mem_norm_g, HM, 2048);
    gemm_k<<<dim3(512 / 64, 2048 / 64), 256, 0, stream>>>(HM, DM, w_mem_kv, 512, KV, 512, DM, nullptr, 0);
    copy_cols_k<<<(2048 * 256 + 255) / 256, 256, 0, stream>>>(KV, 512, 0, o_mk, 256, 2048);
    copy_cols_k<<<(2048 * 256 + 255) / 256, 256, 0, stream>>>(KV, 512, 256, o_mv, 256, 2048);

    for (int ch = 0; ch < 9; ++ch) {
        const bool smp = (ch == 8);
        const int R = smp ? DB * DS : SEQ, L = smp ? DS : SEQ, nb = smp ? DB : 1;
        const float* X = smp ? x_sample : x_prompt + (size_t)ch * SEQ * DM;
        float* Y = smp ? y_sample : y_prompt + (size_t)ch * SEQ * DM;
        rmsnorm_k<<<R / 4, 256, 0, stream>>>(X, ln1_g, H, R);
        gemm_k<<<dim3(DIN / 64, R / 64), 256, 0, stream>>>(H, DM, w_in, DIN, PROJ, DIN, DM, nullptr, 0);
        pool_k<<<R, 256, 0, stream>>>(PROJ, smp ? state_pool : nullptr, L, smp ? 16384 : 0, pool_w, pool_scale, MIX, smp ? o_pool_s : o_pool_p + (size_t)ch * 15 * 256);
        hgrn_k<<<nb * 4, 256, 0, stream>>>(PROJ, L, smp ? state_hgrn : nullptr, lb_logits, onorm_g, MIX, smp ? o_hgrn_s : o_hgrn_p + (size_t)ch * 4 * 128 * 128);
        if (smp) xattn_k<<<R * 4, 256, 0, stream>>>(PROJ, L, cache_k, cache_v, 256, MIX);
        else xattn_k<<<R * 4, 256, 0, stream>>>(PROJ, L, KV + (size_t)ch * NMEM * 512, KV + (size_t)ch * NMEM * 512 + 256, 512, MIX);
        gemm_k<<<dim3(DM / 64, R / 64), 256, 0, stream>>>(MIX, DM, w_out, DM, X1, DM, DM, X, DM);
        rmsnorm_k<<<R / 4, 256, 0, stream>>>(X1, ln2_g, H, R);
        gemm_k<<<dim3(2 * DFF / 64, R / 64), 256, 0, stream>>>(H, DM, w_up, 2 * DFF, AB, 2 * DFF, DM, nullptr, 0);
        conv_k<<<dim3(DFF / 256, R), 256, 0, stream>>>(AB, smp ? state_conv : nullptr, L, conv_w, conv_b, HID, smp ? o_conv_s : o_conv_p + (size_t)ch * 2 * DFF);
        gemm_k<<<dim3(DM / 64, R / 64), 256, 0, stream>>>(HID, DFF, w_down, DM, X2, DM, DFF, X1, DM);
        rmsnorm_k<<<R / 4, 256, 0, stream>>>(X2, lnf_g, Y, R);
    }
}
```

```cpp
#include <hip/hip_runtime.h>
#include <cstdio>
#include <cstdint>
namespace pg8 {
#define PG8_LAS __attribute__((address_space(3)))
typedef unsigned short bf16_t;
typedef short bf16x8 __attribute__((ext_vector_type(8)));
typedef float f32x4 __attribute__((ext_vector_type(4)));
typedef unsigned u32x4 __attribute__((ext_vector_type(4)));
constexpr int BM = 256, BK = 64, HALF = 128, HTB = HALF * BK * 2  , STAGE_BYTES = 8 * HTB, NXCD = 8, WGM = 8;

__host__ __device__ __forceinline__ int lds_byte(int r, int c) { const int st = (r >> 4) * 2 + (c >> 5), rr = r & 15, cc = c & 31, ob = rr * 64 + cc * 2; return st * 1024 + (ob ^ (((ob >> 9) & 1) << 5)); }
__host__ __device__ __forceinline__ void stage_rc(int b, int& R, int& C) { const int st = b / 1024, sb = b % 1024, swz = sb ^ (((sb >> 9) & 1) << 5); R = (st >> 1) * 16 + swz / 64; C = (st & 1) * 32 + (swz % 64) / 2; }
__host__ __device__ __forceinline__ int perm32(int rho) { const int n = rho >> 4, i = rho & 15; return 8 * (i >> 2) + 4 * n + (i & 3); }

struct Unit { int pm, pn; };
struct Gemm { const bf16_t* A; const bf16_t* Bt; int M, N, K; };

struct StaticOrder {
    int nM, nN, nwg, G, c;
    __host__ __device__ void init(int M, int N, int G_, int c_) { nM = M / BM; nN = N / BM; nwg = nM * nN; G = G_; c = c_; }
    __host__ __device__ bool next(int i, Unit& u) const {
        const long L = (long)i * G + c; if (L >= nwg) return false;
        int wgid = (int)L; { const int q = nwg / NXCD, r = nwg % NXCD, xcd = wgid % NXCD, off = wgid / NXCD; wgid = (xcd < r ? xcd * (q + 1) : r * (q + 1) + (xcd - r) * q) + off; }
        const int nig = WGM * nN, gid = wgid / nig, fm = gid * WGM, gsz = (nM - fm) < WGM ? (nM - fm) : WGM;
        u.pm = fm + ((wgid % nig) % gsz); u.pn = (wgid % nig) / gsz; return true;
    }
    __device__ __forceinline__ void a_ready(const Unit&) const {}
    __device__ __forceinline__ void done(const Unit&) const {}
};
__device__ __forceinline__ unsigned cvt_pk_bf16(float lo, float hi) { unsigned r; asm volatile("v_cvt_pk_bf16_f32 %0, %1, %2" : "=v"(r) : "v"(lo), "v"(hi)); return r; }
typedef float f32x2 __attribute__((ext_vector_type(2)));
typedef unsigned u32x2 __attribute__((ext_vector_type(2)));
__device__ __forceinline__ float frcp(float x) { return __builtin_amdgcn_rcpf(x); }
__device__ __forceinline__ float fsilu(float x) { return x * frcp(1.f + __expf(-x)); }
__device__ __forceinline__ u32x4 pack8(const f32x4& v0, const f32x4& v1) { u32x4 w; w.x = cvt_pk_bf16(v0[0], v0[1]); w.y = cvt_pk_bf16(v0[2], v0[3]); w.z = cvt_pk_bf16(v1[0], v1[1]); w.w = cvt_pk_bf16(v1[2], v1[3]); return w; }
constexpr float QX_SCALE = 0.125f * 1.4426950408889634f;
struct EpiIn {
    static constexpr bool PERM = true, AFTER_DRAIN = false;
    float* U; bf16_t* Q; float* LOGF; bf16_t* KK; bf16_t* V; bf16_t* G; bf16_t* QX; const float* lbl;
    __device__ __forceinline__ void operator()(const f32x4 (&acc)[2][2][4][2], const Unit& u, int wr, int wc, int fr, int fq) const {
        const int row0 = u.pm * BM + wr * 64 + fr, pn = u.pn, cl = wc * 32 + 8 * fq;
        if (pn == 0) {
#pragma unroll
            for (int ai = 0; ai < 2; ++ai)
#pragma unroll
                for (int m = 0; m < 4; ++m) { float* rowp = U + (size_t)(row0 + ai * HALF + m * 16) * 256 + cl;
#pragma unroll
                    for (int bj = 0; bj < 2; ++bj) { *(f32x4*)(rowp + bj * HALF) = acc[ai][bj][m][0]; *(f32x4*)(rowp + bj * HALF + 4) = acc[ai][bj][m][1]; } }
        } else if (pn == 3 || pn == 4) {
            const int c0 = (pn - 3) * 256 + cl;
            f32x4 oml[2][2];
#pragma unroll
            for (int bj = 0; bj < 2; ++bj)
#pragma unroll
                for (int n = 0; n < 2; ++n) { const f32x4 l0 = *(const f32x4*)(lbl + c0 + bj * HALF + 4 * n), l1 = *(const f32x4*)(lbl + 512 + c0 + bj * HALF + 4 * n);
#pragma unroll
                    for (int e = 0; e < 4; ++e) oml[bj][n][e] = frcp(1.f + __expf(l0[e] - l1[e])); }
#pragma unroll
            for (int ai = 0; ai < 2; ++ai)
#pragma unroll
                for (int m = 0; m < 4; ++m) { const size_t ro = (size_t)(row0 + ai * HALF + m * 16) * 512 + c0;
#pragma unroll
                    for (int bj = 0; bj < 2; ++bj) { f32x4 kk[2], lf[2];
#pragma unroll
                        for (int n = 0; n < 2; ++n)
#pragma unroll
                            for (int e = 0; e < 4; ++e) { const float x = acc[ai][bj][m][n][e]; const float k = oml[bj][n][e] * frcp(1.f + __expf(x)); kk[n][e] = k; lf[n][e] = __logf(1.f - k); }
                        *(f32x4*)(LOGF + ro + bj * HALF) = lf[0]; *(f32x4*)(LOGF + ro + bj * HALF + 4) = lf[1];
                        *(u32x4*)(KK + ro + bj * HALF) = pack8(kk[0], kk[1]); } }
        } else {
            bf16_t* base; int ldc, cb, mode;
            if (pn <= 2) { base = Q; ldc = 512; cb = (pn - 1) * 256; mode = 1; }
            else if (pn <= 6) { base = V; ldc = 512; cb = (pn - 5) * 256; mode = 0; }
            else if (pn <= 8) { base = G; ldc = 512; cb = (pn - 7) * 256; mode = 1; }
            else { base = QX; ldc = 256; cb = 0; mode = 2; }
#pragma unroll
            for (int ai = 0; ai < 2; ++ai)
#pragma unroll
                for (int m = 0; m < 4; ++m) { bf16_t* rowp = base + (size_t)(row0 + ai * HALF + m * 16) * ldc + cb + cl;
#pragma unroll
                    for (int bj = 0; bj < 2; ++bj) { f32x4 v0 = acc[ai][bj][m][0], v1 = acc[ai][bj][m][1];
                        if (mode == 1) {
#pragma unroll
                            for (int e = 0; e < 4; ++e) { v0[e] = fsilu(v0[e]); v1[e] = fsilu(v1[e]); } }
                        else if (mode == 2) { v0 = v0 * QX_SCALE; v1 = v1 * QX_SCALE; }
                        *(u32x4*)(rowp + bj * HALF) = pack8(v0, v1); } }
        }
    }
};
struct EpiKV {
    static constexpr bool PERM = true, AFTER_DRAIN = false;
    float* MK; float* MV; bf16_t* KVB;
    __device__ __forceinline__ void operator()(const f32x4 (&acc)[2][2][4][2], const Unit& u, int wr, int wc, int fr, int fq) const {
        const int row0 = u.pm * BM + wr * 64 + fr, cl = wc * 32 + 8 * fq; float* of = u.pn ? MV : MK;
#pragma unroll
        for (int ai = 0; ai < 2; ++ai)
#pragma unroll
            for (int m = 0; m < 4; ++m) { const size_t r = (size_t)(row0 + ai * HALF + m * 16);
#pragma unroll
                for (int bj = 0; bj < 2; ++bj) { *(f32x4*)(of + r * 256 + cl + bj * HALF) = acc[ai][bj][m][0]; *(f32x4*)(of + r * 256 + cl + bj * HALF + 4) = acc[ai][bj][m][1];
                    *(u32x4*)(KVB + r * 512 + u.pn * 256 + cl + bj * HALF) = pack8(acc[ai][bj][m][0], acc[ai][bj][m][1]); } }
    }
};
struct EpiRes {
    static constexpr bool PERM = true, AFTER_DRAIN = false;
    const float* r0; const float* r1; int split; float* out;
    __device__ __forceinline__ void operator()(const f32x4 (&acc)[2][2][4][2], const Unit& u, int wr, int wc, int fr, int fq) const {
        const int row0 = u.pm * BM + wr * 64 + fr, cl = u.pn * BM + wc * 32 + 8 * fq;
#pragma unroll
        for (int ai = 0; ai < 2; ++ai)
#pragma unroll
            for (int m = 0; m < 4; ++m) { const int r = row0 + ai * HALF + m * 16; const float* rp = (r < split ? r0 + (size_t)r * 1024 : r1 + (size_t)(r - split) * 1024) + cl; float* op = out + (size_t)r * 1024 + cl;
#pragma unroll
                for (int bj = 0; bj < 2; ++bj)
#pragma unroll
                    for (int n = 0; n < 2; ++n) { const f32x4 x = *(const f32x4*)(rp + bj * HALF + 4 * n); *(f32x4*)(op + bj * HALF + 4 * n) = acc[ai][bj][m][n] + x; } }
    }
};
struct EpiPlanes {
    static constexpr bool PERM = true, AFTER_DRAIN = false;
    bf16_t* P0; bf16_t* P1; int tiles_per_plane, ldc;
    __device__ __forceinline__ void operator()(const f32x4 (&acc)[2][2][4][2], const Unit& u, int wr, int wc, int fr, int fq) const {
        const int row0 = u.pm * BM + wr * 64 + fr; const bool second = u.pn >= tiles_per_plane; bf16_t* base = second ? P1 : P0; const int cl = (second ? u.pn - tiles_per_plane : u.pn) * BM + wc * 32 + 8 * fq;
#pragma unroll
        for (int ai = 0; ai < 2; ++ai)
#pragma unroll
            for (int m = 0; m < 4; ++m) { bf16_t* rowp = base + (size_t)(row0 + ai * HALF + m * 16) * ldc + cl;
#pragma unroll
                for (int bj = 0; bj < 2; ++bj) *(u32x4*)(rowp + bj * HALF) = pack8(acc[ai][bj][m][0], acc[ai][bj][m][1]); }
    }
};
struct EpiOut2 {
    static constexpr bool PERM = true, AFTER_DRAIN = false;
    const float* r0; const float* r1; int split; float* out; bf16_t* XB; float* ROWSS;
    __device__ __forceinline__ void operator()(const f32x4 (&acc)[2][2][4][2], const Unit& u, int wr, int wc, int fr, int fq) const {
        const int row0 = u.pm * BM + wr * 64 + fr, cl = u.pn * BM + wc * 32 + 8 * fq;
#pragma unroll
        for (int ai = 0; ai < 2; ++ai)
#pragma unroll
            for (int m = 0; m < 4; ++m) { const int r = row0 + ai * HALF + m * 16; const float* rp = (r < split ? r0 + (size_t)r * 1024 : r1 + (size_t)(r - split) * 1024) + cl;
                float ss = 0.f;
#pragma unroll
                for (int bj = 0; bj < 2; ++bj) { f32x4 v[2];
#pragma unroll
                    for (int n = 0; n < 2; ++n) { v[n] = acc[ai][bj][m][n] + *(const f32x4*)(rp + bj * HALF + 4 * n);
                        ss += (v[n][0] * v[n][0] + v[n][1] * v[n][1]) + (v[n][2] * v[n][2] + v[n][3] * v[n][3]); }
                    *(u32x4*)(XB + (size_t)r * 1024 + cl + bj * HALF) = pack8(v[0], v[1]); }
                ss += __shfl_xor(ss, 16); ss += __shfl_xor(ss, 32);
                if (fq == 0) ROWSS[(size_t)r * 16 + u.pn * 4 + wc] = ss; }
    }
};
struct EpiUpConv {
    static constexpr bool PERM = true, AFTER_DRAIN = false;
    const float* ROWSS; const float* ROWSS_S; const float* conv_w; const float* conv_b; const float* state_conv; bf16_t* HID; float* EA; float* EB; float* o_conv_p; float* o_conv_s; PG8_LAS float* xch;
    static constexpr int FF = 2816;
    __device__ __forceinline__ static float gelu_t(float x) { const float u2 = 1.5957691216057308f * (x + 0.044715f * x * x * x); return x * frcp(1.f + __expf(-u2)); }
    __device__ __forceinline__ void operator()(const f32x4 (&acc)[2][2][4][2], const Unit& u, int wr, int wc, int fr, int fq) const {
        const int lane = fq * 16 + fr, row0 = u.pm * BM + wr * 64 + fr, j0 = u.pn * 128 + wc * 32 + 8 * fq;
        const bool smp = u.pm >= 64;
        float rstd[2][4];
#pragma unroll
        for (int ai = 0; ai < 2; ++ai)
#pragma unroll
            for (int m = 0; m < 4; ++m) { const int r = row0 + ai * HALF + m * 16; float s;
                if (!smp) { const f32x4 p = *(const f32x4*)(ROWSS + (size_t)r * 16 + 4 * fq); s = (p[0] + p[1]) + (p[2] + p[3]); }
                else { const f32x4 p = *(const f32x4*)(ROWSS_S + (size_t)(r - 16384) * 32 + 8 * fq), q = *(const f32x4*)(ROWSS_S + (size_t)(r - 16384) * 32 + 8 * fq + 4); s = ((p[0] + p[1]) + (p[2] + p[3])) + ((q[0] + q[1]) + (q[2] + q[3])); }
                s += __shfl_xor(s, 16); s += __shfl_xor(s, 32); rstd[ai][m] = 1.0f / sqrtf(s * (1.f / 1024.f) + 1e-6f); }
        if (!smp) {
            if (fr >= 14) {
#pragma unroll
                for (int ai = 0; ai < 2; ++ai)
#pragma unroll
                    for (int n = 0; n < 2; ++n) *(PG8_LAS f32x4*)(xch + ((((ai * 2 + wr) * 4 + wc) * 4 + fq) * 2 + (fr - 14)) * 8 + 4 * n) = acc[ai][0][3][n] * rstd[ai][3]; }
            asm volatile("s_waitcnt lgkmcnt(0)" ::: "memory"); __builtin_amdgcn_s_barrier(); asm volatile("" ::: "memory");
        }
        const int src1 = (lane & 48) | ((fr + 15) & 15), src2 = (lane & 48) | ((fr + 14) & 15);
#pragma unroll
        for (int n = 0; n < 2; ++n) {
            const f32x4 cb = *(const f32x4*)(conv_b + j0 + 4 * n), w0 = *(const f32x4*)(conv_w + j0 + 4 * n), w1 = *(const f32x4*)(conv_w + FF + j0 + 4 * n), w2 = *(const f32x4*)(conv_w + 2 * FF + j0 + 4 * n);
#pragma unroll
            for (int ai = 0; ai < 2; ++ai) {
                f32x4 pa = (f32x4){0.f, 0.f, 0.f, 0.f};
                if (!smp && fr >= 14 && (wr == 1 || ai == 1)) { const int sai = wr == 1 ? ai : 0, swr = wr == 1 ? 0 : 1;
                    pa = *(const PG8_LAS f32x4*)(xch + ((((sai * 2 + swr) * 4 + wc) * 4 + fq) * 2 + (fr - 14)) * 8 + 4 * n); }
#pragma unroll
                for (int m = 0; m < 4; ++m) {
                    const int r = row0 + ai * HALF + m * 16; const float rs = rstd[ai][m];
                    const f32x4 a = acc[ai][0][m][n] * rs, b = acc[ai][1][m][n] * rs; f32x4 p1, p2;
                    if (!smp) {
#pragma unroll
                        for (int e2 = 0; e2 < 4; ++e2) { const float s1 = fr == 15 ? pa[e2] : a[e2], s2 = fr >= 14 ? pa[e2] : a[e2]; p1[e2] = __shfl(s1, src1); p2[e2] = __shfl(s2, src2); }
                        if (ai == 0 && wr == 0 && m == 0 && fr < 2) { *(f32x4*)(EA + ((size_t)u.pm * 4 + fr) * FF + j0 + 4 * n) = a; *(f32x4*)(EB + ((size_t)u.pm * 2 + fr) * FF + j0 + 4 * n) = b; }
                        if (ai == 1 && wr == 1 && m == 3 && fr >= 14) { *(f32x4*)(EA + ((size_t)u.pm * 4 + 2 + (fr - 14)) * FF + j0 + 4 * n) = a;
                            if ((u.pm & 7) == 7) *(f32x4*)(o_conv_p + ((size_t)(u.pm >> 3) * 2 + (fr - 14)) * FF + j0 + 4 * n) = a; }
                    } else {
                        const int t = fr & 7, bb = (r - 16384) >> 3;
#pragma unroll
                        for (int e2 = 0; e2 < 4; ++e2) { p1[e2] = __shfl(a[e2], src1); p2[e2] = __shfl(a[e2], src2); }
                        if (t < 2) { const f32x4 h1 = *(const f32x4*)(state_conv + ((size_t)bb * 2 + 1) * FF + j0 + 4 * n);
                            if (t == 0) { p1 = h1; p2 = *(const f32x4*)(state_conv + ((size_t)bb * 2) * FF + j0 + 4 * n); } else p2 = h1; }
                        if (t >= 6) *(f32x4*)(o_conv_s + ((size_t)bb * 2 + (t - 6)) * FF + j0 + 4 * n) = a;
                    }
                    f32x4 hv;
#pragma unroll
                    for (int e2 = 0; e2 < 4; ++e2) { const float c = cb[e2] + w0[e2] * p2[e2] + w1[e2] * p1[e2] + w2[e2] * a[e2]; hv[e2] = gelu_t(c) * b[e2]; }
                    *(u32x2*)(HID + (size_t)r * FF + j0 + 4 * n) = (u32x2){cvt_pk_bf16(hv[0], hv[1]), cvt_pk_bf16(hv[2], hv[3])};
                    pa = a;
                }
            }
        }
    }
};
struct EpiResB {
    static constexpr bool PERM = true, AFTER_DRAIN = false;
    const bf16_t* XB; float* out;
    __device__ __forceinline__ void operator()(const f32x4 (&acc)[2][2][4][2], const Unit& u, int wr, int wc, int fr, int fq) const {
        const int row0 = u.pm * BM + wr * 64 + fr, cl = u.pn * BM + wc * 32 + 8 * fq;
#pragma unroll
        for (int ai = 0; ai < 2; ++ai)
#pragma unroll
            for (int m = 0; m < 4; ++m) { const int r = row0 + ai * HALF + m * 16; float* op = out + (size_t)r * 1024 + cl;
#pragma unroll
                for (int bj = 0; bj < 2; ++bj) { const u32x4 xb = *(const u32x4*)(XB + (size_t)r * 1024 + cl + bj * HALF);
                    f32x4 x0, x1;
                    x0[0] = __builtin_bit_cast(float, xb[0] << 16); x0[1] = __builtin_bit_cast(float, xb[0] & 0xffff0000u); x0[2] = __builtin_bit_cast(float, xb[1] << 16); x0[3] = __builtin_bit_cast(float, xb[1] & 0xffff0000u);
                    x1[0] = __builtin_bit_cast(float, xb[2] << 16); x1[1] = __builtin_bit_cast(float, xb[2] & 0xffff0000u); x1[2] = __builtin_bit_cast(float, xb[3] << 16); x1[3] = __builtin_bit_cast(float, xb[3] & 0xffff0000u);
                    *(f32x4*)(op + bj * HALF) = acc[ai][bj][m][0] + x0; *(f32x4*)(op + bj * HALF + 4) = acc[ai][bj][m][1] + x1; } }
    }
};
template <class Epi, class Sched, bool ALIGN_EPI = false, bool SP2 = false>
__device__ __forceinline__ void gemm_phase(PG8_LAS unsigned char* lds, const Gemm g, const Sched& S, const Epi& E) {
    const int tid = threadIdx.x, wid = __builtin_amdgcn_readfirstlane(tid >> 6), lane = tid & 63, wr = wid >> 2, wc = wid & 3, fr = lane & 15, fq = lane >> 4;
    const int K = g.K, nt = K / BK;
    unsigned voffA[2], voffB[2];
#pragma unroll
    for (int i = 0; i < 2; ++i) { int R, C; stage_rc(tid * 16 + i * 8192, R, C); const int Rb = Epi::PERM ? ((R & ~31) + perm32(R & 31)) : R;
        voffA[i] = (unsigned)(R * K + C) * 2u; voffB[i] = (unsigned)(Rb * K + C) * 2u; }
    const size_t kstep = (size_t)(BK * 2);
    const size_t hstep = (size_t)HALF * K * 2;
    const size_t tstep = 2 * hstep;
    const unsigned ldsw = (unsigned)wid * 1024u;
    const int aoff = lds_byte(wr * 64 + fr, fq * 8), boff = lds_byte(wc * 32 + fr, fq * 8);
#define PG8_SA(b, h) (((b) * 2 + (h)) * HTB)
#define PG8_SB(b, h) ((4 + (b) * 2 + (h)) * HTB)
#define PG8_STAGE(bufoff, gbase, voff) do { _Pragma("unroll") for (int _i = 0; _i < 2; ++_i) \
        __builtin_amdgcn_global_load_lds((const unsigned*)((const char*)(gbase) + (voff)[_i]), (PG8_LAS unsigned*)(lds + (bufoff) + ldsw + _i * 8192), 16, 0, 0); } while (0)
#define PG8_LDA(dst, b, h) do { _Pragma("unroll") for (int m = 0; m < 4; ++m) _Pragma("unroll") for (int k = 0; k < 2; ++k) dst[m][k] = *(const PG8_LAS bf16x8*)(lds + PG8_SA(b, h) + aoff + m * 2048 + k * 1024); } while (0)
#define PG8_LDB(dst, b, h) do { _Pragma("unroll") for (int n = 0; n < 2; ++n) _Pragma("unroll") for (int k = 0; k < 2; ++k) dst[n][k] = *(const PG8_LAS bf16x8*)(lds + PG8_SB(b, h) + boff + n * 2048 + k * 1024); } while (0)
#define PG8_MMA(ai, bj, At, Bt) do { __builtin_amdgcn_s_setprio(1); _Pragma("unroll") for (int m = 0; m < 4; ++m) _Pragma("unroll") for (int n = 0; n < 2; ++n) _Pragma("unroll") for (int k = 0; k < 2; ++k) \
        acc[ai][bj][m][n] = __builtin_amdgcn_mfma_f32_16x16x32_bf16(Bt[n][k], At[m][k], acc[ai][bj][m][n], 0, 0, 0); __builtin_amdgcn_s_setprio(0); } while (0)
#define PG8_WAIT_V(n) asm volatile("s_waitcnt vmcnt(" #n ")" ::: "memory")
#define PG8_WAIT_L(n) asm volatile("s_waitcnt lgkmcnt(" #n ")" ::: "memory")
#define PG8_BAR __builtin_amdgcn_s_barrier()
#define PG8_SCHED __builtin_amdgcn_sched_barrier(0)
    Unit cur, nxt; int ui = 0;
    if (!S.next(0, cur)) return;
    f32x4 acc[2][2][4][2];
#pragma unroll
    for (int a = 0; a < 2; ++a)
#pragma unroll
        for (int b = 0; b < 2; ++b)
#pragma unroll
            for (int m = 0; m < 4; ++m)
#pragma unroll
                for (int n = 0; n < 2; ++n) acc[a][b][m][n] = (f32x4){0.f, 0.f, 0.f, 0.f};
    bf16x8 At[4][2], B0[2][2], B1[2][2];
    const char* cA = (const char*)g.A + (size_t)cur.pm * tstep; const char* cB = (const char*)g.Bt + (size_t)cur.pn * tstep;
    S.a_ready(cur);
    if constexpr (SP2) {
        PG8_STAGE(PG8_SB(0, 0), cB, voffB); PG8_STAGE(PG8_SB(0, 1), cB + hstep, voffB); PG8_STAGE(PG8_SA(0, 0), cA, voffA); PG8_STAGE(PG8_SA(0, 1), cA + hstep, voffA);
        if (wr == 1) PG8_BAR;
        PG8_WAIT_V(2); PG8_BAR;
        PG8_STAGE(PG8_SB(1, 0), cB + kstep, voffB); PG8_STAGE(PG8_SA(1, 0), cA + kstep, voffA); PG8_STAGE(PG8_SB(1, 1), cB + hstep + kstep, voffB);
        PG8_WAIT_V(6); PG8_BAR;
    } else {
        PG8_STAGE(PG8_SB(0, 0), cB, voffB); PG8_STAGE(PG8_SA(0, 0), cA, voffA); PG8_STAGE(PG8_SB(0, 1), cB + hstep, voffB); PG8_STAGE(PG8_SA(0, 1), cA + hstep, voffA);
        if (wr == 1) PG8_BAR;
        PG8_WAIT_V(4); PG8_BAR;
        PG8_STAGE(PG8_SB(1, 0), cB + kstep, voffB); PG8_STAGE(PG8_SA(1, 0), cA + kstep, voffA); PG8_STAGE(PG8_SB(1, 1), cB + hstep + kstep, voffB);
        PG8_WAIT_V(6); PG8_BAR;
    }
    for (;;) {
        const bool has_next = S.next(ui + 1, nxt);
        const char* nA = has_next ? (const char*)g.A + (size_t)nxt.pm * tstep : cA; const char* nB = has_next ? (const char*)g.Bt + (size_t)nxt.pn * tstep : cB;
        for (int t = 0; t < nt; t += 2) {
            const bool last = (t == nt - 2);
            const char* a1 = cA + (size_t)(t + 1) * kstep;
            const char* a2 = last ? nA : cA + (size_t)(t + 2) * kstep; const char* b2 = last ? nB : cB + (size_t)(t + 2) * kstep;
            const char* a3 = a2 + kstep; const char* b3 = b2 + kstep;
            if (last && has_next) S.a_ready(nxt);
            if constexpr (SP2) {
            PG8_LDB(B0, 0, 0); PG8_LDB(B1, 0, 1); PG8_SCHED; PG8_LDA(At, 0, 0); PG8_STAGE(PG8_SA(1, 1), a1 + hstep, voffA);
            PG8_WAIT_V(8); PG8_WAIT_L(0); PG8_BAR; PG8_MMA(0, 0, At, B0); PG8_MMA(0, 1, At, B1); PG8_BAR; PG8_SCHED;
            PG8_LDA(At, 0, 1); PG8_STAGE(PG8_SB(0, 0), b2, voffB); PG8_STAGE(PG8_SB(0, 1), b2 + hstep, voffB); PG8_STAGE(PG8_SA(0, 0), a2, voffA);
            PG8_WAIT_V(8); PG8_WAIT_L(0); PG8_BAR; PG8_MMA(1, 0, At, B0); PG8_MMA(1, 1, At, B1); PG8_BAR; PG8_SCHED;
            PG8_LDB(B0, 1, 0); PG8_LDB(B1, 1, 1); PG8_SCHED; PG8_LDA(At, 1, 0); PG8_STAGE(PG8_SA(0, 1), a2 + hstep, voffA);
            PG8_WAIT_V(8); PG8_WAIT_L(0); PG8_BAR; PG8_MMA(0, 0, At, B0); PG8_MMA(0, 1, At, B1); PG8_BAR; PG8_SCHED;
            PG8_LDA(At, 1, 1); PG8_STAGE(PG8_SB(1, 0), b3, voffB); PG8_STAGE(PG8_SB(1, 1), b3 + hstep, voffB); PG8_STAGE(PG8_SA(1, 0), a3, voffA);
            PG8_WAIT_V(8); PG8_WAIT_L(0); PG8_BAR; PG8_MMA(1, 0, At, B0); PG8_MMA(1, 1, At, B1); PG8_BAR; PG8_SCHED;
            } else {
            PG8_LDB(B0, 0, 0); PG8_SCHED; PG8_LDA(At, 0, 0); PG8_STAGE(PG8_SA(1, 1), a1 + hstep, voffA);
            PG8_WAIT_L(8); PG8_BAR; PG8_WAIT_L(0); PG8_MMA(0, 0, At, B0); PG8_BAR; PG8_SCHED;
            PG8_LDB(B1, 0, 1); PG8_STAGE(PG8_SB(0, 0), b2, voffB);
            PG8_BAR; PG8_WAIT_L(0); PG8_MMA(0, 1, At, B1); PG8_BAR;
            PG8_LDA(At, 0, 1); PG8_STAGE(PG8_SA(0, 0), a2, voffA);
            PG8_BAR; PG8_WAIT_L(0); PG8_MMA(1, 0, At, B0); PG8_BAR; PG8_SCHED;
            PG8_STAGE(PG8_SB(0, 1), b2 + hstep, voffB);
            PG8_WAIT_V(6); PG8_BAR; PG8_MMA(1, 1, At, B1); PG8_BAR;
            PG8_LDB(B0, 1, 0); PG8_SCHED; PG8_LDA(At, 1, 0); PG8_STAGE(PG8_SA(0, 1), a2 + hstep, voffA);
            PG8_WAIT_L(8); PG8_BAR; PG8_WAIT_L(0); PG8_MMA(0, 0, At, B0); PG8_BAR; PG8_SCHED;
            PG8_LDB(B1, 1, 1); PG8_STAGE(PG8_SB(1, 0), b3, voffB);
            PG8_BAR; PG8_WAIT_L(0); PG8_MMA(0, 1, At, B1); PG8_BAR;
            PG8_LDA(At, 1, 1); PG8_STAGE(PG8_SA(1, 0), a3, voffA);
            PG8_BAR; PG8_WAIT_L(0); PG8_MMA(1, 0, At, B0); PG8_BAR; PG8_SCHED;
            PG8_STAGE(PG8_SB(1, 1), b3 + hstep, voffB);
            PG8_WAIT_V(6); PG8_BAR; PG8_MMA(1, 1, At, B1); PG8_BAR;
            }
        }
        if constexpr (ALIGN_EPI) { if (wr == 0) PG8_BAR; }
        if constexpr (!Epi::AFTER_DRAIN) { E(acc, cur, wr, wc, fr, fq); S.done(cur); }
        if (!has_next) break;
#pragma unroll
        for (int a = 0; a < 2; ++a)
#pragma unroll
            for (int b = 0; b < 2; ++b)
#pragma unroll
                for (int m = 0; m < 4; ++m)
#pragma unroll
                    for (int n = 0; n < 2; ++n) acc[a][b][m][n] = (f32x4){0.f, 0.f, 0.f, 0.f};
        cur = nxt; cA = nA; cB = nB; ++ui;
        if constexpr (ALIGN_EPI) { if (wr == 1) PG8_BAR; }
    }
    PG8_WAIT_V(0);
    if constexpr (!ALIGN_EPI) { if (wr == 0) PG8_BAR; }
    PG8_BAR;
    if constexpr (Epi::AFTER_DRAIN) { E.fused(acc, cur, wr, wc, fr, fq, lds, wid, lane); S.done(cur); }
#undef PG8_SA
#undef PG8_SB
#undef PG8_STAGE
#undef PG8_LDA
#undef PG8_LDB
#undef PG8_MMA
#undef PG8_WAIT_V
#undef PG8_WAIT_L
#undef PG8_BAR
#undef PG8_SCHED
}
}
#define GAS __attribute__((address_space(1)))
#define LAS __attribute__((address_space(3)))
typedef unsigned short bf16;
typedef unsigned v4u __attribute__((ext_vector_type(4)));
typedef float f32x4 __attribute__((ext_vector_type(4)));
typedef short bf16x8 __attribute__((ext_vector_type(8)));
typedef GAS unsigned gu32;
typedef GAS unsigned long long gu64;
#define RLX_AGENT __ATOMIC_RELAXED, __HIP_MEMORY_SCOPE_AGENT
#define LDS_WAIT() asm volatile("s_waitcnt lgkmcnt(0)" ::: "memory")
#define VM_WAIT() asm volatile("s_waitcnt vmcnt(0)" ::: "memory")
__device__ __forceinline__ unsigned long long rt() { return __builtin_amdgcn_s_memrealtime(); }
__device__ __forceinline__ unsigned f2bf(float f) { unsigned u = __builtin_bit_cast(unsigned, f); return (u + 0x7fffu + ((u >> 16) & 1u)) >> 16; }
__device__ __forceinline__ unsigned pk2(float lo, float hi) { return f2bf(lo) | (f2bf(hi) << 16); }

#define XB_TMO      128
#define XB_XCNT(j)  (256  + 64 * (j))
#define XB_XSUB(j)  (1280 + 64 * (j))
#define XB_XGEN(j)  (2304 + 64 * (j))
#define XB_TOP      3328
#define XB_TOPGEN   3392
#define XCD_BAR_WORDS 3456
#define XB_SPIN_CAP (1u << 18)

__device__ __forceinline__ unsigned xb_ld(unsigned* p)              { return __hip_atomic_load(p, __ATOMIC_RELAXED, __HIP_MEMORY_SCOPE_AGENT); }
__device__ __forceinline__ unsigned xb_add(unsigned* p, unsigned v) { return __hip_atomic_fetch_add(p, v, __ATOMIC_RELAXED, __HIP_MEMORY_SCOPE_AGENT); }
__device__ __forceinline__ unsigned xb_xcc_id() { return (unsigned)__builtin_amdgcn_s_getreg((3 << 11) | 20) & 0xFu; }
#define XB_SPIN(cond, bar) do { unsigned _sp = 0; while (cond) { __builtin_amdgcn_s_sleep(1); \
    if ((++_sp & 255u) == 0u) { if (xb_ld(&(bar)[XB_TMO])) break; if (_sp > XB_SPIN_CAP) { atomicAdd(&(bar)[XB_TMO], 1u); break; } } } } while (0)

struct XcdBarrier {
    unsigned* bar; unsigned x;
    volatile LAS unsigned* st;
};

__device__ __forceinline__ XcdBarrier xcd_barrier_post(unsigned* bar, volatile LAS unsigned* st) {
    XcdBarrier b; b.bar = bar; b.x = xb_xcc_id(); b.st = st;
    if (threadIdx.x == 0) (void)xb_add(&bar[XB_XCNT(b.x)], 1u);
    return b;
}
__device__ __forceinline__ void xcd_barrier_complete(unsigned* bar, unsigned x, unsigned& nloc, unsigned& nx) {
    const unsigned G = gridDim.x * gridDim.y * gridDim.z;
    unsigned sum, cnt, mine, sp = 0u;
    for (;;) {
        sum = 0u; cnt = 0u; mine = 0u;
#pragma unroll
        for (unsigned j = 0; j < 16; ++j) { const unsigned c = xb_ld(&bar[XB_XCNT(j)]); sum += c; cnt += (c > 0u) ? 1u : 0u; mine = (j == x) ? c : mine; }
        if (sum == G) break;
        __builtin_amdgcn_s_sleep(1);
        if ((++sp & 255u) == 0u) { if (xb_ld(&bar[XB_TMO])) break; if (sp > XB_SPIN_CAP) { atomicAdd(&bar[XB_TMO], 1u); break; } }
    }
    nloc = mine > 0u ? mine : 1u; nx = cnt > 0u ? cnt : 1u;
}

__device__ __forceinline__ void xcd_barrier(const XcdBarrier& b) {
    asm volatile("s_waitcnt vmcnt(0)" ::: "memory");
    __syncthreads();
    if (threadIdx.x == 0) {
        unsigned* bar = b.bar;
        __builtin_amdgcn_s_waitcnt(0);
        unsigned nloc = b.st[0], nx = b.st[1];
        if (nloc == 0u) { xcd_barrier_complete(bar, b.x, nloc, nx); b.st[0] = nloc; b.st[1] = nx; }
        const unsigned old = xb_add(&bar[XB_XSUB(b.x)], 1u);
        const unsigned gen = old / nloc;
        if (old + 1u == (gen + 1u) * nloc) {
            __builtin_amdgcn_fence(__ATOMIC_RELEASE, "agent");
            asm volatile("s_waitcnt vmcnt(0)" ::: "memory");
            const unsigned og = xb_add(&bar[XB_TOP], 1u);
            const unsigned tg = og / nx;
            if (og + 1u == (tg + 1u) * nx) xb_add(&bar[XB_TOPGEN], 1u);
            else XB_SPIN(xb_ld(&bar[XB_TOPGEN]) == tg, bar);
            __builtin_amdgcn_fence(__ATOMIC_ACQUIRE, "agent");
            xb_add(&bar[XB_XGEN(b.x)], 1u);
            asm volatile("s_waitcnt vmcnt(0)" ::: "memory");
        } else {
            XB_SPIN(xb_ld(&bar[XB_XGEN(b.x)]) == gen, bar);
            __builtin_amdgcn_fence(__ATOMIC_ACQUIRE, "agent");
            asm volatile("s_waitcnt vmcnt(0)" ::: "memory");
        }
    }
    __syncthreads();
}
__device__ __forceinline__ float wave_sum(float v) {
#pragma unroll
    for (int o = 1; o < 64; o <<= 1) v += __shfl_xor(v, o);
    return v;
}
__device__ __forceinline__ void p0_transpose_item(const float* W, int K, int N, bf16* WT, int row_off, LAS float* scr, int item, int lane) {
    const int nblk = N / 32, kb = item / nblk, nb = item % nblk, k0 = 64 * kb, n0 = 32 * nb;
#pragma unroll 8
    for (int i = 0; i < 32; ++i) { const int kk = 2 * i + (lane >> 5); scr[kk * 33 + (lane & 31)] = W[(size_t)(k0 + kk) * N + n0 + (lane & 31)]; }
    LDS_WAIT(); asm volatile("" ::: "memory");
    const int c = lane & 7;
#pragma unroll
    for (int j = 0; j < 4; ++j) { const int n = (lane >> 3) + 8 * j; const LAS float* s = scr + (8 * c) * 33 + n;
        v4u o; o.x = pk2(s[0 * 33], s[1 * 33]); o.y = pk2(s[2 * 33], s[3 * 33]); o.z = pk2(s[4 * 33], s[5 * 33]); o.w = pk2(s[6 * 33], s[7 * 33]);
        *(GAS v4u*)(WT + (size_t)(row_off + n0 + n) * K + k0 + 8 * c) = o; }
    LDS_WAIT(); asm volatile("" ::: "memory");
}
constexpr int NWAVES = 8;
constexpr int D = 1024, TP = 16384, TS = 1024, MT = TP + TS, MEMR = 2048, DIN = 2560, DFF = 2816, NMEM = 256;
constexpr float EPS = 1e-6f;
#ifndef MK_PER_PHASE
#define MK_PER_PHASE 0
#endif
constexpr int NPHASE = 9;
constexpr size_t MiB = 1u << 20;
constexpr size_t WS_CTL = 0, CTL_ZERO_BYTES = 64 * 1024;
constexpr size_t WS_WIN = 1 * MiB, WS_WKV = 6 * MiB, WS_WOUT = 7 * MiB, WS_WUP = 9 * MiB, WS_WDN = 20 * MiB;
constexpr size_t WS_XN = 26 * MiB;
constexpr size_t WS_XNM = 60 * MiB;
constexpr size_t WS_KVB = 64 * MiB;
constexpr size_t WS_HU = 66 * MiB, WS_HD = 82 * MiB;
constexpr size_t WS_MIX = 83 * MiB;
constexpr size_t WS_U = 117 * MiB, WS_Q = 134 * MiB, WS_LOGF = 151 * MiB, WS_KK = 185 * MiB, WS_V = 202 * MiB, WS_G = 219 * MiB, WS_QX = 236 * MiB;
constexpr size_t WS_EA = 64 * MiB, WS_EB = 68 * MiB, WS_ROWSS = 70 * MiB, WS_ROWSS_S = 72 * MiB;
constexpr size_t WS_PA = 64 * MiB, WS_PB = 158 * MiB;
constexpr size_t WS_END = 256 * MiB;
static_assert(WS_QX + (size_t)MT * 256 * 2 <= WS_END && WS_PB + (size_t)MT * DFF * 2 <= WS_END && WS_PA + (size_t)MT * DFF * 2 <= WS_PB, "d_ws map");
constexpr int CW_BAR = 4096;
constexpr int RING_BYTES = 131072, LDSCTL_OFF = RING_BYTES, MISC_OFF = LDSCTL_OFF + 320, LDS_BYTES = 147456;

struct Args { const float* in[23]; float* out; unsigned char* ws; int ph_lo, ph_hi; };
struct Frame {
    LAS unsigned char* lds; int tid, lane, wave, G;
    const float *x_prompt, *x_sample, *mem_prompt, *state_pool, *state_hgrn, *state_conv, *cache_k, *cache_v, *ln1_g, *w_in, *pool_w, *pool_scale, *lb_logits, *onorm_g, *mem_norm_g, *w_mem_kv, *w_out, *ln2_g, *w_up, *conv_w, *conv_b, *w_down, *lnf_g;
    float *y, *o_pool_p, *o_hgrn_p, *o_conv_p, *o_mk, *o_mv, *o_pool_s, *o_hgrn_s, *o_conv_s;
    bf16 *WIN, *WKV, *WOUT, *WUP, *WDN, *XN, *XNM, *KVB, *MIX, *Q, *KK, *V, *GS, *QX, *PA, *PB;
    float *U, *LOGF, *EA, *EB, *ROWSS, *ROWSS_S;
};
typedef unsigned u32x2v __attribute__((ext_vector_type(2)));
__device__ __forceinline__ float bf2f(bf16 h) { return __builtin_bit_cast(float, (unsigned)h << 16); }
__device__ __forceinline__ float frcp_(float x) { return __builtin_amdgcn_rcpf(x); }
__device__ __forceinline__ float wave_max(float v) {
#pragma unroll
    for (int o = 1; o < 64; o <<= 1) v = fmaxf(v, __shfl_xor(v, o));
    return v;
}
__device__ __forceinline__ void rms_row_to_bf16(int lane, const float* xrow, const float* g, bf16* orow) {
    const GAS f32x4* xr = (const GAS f32x4*)xrow + lane; const GAS f32x4* gr = (const GAS f32x4*)g + lane;
    f32x4 v[4]; float s = 0.f;
#pragma unroll
    for (int j = 0; j < 4; ++j) { v[j] = xr[64 * j]; s += (v[j].x * v[j].x + v[j].y * v[j].y) + (v[j].z * v[j].z + v[j].w * v[j].w); }
    const float rstd = 1.f / sqrtf(wave_sum(s) * (1.f / D) + EPS);
    GAS unsigned long long* o8 = (GAS unsigned long long*)orow + lane;
#pragma unroll
    for (int j = 0; j < 4; ++j) { const f32x4 gg = gr[64 * j]; o8[64 * j] = (unsigned long long)pk2(v[j].x * rstd * gg.x, v[j].y * rstd * gg.y) | ((unsigned long long)pk2(v[j].z * rstd * gg.z, v[j].w * rstd * gg.w) << 32); }
}
__device__ __forceinline__ void p0_transpose_item2(const float* W, int K, int N, bf16* WT, int dst_row0, const float* gain, LAS float* scr, int kb, int nb, int lane) {
    const int k0 = 64 * kb, n0 = 32 * nb;
#pragma unroll 8
    for (int i = 0; i < 32; ++i) { const int kk = 2 * i + (lane >> 5); scr[kk * 33 + (lane & 31)] = W[(size_t)(k0 + kk) * N + n0 + (lane & 31)]; }
    LDS_WAIT(); asm volatile("" ::: "memory");
    const int c = lane & 7; float gg[8];
#pragma unroll
    for (int e = 0; e < 8; ++e) gg[e] = gain[k0 + 8 * c + e];
#pragma unroll
    for (int j = 0; j < 4; ++j) { const int n = (lane >> 3) + 8 * j; const LAS float* s = scr + (8 * c) * 33 + n;
        v4u o; o.x = pk2(s[0 * 33] * gg[0], s[1 * 33] * gg[1]); o.y = pk2(s[2 * 33] * gg[2], s[3 * 33] * gg[3]); o.z = pk2(s[4 * 33] * gg[4], s[5 * 33] * gg[5]); o.w = pk2(s[6 * 33] * gg[6], s[7 * 33] * gg[7]);
        *(GAS v4u*)(WT + (size_t)(dst_row0 + n) * K + k0 + 8 * c) = o; }
    LDS_WAIT(); asm volatile("" ::: "memory");
}
__device__ __forceinline__ void p0_prologue(Frame& F) {
    LAS float* scr = (LAS float*)(F.lds + F.wave * 16384);
    const int gw = blockIdx.x * NWAVES + F.wave, NGW = F.G * NWAVES;
    constexpr int I_IN = (D / 64) * (DIN / 32), I_KV = (D / 64) * (512 / 32);
    for (int it = gw; it < I_IN + I_KV; it += NGW) {
        if (it < I_IN) p0_transpose_item(F.w_in, D, DIN, F.WIN, 0, scr, it, F.lane);
        else p0_transpose_item(F.w_mem_kv, D, 512, F.WKV, 0, scr, it - I_IN, F.lane);
    }
    for (int m = gw; m < MT + MEMR; m += NGW) {
        if (m < TP) rms_row_to_bf16(F.lane, F.x_prompt + (size_t)m * D, F.ln1_g, F.XN + (size_t)m * D);
        else if (m < MT) rms_row_to_bf16(F.lane, F.x_sample + (size_t)(m - TP) * D, F.ln1_g, F.XN + (size_t)m * D);
        else rms_row_to_bf16(F.lane, F.mem_prompt + (size_t)(m - MT) * D, F.mem_norm_g, F.XNM + (size_t)(m - MT) * D);
    }
}
__device__ __forceinline__ void p0_late(Frame& F, int gw, int NGW) {
    LAS float* scr = (LAS float*)(F.lds + F.wave * 16384);
    constexpr int I_OUT = (D / 64) * (D / 32), I_UP = (D / 64) * (2 * DFF / 32), I_DN = (DFF / 64) * (D / 32);
    for (int it = gw; it < I_OUT + I_UP + I_DN; it += NGW) {
        int r = it;
        if (r < I_OUT) { if (r >= 4 * (D / 32)) p0_transpose_item(F.w_out, D, D, F.WOUT, 0, scr, r, F.lane); continue; } r -= I_OUT;
        if (r < I_UP) { const int nblk = 2 * DFF / 32, kb = r / nblk, nb = r % nblk, n0 = 32 * nb, j = n0 < DFF ? n0 : n0 - DFF;
            p0_transpose_item2(F.w_up, D, 2 * DFF, F.WUP, (j >> 7) * 256 + (j & 127) + (n0 < DFF ? 0 : 128), F.ln2_g, scr, kb, nb, F.lane); continue; } r -= I_UP;
        p0_transpose_item(F.w_down, DFF, D, F.WDN, 0, scr, r, F.lane);
    }
    for (int it = gw; it < 2048; it += NGW) { const int g = it >> 9, c2 = (it >> 4) & 31, n = (it & 15) * 64 + F.lane;
        const float* p0 = F.pool_w + (size_t)g * 4096 + (2 * c2) * 64; const float* p1 = p0 + 64; float o0 = 0.f, o1 = 0.f;
#pragma unroll
        for (int dd = 0; dd < 64; ++dd) { const float sw = F.pool_scale[64 * g + dd] * F.w_out[(size_t)(64 * g + dd) * D + n]; o0 += p0[dd] * sw; o1 += p1[dd] * sw; }
        *(GAS unsigned*)(F.WOUT + (size_t)n * D + 64 * g + 2 * c2) = pk2(o0, o1); }
}
__device__ __forceinline__ void pool_phase(Frame& F) {
    const int total = (MT / 8) * 64;
    for (int i = blockIdx.x * 512 + F.tid; i < total; i += F.G * 512) {
        const int r0 = (i >> 6) * 8, c = (i & 63) * 4, g = c >> 6; const bool smp = r0 >= TP; const int rr = smp ? r0 - TP : r0; const int b = smp ? rr >> 3 : rr >> 11, t0 = smp ? 0 : rr & 2047;
        const float* ub = F.U + (size_t)(r0 - t0) * 256 + c;
        f32x4 x[23];
#pragma unroll
        for (int k = 0; k < 23; ++k) { const int tau = t0 - 15 + k;
            if (tau >= 0) x[k] = *(const GAS f32x4*)(ub + (size_t)tau * 256); else if (smp) x[k] = *(const GAS f32x4*)(F.state_pool + ((size_t)b * 15 + 15 + tau) * 256 + c); else x[k] = (f32x4){0.f, 0.f, 0.f, 0.f}; }
        f32x4 s2[23], s4[23], s8[23], s16[8];
#pragma unroll
        for (int k = 1; k < 23; ++k) s2[k] = x[k] + x[k - 1];
#pragma unroll
        for (int k = 3; k < 23; ++k) s4[k] = s2[k] + s2[k - 2];
#pragma unroll
        for (int k = 7; k < 23; ++k) s8[k] = s4[k] + s4[k - 4];
#pragma unroll
        for (int k = 0; k < 8; ++k) s16[k] = s8[15 + k] + s8[7 + k];
        const float wf = (float)(2 << g);
#pragma unroll
        for (int k = 0; k < 8; ++k) { const int t = t0 + k;
            const f32x4 s = g == 0 ? s2[15 + k] : g == 1 ? s4[15 + k] : g == 2 ? s8[15 + k] : s16[k];
            const float cnt = smp ? wf : fminf(wf, (float)(t + 1));
            const f32x4 dd = s * (1.f / cnt) - x[15 + k];
            *(GAS u32x2v*)(F.MIX + (size_t)(r0 + k) * D + c) = (u32x2v){pk2(dd[0], dd[1]), pk2(dd[2], dd[3])}; }
        if (smp || t0 == 2040) { float* np = (smp ? F.o_pool_s : F.o_pool_p) + (size_t)b * 15 * 256 + c;
#pragma unroll
            for (int k = 0; k < 15; ++k) *(GAS f32x4*)(np + k * 256) = x[8 + k]; }
    }
}
__device__ __forceinline__ void hgrn_naive_phase(Frame& F) {
    LAS float* qs = (LAS float*)F.lds; LAS float* fs = qs + 128; LAS float* ks = fs + 128; LAS float* part = ks + 128; LAS float* red = part + 512;
    const int tid = F.tid, dv = tid & 127, qd = tid >> 7;
    for (int u = blockIdx.x; u < 32 + 512; u += F.G) {
        const bool smp = u >= 32; const int bh = smp ? u - 32 : u, b = bh >> 2, h = bh & 3, L = smp ? 8 : 2048, row0 = smp ? TP + b * 8 : b * 2048;
        float S[32];
#pragma unroll
        for (int j = 0; j < 32; ++j) S[j] = smp ? F.state_hgrn[(((size_t)b * 4 + h) * 128 + qd * 32 + j) * 128 + dv] : 0.f;
        for (int t = 0; t < L; ++t) {
            const size_t ro = (size_t)(row0 + t) * 512 + h * 128;
            if (tid < 128) { qs[tid] = bf2f(F.Q[ro + tid]); fs[tid] = __expf(F.LOGF[ro + tid]); ks[tid] = bf2f(F.KK[ro + tid]); }
            const float v = bf2f(F.V[ro + dv]);
            __syncthreads();
            float op = 0.f;
#pragma unroll
            for (int j = 0; j < 32; ++j) { const int dk = qd * 32 + j; S[j] = fs[dk] * S[j] + ks[dk] * v; op += qs[dk] * S[j]; }
            part[qd * 128 + dv] = op;
            __syncthreads();
            const float o = (part[dv] + part[128 + dv]) + (part[256 + dv] + part[384 + dv]);
            const float ss = wave_sum(o * o);
            if (F.lane == 0) red[F.wave] = ss;
            __syncthreads();
            if (qd == 0) { const float tot = red[0] + red[1];
                F.MIX[(size_t)(row0 + t) * D + 256 + h * 128 + dv] = (bf16)f2bf(o * (1.f / sqrtf(tot * (1.f / 128.f) + EPS)) * F.onorm_g[h * 128 + dv] * bf2f(F.GS[ro + dv])); }
        }
        float* so = (smp ? F.o_hgrn_s : F.o_hgrn_p) + ((size_t)b * 4 + h) * 128 * 128;
#pragma unroll
        for (int j = 0; j < 32; ++j) so[(size_t)(qd * 32 + j) * 128 + dv] = S[j];
        __syncthreads();
    }
}
__device__ __forceinline__ void xattn_naive_phase(Frame& F) {
    const int half = F.tid >> 8, t2 = F.tid & 255, wv = t2 >> 6;
    LAS float* q = (LAS float*)F.lds + half * 1024; LAS float* p = q + 64; LAS float* red = p + 256; LAS float* po = red + 8;
    for (int it = blockIdx.x; it < MT * 2; it += F.G) {
        const int item = it * 2 + half, r = item >> 2, h = item & 3; const bool smp = r >= TP; const int b = smp ? (r - TP) >> 3 : r >> 11;
        if (t2 < 64) q[t2] = bf2f(F.QX[(size_t)r * 256 + h * 64 + t2]);
        __syncthreads();
        float s = 0.f;
        if (smp) { const float* kr = F.cache_k + ((size_t)b * NMEM + t2) * 256 + h * 64; for (int d = 0; d < 64; ++d) s += q[d] * kr[d]; }
        else { const bf16* kr = F.KVB + ((size_t)b * NMEM + t2) * 512 + h * 64; for (int d = 0; d < 64; ++d) s += q[d] * bf2f(kr[d]); }
        float m = wave_max(s);
        if (F.lane == 0) red[wv] = m;
        __syncthreads();
        m = fmaxf(fmaxf(red[0], red[1]), fmaxf(red[2], red[3]));
        const float e = exp2f(s - m);
        p[t2] = e;
        float sum = wave_sum(e);
        __syncthreads();
        if (F.lane == 0) red[wv] = sum;
        __syncthreads();
        sum = (red[0] + red[1]) + (red[2] + red[3]);
        const int d = t2 & 63, pt = t2 >> 6; float o = 0.f;
        if (smp) { for (int mm = pt * 64; mm < pt * 64 + 64; ++mm) o += p[mm] * F.cache_v[((size_t)b * NMEM + mm) * 256 + h * 64 + d]; }
        else { for (int mm = pt * 64; mm < pt * 64 + 64; ++mm) o += p[mm] * bf2f(F.KVB[((size_t)b * NMEM + mm) * 512 + 256 + h * 64 + d]); }
        po[pt * 64 + d] = o;
        __syncthreads();
        if (t2 < 64) F.MIX[(size_t)r * D + 768 + h * 64 + t2] = (bf16)f2bf(((po[t2] + po[64 + t2]) + (po[128 + t2] + po[192 + t2])) / sum);
        __syncthreads();
    }
}
__device__ __forceinline__ void norm2_phase(Frame& F) {
    const int gw = blockIdx.x * NWAVES + F.wave, NGW = F.G * NWAVES;
    for (int m = gw; m < MT; m += NGW) rms_row_to_bf16(F.lane, F.y + (size_t)m * D, F.ln2_g, F.XN + (size_t)m * D);
}
__device__ __forceinline__ void final_norm_phase(Frame& F) {
    const int gw = blockIdx.x * NWAVES + F.wave, NGW = F.G * NWAVES;
    for (int m = gw; m < MT; m += NGW) {
        GAS f32x4* xr = (GAS f32x4*)(F.y + (size_t)m * D) + F.lane; const GAS f32x4* gr = (const GAS f32x4*)F.lnf_g + F.lane;
        f32x4 v[4]; float s = 0.f;
#pragma unroll
        for (int j = 0; j < 4; ++j) { v[j] = xr[64 * j]; s += (v[j].x * v[j].x + v[j].y * v[j].y) + (v[j].z * v[j].z + v[j].w * v[j].w); }
        const float rstd = 1.f / sqrtf(wave_sum(s) * (1.f / D) + EPS);
#pragma unroll
        for (int j = 0; j < 4; ++j) xr[64 * j] = v[j] * rstd * gr[64 * j];
    }
}
__device__ __forceinline__ float gelu_tanh(float x) { const float u2 = 1.5957691216057308f * (x + 0.044715f * x * x * x); return x * frcp_(1.f + __expf(-u2)); }
__device__ __forceinline__ void conv_fixup_phase(Frame& F) {
    const int total = 56 * 2 * (DFF / 4);
    for (int i = blockIdx.x * 512 + F.tid; i < total; i += F.G * 512) {
        const int j = (i % (DFF / 4)) * 4, k = (i / (DFF / 4)) & 1, q = i / (DFF / 2), pm = (q / 7) * 8 + 1 + (q % 7);
        const f32x4 a0 = *(const GAS f32x4*)(F.EA + ((size_t)pm * 4 + k) * DFF + j);
        const f32x4 a1 = k == 0 ? *(const GAS f32x4*)(F.EA + ((size_t)(pm - 1) * 4 + 3) * DFF + j) : *(const GAS f32x4*)(F.EA + ((size_t)pm * 4 + 0) * DFF + j);
        const f32x4 a2 = k == 0 ? *(const GAS f32x4*)(F.EA + ((size_t)(pm - 1) * 4 + 2) * DFF + j) : *(const GAS f32x4*)(F.EA + ((size_t)(pm - 1) * 4 + 3) * DFF + j);
        const f32x4 bv = *(const GAS f32x4*)(F.EB + ((size_t)pm * 2 + k) * DFF + j);
        const f32x4 cb = *(const GAS f32x4*)(F.conv_b + j), w0 = *(const GAS f32x4*)(F.conv_w + j), w1 = *(const GAS f32x4*)(F.conv_w + DFF + j), w2 = *(const GAS f32x4*)(F.conv_w + 2 * DFF + j);
        float h[4];
#pragma unroll
        for (int e = 0; e < 4; ++e) h[e] = gelu_tanh(cb[e] + w0[e] * a2[e] + w1[e] * a1[e] + w2[e] * a0[e]) * bv[e];
        *(GAS u32x2v*)(F.PB + (size_t)(pm * 256 + k) * DFF + j) = (u32x2v){pk2(h[0], h[1]), pk2(h[2], h[3])};
    }
}
__device__ __forceinline__ void conv_phase(Frame& F) {
    const int total = MT * (DFF / 8);
    for (int i = blockIdx.x * 512 + F.tid; i < total; i += F.G * 512) {
        const int r = i / (DFF / 8), j0 = (i % (DFF / 8)) * 8; const bool smp = r >= TP; const int rr = smp ? r - TP : r; const int b = smp ? rr >> 3 : rr >> 11, t = smp ? rr & 7 : rr & 2047, L = smp ? 8 : 2048;
        const v4u a0p = *(const GAS v4u*)(F.PA + (size_t)r * DFF + j0); const v4u bp = *(const GAS v4u*)(F.PB + (size_t)r * DFF + j0);
        float a0[8], a1[8], a2[8], bb[8];
#pragma unroll
        for (int e = 0; e < 4; ++e) { a0[2 * e] = __builtin_bit_cast(float, a0p[e] << 16); a0[2 * e + 1] = __builtin_bit_cast(float, a0p[e] & 0xffff0000u); bb[2 * e] = __builtin_bit_cast(float, bp[e] << 16); bb[2 * e + 1] = __builtin_bit_cast(float, bp[e] & 0xffff0000u); }
        if (t >= 1) { const v4u p = *(const GAS v4u*)(F.PA + (size_t)(r - 1) * DFF + j0);
#pragma unroll
            for (int e = 0; e < 4; ++e) { a1[2 * e] = __builtin_bit_cast(float, p[e] << 16); a1[2 * e + 1] = __builtin_bit_cast(float, p[e] & 0xffff0000u); } }
        else {
#pragma unroll
            for (int e = 0; e < 8; ++e) a1[e] = smp ? F.state_conv[((size_t)b * 2 + 1) * DFF + j0 + e] : 0.f; }
        if (t >= 2) { const v4u p = *(const GAS v4u*)(F.PA + (size_t)(r - 2) * DFF + j0);
#pragma unroll
            for (int e = 0; e < 4; ++e) { a2[2 * e] = __builtin_bit_cast(float, p[e] << 16); a2[2 * e + 1] = __builtin_bit_cast(float, p[e] & 0xffff0000u); } }
        else {
#pragma unroll
            for (int e = 0; e < 8; ++e) a2[e] = smp ? F.state_conv[((size_t)b * 2 + t) * DFF + j0 + e] : 0.f; }
        float h[8];
#pragma unroll
        for (int e = 0; e < 8; ++e) { const int j = j0 + e; const float c = F.conv_b[j] + F.conv_w[j] * a2[e] + F.conv_w[DFF + j] * a1[e] + F.conv_w[2 * DFF + j] * a0[e]; h[e] = gelu_tanh(c) * bb[e]; }
        v4u o; o.x = pk2(h[0], h[1]); o.y = pk2(h[2], h[3]); o.z = pk2(h[4], h[5]); o.w = pk2(h[6], h[7]);
        *(GAS v4u*)(F.PB + (size_t)r * DFF + j0) = o;
        if (t == L - 1) { float* nc = (smp ? F.o_conv_s : F.o_conv_p) + (size_t)b * 2 * DFF + j0;
#pragma unroll
            for (int e = 0; e < 8; ++e) { nc[e] = a1[e]; nc[DFF + e] = a0[e]; } }
    }
}
__device__ __forceinline__ int sw512(int row, int ch) { return row * 512 + ((ch ^ (row & 15)) << 4); }
__device__ __forceinline__ int sw256(int row, int ch) { return row * 256 + ((ch ^ (row & 15)) << 4); }
__device__ __forceinline__ int sw128(int row, int ch) { return row * 128 + ((ch ^ ((row >> 1) & 7)) << 4); }
__device__ __forceinline__ bf16x8 ldfrag(const LAS unsigned char* p) { return *(const LAS bf16x8*)p; }
__device__ __forceinline__ f32x4 mma16(bf16x8 a, bf16x8 b, f32x4 c) { return __builtin_amdgcn_mfma_f32_16x16x32_bf16(a, b, c, 0, 0, 0); }
constexpr int HG_NU = 8 * 4 * 8;
constexpr float A_CLAMP = -80.f;

__device__ __forceinline__ int sw512b(int row, int ch) { return row * 512 + ((ch ^ ((row ^ (row >> 3)) & 15)) << 4); }
__device__ __forceinline__ void hgrn_passA(Frame& F, f32x4* HU, float* HD) {
    LAS unsigned char* KT = F.lds;
    LAS unsigned char* VT = F.lds + 65536;
    LAS float* segtot = (LAS float*)F.lds;
    const int tid = F.tid, c8 = tid & 15, tq = tid >> 4, w = F.wave, lane = F.lane, l15 = lane & 15, lq = lane >> 4;
    for (int u = blockIdx.x; u < HG_NU; u += F.G) {
        const int sc = u & 7, bh = u >> 3, b = bh >> 2, h = bh & 3;
        const size_t rbase = (size_t)(b * 2048 + sc * 256 + tq * 8) * 512 + h * 128 + 8 * c8;
        f32x4 lf[8][2]; v4u kq[8], vq[8];
#pragma unroll
        for (int i = 0; i < 8; ++i) { lf[i][0] = *(const GAS f32x4*)(F.LOGF + rbase + (size_t)i * 512); lf[i][1] = *(const GAS f32x4*)(F.LOGF + rbase + (size_t)i * 512 + 4);
            kq[i] = *(const GAS v4u*)(F.KK + rbase + (size_t)i * 512); }
#pragma unroll
        for (int i = 1; i < 8; ++i) { lf[i][0] += lf[i - 1][0]; lf[i][1] += lf[i - 1][1]; }
        *(LAS f32x4*)(segtot + tq * 128 + 8 * c8) = lf[7][0]; *(LAS f32x4*)(segtot + tq * 128 + 8 * c8 + 4) = lf[7][1];
        __syncthreads();
        f32x4 off[2] = {(f32x4){0.f, 0.f, 0.f, 0.f}, (f32x4){0.f, 0.f, 0.f, 0.f}}, aend[2] = {(f32x4){0.f, 0.f, 0.f, 0.f}, (f32x4){0.f, 0.f, 0.f, 0.f}};
#pragma unroll 8
        for (int s2 = 0; s2 < 32; ++s2) { const f32x4 t0 = *(const LAS f32x4*)(segtot + s2 * 128 + 8 * c8), t1 = *(const LAS f32x4*)(segtot + s2 * 128 + 8 * c8 + 4);
            aend[0] += t0; aend[1] += t1; if (s2 < tq) { off[0] += t0; off[1] += t1; } }
        __syncthreads();
        if (tq == 0) { f32x4 d0, d1;
#pragma unroll
            for (int e = 0; e < 4; ++e) { d0[e] = __expf(aend[0][e]); d1[e] = __expf(aend[1][e]); }
            *(GAS f32x4*)(HD + (size_t)u * 128 + 8 * c8) = d0; *(GAS f32x4*)(HD + (size_t)u * 128 + 8 * c8 + 4) = d1; }
#pragma unroll
        for (int jh = 0; jh < 2; ++jh) {
            unsigned ke[4][4];
#pragma unroll
            for (int i = 0; i < 8; ++i)
#pragma unroll
                for (int jj = 0; jj < 4; ++jj) { const int j = 4 * jh + jj; const float kk = __builtin_bit_cast(float, (j & 1) ? (kq[i][j >> 1] & 0xffff0000u) : (kq[i][j >> 1] << 16));
                    const float ev = kk * __expf(aend[jh][jj] - (off[jh][jj] + lf[i][jh][jj])); const unsigned bits = f2bf(ev);
                    if (i & 1) ke[jj][i >> 1] |= bits << 16; else ke[jj][i >> 1] = bits; }
#pragma unroll
            for (int jj = 0; jj < 4; ++jj) *(LAS v4u*)(KT + sw512b(8 * c8 + 4 * jh + jj, tq)) = (v4u){ke[jj][0], ke[jj][1], ke[jj][2], ke[jj][3]};
            __builtin_amdgcn_sched_barrier(0);
            if (jh == 0) {
#pragma unroll
                for (int i = 0; i < 8; ++i) vq[i] = *(const GAS v4u*)(F.V + rbase + (size_t)i * 512);
            }
        }
#pragma unroll
        for (int j = 0; j < 8; ++j) {
            unsigned vv[4];
#pragma unroll
            for (int p = 0; p < 4; ++p) { const unsigned lo = (j & 1) ? (vq[2 * p][j >> 1] >> 16) : (vq[2 * p][j >> 1] & 0xffffu), hi = (j & 1) ? (vq[2 * p + 1][j >> 1] & 0xffff0000u) : (vq[2 * p + 1][j >> 1] << 16); vv[p] = lo | hi; }
            *(LAS v4u*)(VT + sw512b(8 * c8 + j, tq)) = (v4u){vv[0], vv[1], vv[2], vv[3]}; }
        __syncthreads();
        f32x4 acc[8];
#pragma unroll
        for (int n = 0; n < 8; ++n) acc[n] = (f32x4){0.f, 0.f, 0.f, 0.f};
#pragma unroll
        for (int ks = 0; ks < 8; ++ks) {
            const bf16x8 af = ldfrag(KT + sw512b(16 * w + l15, 4 * ks + lq));
#pragma unroll
            for (int n = 0; n < 8; ++n) acc[n] = mma16(af, ldfrag(VT + sw512b(16 * n + l15, 4 * ks + lq)), acc[n]);
        }
#pragma unroll
        for (int n = 0; n < 8; ++n) HU[(((size_t)u * 8 + w) * 8 + n) * 64 + lane] = acc[n];
        __syncthreads();
    }
}

#define PC_LOAD_LF(LF, ckk) do { const size_t rb_ = (size_t)(b * 2048 + sc * 256 + (ckk) * 64 + seg * 16) * 512 + h * 128 + c; \
    _Pragma("unroll") for (int i = 0; i < 16; ++i) LF[i] = F.LOGF[rb_ + (size_t)i * 512]; } while (0)
#define PC_LOAD_QKV(QQ, KQ, VQ, ckk) do { const size_t rb_ = (size_t)(b * 2048 + sc * 256 + (ckk) * 64 + seg * 16) * 512 + h * 128 + c; \
    _Pragma("unroll") for (int i = 0; i < 16; ++i) { QQ[i] = F.Q[rb_ + (size_t)i * 512]; KQ[i] = F.KK[rb_ + (size_t)i * 512]; VQ[i] = F.V[rb_ + (size_t)i * 512]; } } while (0)
#define PC_CHUNK(ck, LF, QQ, KQ, VQ, NLF, NQQ, NKQ, NVQ) do { \
    const int trow0 = b * 2048 + sc * 256 + (ck) * 64; \
    _Pragma("unroll") for (int n = 0; n < 8; ++n) { const int dv = 16 * n + l15; *(LAS u32x2v*)(ST + sw256(dv, 2 * w + (lq >> 1)) + 8 * (lq & 1)) = (u32x2v){pk2(S[n][0], S[n][1]), pk2(S[n][2], S[n][3])}; } \
    float a[16]; { float run = 0.f; _Pragma("unroll") for (int i = 0; i < 16; ++i) { run += LF[i]; a[i] = run; } } \
    segtot[seg * 128 + c] = a[15]; \
    __syncthreads(); \
    float off = 0.f, aend = 0.f; \
    _Pragma("unroll") for (int s2 = 0; s2 < 4; ++s2) { const float v_ = segtot[s2 * 128 + c]; aend += v_; if (s2 < seg) off += v_; } \
    if (seg == 0) AE[c] = aend; \
    unsigned ke[8], vv[8]; \
    _Pragma("unroll") for (int i = 0; i < 16; ++i) { \
        const float At = fmaxf(off + a[i], A_CLAMP); const float q = bf2f(QQ[i]), k = bf2f(KQ[i]); \
        const float eA = __expf(At), eN = __expf(-At), eE = __expf(aend - (off + a[i])); const int t = seg * 16 + i; \
        *(LAS bf16*)(QA + sw256(t, c >> 3) + 2 * (c & 7)) = (bf16)f2bf(q * eA); *(LAS bf16*)(KA + sw256(t, c >> 3) + 2 * (c & 7)) = (bf16)f2bf(k * eN); \
        const unsigned kev = f2bf(k * eE), vvv = (unsigned)VQ[i]; \
        if (i & 1) { ke[i >> 1] |= kev << 16; vv[i >> 1] |= vvv << 16; } else { ke[i >> 1] = kev; vv[i >> 1] = vvv; } } \
    *(LAS v4u*)(KET + sw128(c, 2 * seg)) = (v4u){ke[0], ke[1], ke[2], ke[3]}; *(LAS v4u*)(KET + sw128(c, 2 * seg + 1)) = (v4u){ke[4], ke[5], ke[6], ke[7]}; \
    *(LAS v4u*)(VT + sw128(c, 2 * seg)) = (v4u){vv[0], vv[1], vv[2], vv[3]}; *(LAS v4u*)(VT + sw128(c, 2 * seg + 1)) = (v4u){vv[4], vv[5], vv[6], vv[7]}; \
    __syncthreads(); \
    _Pragma("unroll") for (int j = 0; j < 2; ++j) { const int sb = 2 * wh + j; f32x4 p = (f32x4){0.f, 0.f, 0.f, 0.f}; \
        if (sb <= tb) { _Pragma("unroll") for (int ks = 0; ks < 4; ++ks) p = mma16(ldfrag(QA + sw256(16 * tb + l15, 4 * ks + lq)), ldfrag(KA + sw256(16 * sb + l15, 4 * ks + lq)), p); } \
        _Pragma("unroll") for (int i = 0; i < 4; ++i) { const int t = 16 * tb + 4 * lq + i, s = 16 * sb + l15; const float pv = (s <= t) ? p[i] : 0.f; \
            *(LAS bf16*)(PS + sw128(t, s >> 3) + 2 * (s & 7)) = (bf16)f2bf(pv); } } \
    __syncthreads(); \
    bf16 gq[4][4]; \
    _Pragma("unroll") for (int i = 0; i < 4; ++i) _Pragma("unroll") for (int n = 0; n < 4; ++n) gq[i][n] = F.GS[(size_t)(trow0 + 16 * tb + 4 * lq + i) * 512 + h * 128 + 16 * (4 * wh + n) + l15]; \
    f32x4 o[4]; \
    _Pragma("unroll") for (int n = 0; n < 4; ++n) o[n] = (f32x4){0.f, 0.f, 0.f, 0.f}; \
    _Pragma("unroll") for (int ks = 0; ks < 2; ++ks) { const bf16x8 af = ldfrag(PS + sw128(16 * tb + l15, 4 * ks + lq)); \
        _Pragma("unroll") for (int n = 0; n < 4; ++n) o[n] = mma16(af, ldfrag(VT + sw128(16 * (4 * wh + n) + l15, 4 * ks + lq)), o[n]); } \
    _Pragma("unroll") for (int ks = 0; ks < 4; ++ks) { const bf16x8 af = ldfrag(QA + sw256(16 * tb + l15, 4 * ks + lq)); \
        _Pragma("unroll") for (int n = 0; n < 4; ++n) o[n] = mma16(af, ldfrag(ST + sw256(16 * (4 * wh + n) + l15, 4 * ks + lq)), o[n]); } \
    if ((ck) < 3) { const f32x4 d4 = *(const LAS f32x4*)(AE + 16 * w + 4 * lq); f32x4 dc; \
        _Pragma("unroll") for (int i = 0; i < 4; ++i) dc[i] = __expf(d4[i]); \
        _Pragma("unroll") for (int n = 0; n < 8; ++n) S[n] = S[n] * dc; \
        _Pragma("unroll") for (int ks = 0; ks < 2; ++ks) { const bf16x8 af = ldfrag(KET + sw128(16 * w + l15, 4 * ks + lq)); \
            _Pragma("unroll") for (int n = 0; n < 8; ++n) S[n] = mma16(af, ldfrag(VT + sw128(16 * n + l15, 4 * ks + lq)), S[n]); } } \
    if ((ck) < 3) { PC_LOAD_LF(NLF, (ck) + 1); PC_LOAD_QKV(NQQ, NKQ, NVQ, (ck) + 1); } \
    f32x4 ss = (f32x4){0.f, 0.f, 0.f, 0.f}; \
    _Pragma("unroll") for (int n = 0; n < 4; ++n) ss += o[n] * o[n]; \
    _Pragma("unroll") for (int i = 0; i < 4; ++i) { float v_ = ss[i]; v_ += __shfl_xor(v_, 1); v_ += __shfl_xor(v_, 2); v_ += __shfl_xor(v_, 4); v_ += __shfl_xor(v_, 8); ss[i] = v_; } \
    if (l15 == 0) { _Pragma("unroll") for (int i = 0; i < 4; ++i) RS[(16 * tb + 4 * lq + i) * 2 + wh] = ss[i]; } \
    __syncthreads(); \
    _Pragma("unroll") for (int i = 0; i < 4; ++i) { const int t = 16 * tb + 4 * lq + i; const float tot = RS[t * 2] + RS[t * 2 + 1]; const float rs = 1.f / sqrtf(tot * (1.f / 128.f) + EPS); \
        const size_t r = (size_t)(trow0 + t); \
        _Pragma("unroll") for (int n = 0; n < 4; ++n) { const int dv = 16 * (4 * wh + n) + l15; \
            F.MIX[r * D + 256 + h * 128 + dv] = (bf16)f2bf(o[n][i] * rs * og[n] * bf2f(gq[i][n])); } } \
  } while (0)
__device__ __forceinline__ void hgrn_passC(Frame& F, const f32x4* HU, const float* HD) {
    LAS unsigned char* QA = F.lds;
    LAS unsigned char* KA = F.lds + 16384;
    LAS unsigned char* KET = F.lds + 32768;
    LAS unsigned char* VT = F.lds + 49152;
    LAS unsigned char* PS = F.lds + 65536;
    LAS unsigned char* ST = F.lds + 73728;
    LAS float* AE = (LAS float*)(F.lds + 106496);
    LAS float* segtot = AE + 128;
    LAS float* RS = segtot + 512;
    const int tid = F.tid, c = tid & 127, seg = tid >> 7, w = F.wave, lane = F.lane, l15 = lane & 15, lq = lane >> 4;
    const int tb = w >> 1, wh = w & 1;
    for (int u = blockIdx.x; u < HG_NU; u += F.G) {
        const int sc = u & 7, bh = u >> 3, b = bh >> 2, h = bh & 3;
        float lfA[16], lfB[16]; bf16 qA_[16], kA_[16], vA_[16], qB_[16], kB_[16], vB_[16];
        PC_LOAD_LF(lfA, 0); PC_LOAD_QKV(qA_, kA_, vA_, 0);
        float og[4];
#pragma unroll
        for (int n = 0; n < 4; ++n) og[n] = F.onorm_g[h * 128 + 16 * (4 * wh + n) + l15];
        f32x4 S[8];
#pragma unroll
        for (int n = 0; n < 8; ++n) S[n] = (f32x4){0.f, 0.f, 0.f, 0.f};
        for (int p = 0; p < sc; ++p) { const int up = (bh << 3) + p; const f32x4 d4 = *(const f32x4*)(HD + (size_t)up * 128 + 16 * w + 4 * lq);
#pragma unroll
            for (int n = 0; n < 8; ++n) S[n] = S[n] * d4 + HU[(((size_t)up * 8 + w) * 8 + n) * 64 + lane]; }
        if (sc == 7) { const f32x4 d4 = *(const f32x4*)(HD + (size_t)u * 128 + 16 * w + 4 * lq); float* so = F.o_hgrn_p + (size_t)bh * 128 * 128;
#pragma unroll
            for (int n = 0; n < 8; ++n) { const f32x4 fin = S[n] * d4 + HU[(((size_t)u * 8 + w) * 8 + n) * 64 + lane];
#pragma unroll
                for (int i = 0; i < 4; ++i) so[(size_t)(16 * w + 4 * lq + i) * 128 + 16 * n + l15] = fin[i]; } }
        PC_CHUNK(0, lfA, qA_, kA_, vA_, lfB, qB_, kB_, vB_);
        PC_CHUNK(1, lfB, qB_, kB_, vB_, lfA, qA_, kA_, vA_);
        PC_CHUNK(2, lfA, qA_, kA_, vA_, lfB, qB_, kB_, vB_);
        PC_CHUNK(3, lfB, qB_, kB_, vB_, lfA, qA_, kA_, vA_);
        __syncthreads();
    }
}
#undef PC_LOAD_LF
#undef PC_LOAD_QKV
#undef PC_CHUNK

__device__ __forceinline__ void hgrn_sample(Frame& F) {
    LAS float* qs = (LAS float*)F.lds; LAS float* fs = qs + 1024; LAS float* ks = fs + 1024;
    LAS float* part = ks + 1024;
    LAS float* red = part + 4096;
    const int tid = F.tid, dv = tid & 127, qd = tid >> 7;
    for (int u = blockIdx.x; u < 512; u += F.G) {
        const int b = u >> 2, h = u & 3, row0 = TP + b * 8;
        float S[32];
#pragma unroll
        for (int j = 0; j < 32; ++j) S[j] = F.state_hgrn[(((size_t)b * 4 + h) * 128 + qd * 32 + j) * 128 + dv];
#pragma unroll
        for (int i = 0; i < 2; ++i) { const int idx = tid + 512 * i, t = idx >> 7, cc = idx & 127; const size_t ro = (size_t)(row0 + t) * 512 + h * 128 + cc;
            qs[idx] = bf2f(F.Q[ro]); fs[idx] = __expf(F.LOGF[ro]); ks[idx] = bf2f(F.KK[ro]); }
        float v[8];
#pragma unroll
        for (int t = 0; t < 8; ++t) v[t] = bf2f(F.V[(size_t)(row0 + t) * 512 + h * 128 + dv]);
        __syncthreads();
#pragma unroll
        for (int t = 0; t < 8; ++t) { float op = 0.f;
#pragma unroll
            for (int j4 = 0; j4 < 8; ++j4) { const f32x4 f4 = *(const LAS f32x4*)(fs + t * 128 + qd * 32 + 4 * j4), k4 = *(const LAS f32x4*)(ks + t * 128 + qd * 32 + 4 * j4), q4 = *(const LAS f32x4*)(qs + t * 128 + qd * 32 + 4 * j4);
#pragma unroll
                for (int e = 0; e < 4; ++e) { float s = f4[e] * S[4 * j4 + e] + k4[e] * v[t]; S[4 * j4 + e] = s; op += q4[e] * s; } }
            part[(qd * 8 + t) * 128 + dv] = op; }
        float* so = F.o_hgrn_s + ((size_t)b * 4 + h) * 128 * 128;
#pragma unroll
        for (int j = 0; j < 32; ++j) so[(size_t)(qd * 32 + j) * 128 + dv] = S[j];
        __syncthreads();
        float o2[2];
#pragma unroll
        for (int i = 0; i < 2; ++i) { const int idx = tid + 512 * i, t = idx >> 7, d2 = idx & 127;
            const float o = (part[(0 * 8 + t) * 128 + d2] + part[(1 * 8 + t) * 128 + d2]) + (part[(2 * 8 + t) * 128 + d2] + part[(3 * 8 + t) * 128 + d2]);
            o2[i] = o; const float ssq = wave_sum(o * o); if (F.lane == 0) red[i * 8 + F.wave] = ssq; }
        __syncthreads();
#pragma unroll
        for (int i = 0; i < 2; ++i) { const int idx = tid + 512 * i, t = idx >> 7, d2 = idx & 127; const float tot = red[i * 8 + (F.wave & ~1)] + red[i * 8 + (F.wave | 1)];
            const size_t r = (size_t)(row0 + t);
            F.MIX[r * D + 256 + h * 128 + d2] = (bf16)f2bf(o2[i] * (1.f / sqrtf(tot * (1.f / 128.f) + EPS)) * F.onorm_g[h * 128 + d2] * bf2f(F.GS[r * 512 + h * 128 + d2])); }
        __syncthreads();
    }
}
__device__ __forceinline__ bf16x8 frag_from(unsigned a, unsigned b, unsigned c, unsigned d) { return __builtin_bit_cast(bf16x8, (v4u){a, b, c, d}); }
__device__ __forceinline__ void xattn_prompt(Frame& F) {
    LAS unsigned char* KS = F.lds;
    LAS unsigned char* VT = F.lds + 32768;
    const int tid = F.tid, w = F.wave, lane = F.lane, l15 = lane & 15, lq = lane >> 4;
    for (int u = blockIdx.x; u < 256; u += F.G) {
        const int qb = u & 7, bh = u >> 3, b = bh >> 2, h = bh & 3;
        { const int kv = tid >> 1, half = tid & 1; const bf16* src = F.KVB + (size_t)(b * 256 + kv) * 512 + h * 64 + half * 32;
#pragma unroll
          for (int j = 0; j < 4; ++j) { const int cidx = 4 * half + j; *(LAS v4u*)(KS + ((((kv >> 4) * 2 + (cidx >> 2)) * 64 + 16 * (cidx & 3) + (kv & 15)) << 4)) = *(const GAS v4u*)(src + 8 * j); } }
        { const int d = tid & 63, kvg = tid >> 6; const bf16* src = F.KVB + (size_t)(b * 256 + 32 * kvg) * 512 + 256 + h * 64 + d;
          unsigned x[32];
#pragma unroll
          for (int i = 0; i < 32; ++i) x[i] = (unsigned)src[(size_t)i * 512];
#pragma unroll
          for (int q4 = 0; q4 < 4; ++q4) *(LAS v4u*)(VT + ((((d >> 4) * 8 + kvg) * 64 + 16 * q4 + (d & 15)) << 4)) =
              (v4u){x[4 * q4] | (x[4 * q4 + 1] << 16), x[4 * q4 + 2] | (x[4 * q4 + 3] << 16), x[16 + 4 * q4] | (x[16 + 4 * q4 + 1] << 16), x[16 + 4 * q4 + 2] | (x[16 + 4 * q4 + 3] << 16)}; }
        __syncthreads();
        const LAS unsigned char* kl = KS + lane * 16; const LAS unsigned char* vl = VT + lane * 16;
#pragma unroll 1
        for (int blk = 0; blk < 2; ++blk) {
            const int q0 = b * 2048 + qb * 256 + 32 * w + 16 * blk;
            bf16x8 qf[2];
#pragma unroll
            for (int ks = 0; ks < 2; ++ks) qf[ks] = *(const GAS bf16x8*)(F.QX + (size_t)(q0 + l15) * 256 + h * 64 + 32 * ks + 8 * lq);
            f32x4 s[16];
#pragma unroll
            for (int kt = 0; kt < 16; ++kt) { s[kt] = mma16(ldfrag(kl + (kt * 2 + 0) * 1024), qf[0], (f32x4){0.f, 0.f, 0.f, 0.f}); s[kt] = mma16(ldfrag(kl + (kt * 2 + 1) * 1024), qf[1], s[kt]);
                if ((kt & 3) == 3) __builtin_amdgcn_sched_barrier(0); }
            float m = s[0][0];
#pragma unroll
            for (int kt = 0; kt < 16; ++kt)
#pragma unroll
                for (int i = 0; i < 4; ++i) m = fmaxf(m, s[kt][i]);
            m = fmaxf(m, __shfl_xor(m, 16)); m = fmaxf(m, __shfl_xor(m, 32));
            float l = 0.f;
#pragma unroll
            for (int kt = 0; kt < 16; ++kt)
#pragma unroll
                for (int i = 0; i < 4; ++i) { const float p = exp2f(s[kt][i] - m); s[kt][i] = p; l += p; }
            l += __shfl_xor(l, 16); l += __shfl_xor(l, 32);
            const float inv = 1.f / l;
            f32x4 o[4];
#pragma unroll
            for (int dt = 0; dt < 4; ++dt) o[dt] = (f32x4){0.f, 0.f, 0.f, 0.f};
#pragma unroll
            for (int ks = 0; ks < 8; ++ks) {
                const f32x4 p0 = s[2 * ks] * inv, p1 = s[2 * ks + 1] * inv;
                const bf16x8 bfr = frag_from(pk2(p0[0], p0[1]), pk2(p0[2], p0[3]), pk2(p1[0], p1[1]), pk2(p1[2], p1[3]));
#pragma unroll
                for (int dt = 0; dt < 4; ++dt) o[dt] = mma16(ldfrag(vl + (dt * 8 + ks) * 1024), bfr, o[dt]);
                __builtin_amdgcn_sched_barrier(0);
            }
#pragma unroll
            for (int dt = 0; dt < 4; ++dt) *(GAS u32x2v*)(F.MIX + (size_t)(q0 + l15) * D + 768 + h * 64 + 16 * dt + 4 * lq) = (u32x2v){pk2(o[dt][0], o[dt][1]), pk2(o[dt][2], o[dt][3])};
        }
        __syncthreads();
    }
}
__device__ __forceinline__ void xattn_sample(Frame& F) {
    LAS float* MX = (LAS float*)F.lds; LAS float* LS = MX + 128; LAS float* OP = LS + 128;
    const int tid = F.tid, w = F.wave, lane = F.lane, l15 = lane & 15, lq = lane >> 4;
    for (int u = blockIdx.x; u < 512; u += F.G) {
        const int b = u >> 2, h = u & 3, row0 = TP + 8 * b;
        bf16x8 qf[2];
#pragma unroll
        for (int ks = 0; ks < 2; ++ks) qf[ks] = *(const GAS bf16x8*)(F.QX + (size_t)(row0 + (l15 & 7)) * 256 + h * 64 + 32 * ks + 8 * lq);
        f32x4 s[2];
#pragma unroll
        for (int t2 = 0; t2 < 2; ++t2) { s[t2] = (f32x4){0.f, 0.f, 0.f, 0.f};
#pragma unroll
            for (int ks = 0; ks < 2; ++ks) { const float* kp = F.cache_k + (((size_t)b * 256 + 32 * w + 16 * t2 + l15) * 4 + h) * 64 + 32 * ks + 8 * lq;
                const f32x4 x0 = *(const GAS f32x4*)kp, x1 = *(const GAS f32x4*)(kp + 4);
                s[t2] = mma16(frag_from(pk2(x0[0], x0[1]), pk2(x0[2], x0[3]), pk2(x1[0], x1[1]), pk2(x1[2], x1[3])), qf[ks], s[t2]); } }
        float vv[4][8];
#pragma unroll
        for (int dt = 0; dt < 4; ++dt)
#pragma unroll
            for (int j = 0; j < 8; ++j) vv[dt][j] = F.cache_v[(((size_t)b * 256 + 32 * w + 16 * (j >> 2) + 4 * lq + (j & 3)) * 4 + h) * 64 + 16 * dt + l15];
        float m = fmaxf(fmaxf(fmaxf(s[0][0], s[0][1]), fmaxf(s[0][2], s[0][3])), fmaxf(fmaxf(s[1][0], s[1][1]), fmaxf(s[1][2], s[1][3])));
        m = fmaxf(m, __shfl_xor(m, 16)); m = fmaxf(m, __shfl_xor(m, 32));
        if (lq == 0) MX[w * 16 + l15] = m;
        __syncthreads();
        m = MX[l15];
#pragma unroll
        for (int w2 = 1; w2 < 8; ++w2) m = fmaxf(m, MX[w2 * 16 + l15]);
        float l = 0.f;
#pragma unroll
        for (int t2 = 0; t2 < 2; ++t2)
#pragma unroll
            for (int i = 0; i < 4; ++i) { const float p = exp2f(s[t2][i] - m); s[t2][i] = p; l += p; }
        l += __shfl_xor(l, 16); l += __shfl_xor(l, 32);
        if (lq == 0) LS[w * 16 + l15] = l;
        const bf16x8 bfr = frag_from(pk2(s[0][0], s[0][1]), pk2(s[0][2], s[0][3]), pk2(s[1][0], s[1][1]), pk2(s[1][2], s[1][3]));
#pragma unroll
        for (int dt = 0; dt < 4; ++dt) {
            const f32x4 o = mma16(frag_from(pk2(vv[dt][0], vv[dt][1]), pk2(vv[dt][2], vv[dt][3]), pk2(vv[dt][4], vv[dt][5]), pk2(vv[dt][6], vv[dt][7])), bfr, (f32x4){0.f, 0.f, 0.f, 0.f});
#pragma unroll
            for (int i = 0; i < 4; ++i) OP[(w * 64 + 16 * dt + 4 * lq + i) * 16 + l15] = o[i];
        }
        __syncthreads();
        { const int q = tid >> 6, d = tid & 63; float o = 0.f, ll = 0.f;
#pragma unroll
          for (int w2 = 0; w2 < 8; ++w2) { o += OP[(w2 * 64 + d) * 16 + q]; ll += LS[w2 * 16 + q]; }
          F.MIX[(size_t)(row0 + q) * D + 768 + h * 64 + d] = (bf16)f2bf(o / ll); }
        __syncthreads();
    }
}
template <class Epi> __device__ __forceinline__ void small_piece(const bf16* A, const bf16* Bt, int K, int w, int lane, const Epi& epi) {
    const int rb = w >> 1, cb = w & 1, l15 = lane & 15, lq = lane >> 4;
    const bf16* ap = A + (size_t)(16 * rb + l15) * K + 8 * lq;
    const bf16* bp0 = Bt + (size_t)(32 * cb + l15) * K + 8 * lq; const bf16* bp1 = bp0 + (size_t)16 * K;
    f32x4 acc0 = (f32x4){0.f, 0.f, 0.f, 0.f}, acc1 = (f32x4){0.f, 0.f, 0.f, 0.f};
    const int ng = K / 256;
    bf16x8 xa[8], wa0[8], wa1[8], xb[8], wb0[8], wb1[8];
#define SP_LOAD(X, W0, W1, gi) do { const int o_ = 256 * (gi); _Pragma("unroll") for (int j = 0; j < 8; ++j) { X[j] = *(const GAS bf16x8*)(ap + o_ + 32 * j); W0[j] = *(const GAS bf16x8*)(bp0 + o_ + 32 * j); W1[j] = *(const GAS bf16x8*)(bp1 + o_ + 32 * j); } } while (0)
#define SP_MMA(X, W0, W1) do { _Pragma("unroll") for (int j = 0; j < 8; ++j) { acc0 = mma16(W0[j], X[j], acc0); acc1 = mma16(W1[j], X[j], acc1); } } while (0)
    SP_LOAD(xa, wa0, wa1, 0);
    int g = 0;
#pragma unroll 1
    for (; g + 1 < ng; g += 2) {
        SP_LOAD(xb, wb0, wb1, g + 1);
        SP_MMA(xa, wa0, wa1);
        SP_LOAD(xa, wa0, wa1, (g + 2 < ng ? g + 2 : ng - 1));
        SP_MMA(xb, wb0, wb1);
    }
    if (g < ng) SP_MMA(xa, wa0, wa1);
#undef SP_LOAD
#undef SP_MMA
    epi(acc0, acc1, 16 * rb + l15, 32 * cb + 4 * lq, cb, lq);
}
__device__ __forceinline__ void out_sample_piece(Frame& F) {
    const int p = blockIdx.x; if (p >= 256) return; const int pr = p >> 4, pc = p & 15;
    auto epi = [&](const f32x4& a0, const f32x4& a1, int r, int c, int cb, int lq) {
        const int rs = 64 * pr + r, col = 64 * pc + c; const float* xr = F.x_sample + (size_t)rs * D + col; bf16* xo = F.XN + (size_t)(TP + rs) * D + col;
        const f32x4 v0 = a0 + *(const GAS f32x4*)xr, v1 = a1 + *(const GAS f32x4*)(xr + 16);
        *(GAS u32x2v*)xo = (u32x2v){pk2(v0[0], v0[1]), pk2(v0[2], v0[3])}; *(GAS u32x2v*)(xo + 16) = (u32x2v){pk2(v1[0], v1[1]), pk2(v1[2], v1[3])};
        float ss = ((v0[0] * v0[0] + v0[1] * v0[1]) + (v0[2] * v0[2] + v0[3] * v0[3])) + ((v1[0] * v1[0] + v1[1] * v1[1]) + (v1[2] * v1[2] + v1[3] * v1[3]));
        ss += __shfl_xor(ss, 16); ss += __shfl_xor(ss, 32);
        if (lq == 0) F.ROWSS_S[(size_t)rs * 32 + pc * 2 + cb] = ss; };
    small_piece(F.MIX + (size_t)(TP + 64 * pr) * D, F.WOUT + (size_t)(64 * pc) * D, D, F.wave, F.lane, epi);
}
__device__ __forceinline__ void down_sample_piece(Frame& F) {
    const int p = blockIdx.x; if (p >= 256) return; const int pr = p >> 4, pc = p & 15;
    auto epi = [&](const f32x4& a0, const f32x4& a1, int r, int c, int cb, int lq) {
        float* yo = F.y + (size_t)(TP + 64 * pr + r) * D + 64 * pc + c; const bf16* xi = F.XN + (size_t)(TP + 64 * pr + r) * D + 64 * pc + c;
        const u32x2v b0 = *(const GAS u32x2v*)xi, b1 = *(const GAS u32x2v*)(xi + 16);
        const f32x4 r0 = (f32x4){__builtin_bit_cast(float, b0.x << 16), __builtin_bit_cast(float, b0.x & 0xffff0000u), __builtin_bit_cast(float, b0.y << 16), __builtin_bit_cast(float, b0.y & 0xffff0000u)};
        const f32x4 r1 = (f32x4){__builtin_bit_cast(float, b1.x << 16), __builtin_bit_cast(float, b1.x & 0xffff0000u), __builtin_bit_cast(float, b1.y << 16), __builtin_bit_cast(float, b1.y & 0xffff0000u)};
        const f32x4 v0 = a0 + r0, v1 = a1 + r1;
        *(GAS f32x4*)yo = v0; *(GAS f32x4*)(yo + 16) = v1; };
    small_piece(F.PB + (size_t)(TP + 64 * pr) * DFF, F.WDN + (size_t)(64 * pc) * DFF, DFF, F.wave, F.lane, epi);
}
__global__ void __launch_bounds__(NWAVES * 64, 2) mk_fwd(Args args) {
    extern __shared__ __attribute__((aligned(16))) unsigned char lds[];
    Frame F;
    F.lds = (LAS unsigned char*)lds;
    F.tid = threadIdx.x; F.lane = F.tid & 63; F.wave = __builtin_amdgcn_readfirstlane(F.tid >> 6); F.G = gridDim.x;
    volatile LAS unsigned* MISC = (volatile LAS unsigned*)(F.lds + MISC_OFF);
    unsigned char* ws = args.ws;
    gu32* ctl = (gu32*)(ws + WS_CTL);
    F.x_prompt = args.in[0]; F.x_sample = args.in[1]; F.mem_prompt = args.in[2]; F.state_pool = args.in[3]; F.state_hgrn = args.in[4]; F.state_conv = args.in[5];
    F.cache_k = args.in[6]; F.cache_v = args.in[7]; F.ln1_g = args.in[8]; F.w_in = args.in[9]; F.pool_w = args.in[10]; F.pool_scale = args.in[11]; F.lb_logits = args.in[12];
    F.onorm_g = args.in[13]; F.mem_norm_g = args.in[14]; F.w_mem_kv = args.in[15]; F.w_out = args.in[16]; F.ln2_g = args.in[17]; F.w_up = args.in[18]; F.conv_w = args.in[19];
    F.conv_b = args.in[20]; F.w_down = args.in[21]; F.lnf_g = args.in[22];
    float* out = args.out;
    F.y = out; F.o_pool_p = out + (size_t)MT * D; F.o_hgrn_p = F.o_pool_p + 8 * 15 * 256; F.o_conv_p = F.o_hgrn_p + 8 * 4 * 128 * 128; F.o_mk = F.o_conv_p + 8 * 2 * DFF;
    F.o_mv = F.o_mk + MEMR * 256; F.o_pool_s = F.o_mv + MEMR * 256; F.o_hgrn_s = F.o_pool_s + 128 * 15 * 256; F.o_conv_s = F.o_hgrn_s + (size_t)128 * 4 * 128 * 128;
    F.WIN = (bf16*)(ws + WS_WIN); F.WKV = (bf16*)(ws + WS_WKV); F.WOUT = (bf16*)(ws + WS_WOUT); F.WUP = (bf16*)(ws + WS_WUP); F.WDN = (bf16*)(ws + WS_WDN);
    F.XN = (bf16*)(ws + WS_XN); F.XNM = (bf16*)(ws + WS_XNM); F.KVB = (bf16*)(ws + WS_KVB); F.MIX = (bf16*)(ws + WS_MIX);
    F.U = (float*)(ws + WS_U); F.Q = (bf16*)(ws + WS_Q); F.LOGF = (float*)(ws + WS_LOGF); F.KK = (bf16*)(ws + WS_KK); F.V = (bf16*)(ws + WS_V); F.GS = (bf16*)(ws + WS_G); F.QX = (bf16*)(ws + WS_QX);
    F.PA = (bf16*)(ws + WS_PA); F.PB = (bf16*)(ws + WS_PB); F.EA = (float*)(ws + WS_EA); F.EB = (float*)(ws + WS_EB); F.ROWSS = (float*)(ws + WS_ROWSS); F.ROWSS_S = (float*)(ws + WS_ROWSS_S);
    for (int u = F.tid; u < (LDS_BYTES - LDSCTL_OFF) / 4; u += NWAVES * 64) ((LAS unsigned*)(F.lds + LDSCTL_OFF))[u] = 0u;
    __syncthreads();
    const int lo = args.ph_lo, hi = args.ph_hi;
    XcdBarrier bar; bar.bar = (unsigned*)(ctl + CW_BAR); bar.x = 0; bar.st = nullptr;
    if (hi - lo > 1) bar = xcd_barrier_post((unsigned*)(ctl + CW_BAR), MISC + 8);
#define IN(k) (lo <= (k) && (k) < hi)
#if defined(PROBE_A)
    volatile LAS unsigned long long* TSW = (volatile LAS unsigned long long*)(F.lds + LDSCTL_OFF + 512);
    if (blockIdx.x == 0 && F.tid == 0) TSW[0] = __builtin_amdgcn_s_memrealtime();
#define SEAM(k) do { if (IN(k) && IN((k) + 1)) xcd_barrier(bar); if (blockIdx.x == 0 && F.tid == 0) TSW[(k) + 1] = __builtin_amdgcn_s_memrealtime(); } while (0)
#else
#define SEAM(k) do { if (IN(k) && IN((k) + 1)) xcd_barrier(bar); } while (0)
#endif

    if (IN(0)) { p0_prologue(F); } SEAM(0);
    if (IN(1)) {
        { pg8::Gemm g{F.XN, F.WIN, MT, DIN, D}; pg8::StaticOrder S; S.init(MT, DIN, F.G, (int)blockIdx.x);
          pg8::EpiIn E{F.U, F.Q, F.LOGF, F.KK, F.V, F.GS, F.QX, F.lb_logits};
          pg8::gemm_phase<pg8::EpiIn, pg8::StaticOrder, true, true>(F.lds, g, S, E); }
        { pg8::Gemm g{F.XNM, F.WKV, MEMR, 512, D}; pg8::StaticOrder S; S.init(MEMR, 512, F.G, (int)((blockIdx.x + F.G - 168 % F.G) % F.G));
          pg8::EpiKV E{F.o_mk, F.o_mv, F.KVB};
          pg8::gemm_phase<pg8::EpiKV, pg8::StaticOrder, true, true>(F.lds, g, S, E); }
        { const int first = (int)((long)(MT / 256) * (DIN / 256) - 2L * F.G); const int nb2 = F.G - first;
          if (first >= 0 && nb2 > 0) { if ((int)blockIdx.x >= first) p0_late(F, ((int)blockIdx.x - first) * NWAVES + F.wave, nb2 * NWAVES); }
          else p0_late(F, (int)blockIdx.x * NWAVES + F.wave, F.G * NWAVES); }
    } SEAM(1);
#if defined(PROBE_A)
#define SUBSTAMP(k) do { if (blockIdx.x == 0 && F.tid == 0) TSW[k] = __builtin_amdgcn_s_memrealtime(); } while (0)
#else
#define SUBSTAMP(k) do { } while (0)
#endif
    if (IN(2)) { pool_phase(F); SUBSTAMP(26); hgrn_passA(F, (f32x4*)(ws + WS_HU), (float*)(ws + WS_HD)); SUBSTAMP(27); hgrn_sample(F); SUBSTAMP(28); xattn_prompt(F); SUBSTAMP(29); xattn_sample(F); SUBSTAMP(30); } SEAM(2);
    if (IN(3)) { hgrn_passC(F, (const f32x4*)(ws + WS_HU), (const float*)(ws + WS_HD)); } SEAM(3);
    if (IN(4)) {
        pg8::Gemm g{F.MIX, F.WOUT, TP, D, D}; pg8::StaticOrder S; S.init(TP, D, F.G, (int)blockIdx.x);
        pg8::EpiOut2 E{F.x_prompt, F.x_sample, TP, F.y, F.XN, F.ROWSS};
        pg8::gemm_phase<pg8::EpiOut2, pg8::StaticOrder, true, true>(F.lds, g, S, E);
#if defined(PROBE_A)
        if (blockIdx.x == 0 && F.tid == 0) TSW[20] = __builtin_amdgcn_s_memrealtime();
        if (F.tid == 0) atomicMax((unsigned long long*)(ws + WS_CTL + 32768 + 128), (unsigned long long)__builtin_amdgcn_s_memrealtime());
#endif
        out_sample_piece(F);
#if defined(PROBE_A)
        if (F.tid == 0) atomicMax((unsigned long long*)(ws + WS_CTL + 32768 + 192), (unsigned long long)__builtin_amdgcn_s_memrealtime());
#endif
    } SEAM(4);
    if (IN(5)) {
        pg8::Gemm g{F.XN, F.WUP, MT, 2 * DFF, D}; pg8::StaticOrder S; S.init(MT, 2 * DFF, F.G, (int)blockIdx.x);
        pg8::EpiUpConv E{F.ROWSS, F.ROWSS_S, F.conv_w, F.conv_b, F.state_conv, F.PB, F.EA, F.EB, F.o_conv_p, F.o_conv_s, (LAS float*)(F.lds + RING_BYTES + 4096)};
        pg8::gemm_phase<pg8::EpiUpConv, pg8::StaticOrder, true, true>(F.lds, g, S, E);
    } SEAM(5);
    if (IN(6)) { conv_fixup_phase(F); } SEAM(6);
    if (IN(7)) {
        pg8::Gemm g{F.PB, F.WDN, TP, D, DFF}; pg8::StaticOrder S; S.init(TP, D, F.G, (int)blockIdx.x);
        pg8::EpiResB E{F.XN, F.y};
        pg8::gemm_phase<pg8::EpiResB, pg8::StaticOrder, true, true>(F.lds, g, S, E);
#if defined(PROBE_A)
        if (blockIdx.x == 0 && F.tid == 0) TSW[21] = __builtin_amdgcn_s_memrealtime();
        if (F.tid == 0) atomicMax((unsigned long long*)(ws + WS_CTL + 32768), (unsigned long long)__builtin_amdgcn_s_memrealtime());
#endif
        down_sample_piece(F);
#if defined(PROBE_A)
        if (F.tid == 0) atomicMax((unsigned long long*)(ws + WS_CTL + 32768 + 64), (unsigned long long)__builtin_amdgcn_s_memrealtime());
#endif
    } SEAM(7);
    if (IN(8)) { final_norm_phase(F); }
#if defined(PROBE_A)
    __syncthreads();
    if (blockIdx.x == 0 && F.tid == 0) { TSW[NPHASE] = __builtin_amdgcn_s_memrealtime();
        TSW[22] = __hip_atomic_load((unsigned long long*)(ws + WS_CTL + 32768), __ATOMIC_RELAXED, __HIP_MEMORY_SCOPE_AGENT); TSW[23] = __hip_atomic_load((unsigned long long*)(ws + WS_CTL + 32768 + 64), __ATOMIC_RELAXED, __HIP_MEMORY_SCOPE_AGENT); TSW[24] = __hip_atomic_load((unsigned long long*)(ws + WS_CTL + 32768 + 128), __ATOMIC_RELAXED, __HIP_MEMORY_SCOPE_AGENT); TSW[25] = __hip_atomic_load((unsigned long long*)(ws + WS_CTL + 32768 + 192), __ATOMIC_RELAXED, __HIP_MEMORY_SCOPE_AGENT);
        const unsigned long long wait = (TSW[PROBE_B] - TSW[PROBE_A]) * 512ull, t0 = __builtin_amdgcn_s_memrealtime();
        while (__builtin_amdgcn_s_memrealtime() - t0 < wait) __builtin_amdgcn_s_sleep(32); }
#endif
#undef IN
#undef SEAM
}

extern "C" void kernel_launch(void* const* d_in, const int* in_sizes, int n_in, void* d_out, int out_size, void* d_ws, size_t ws_size, hipStream_t stream) {
    static int grid = 0;
    if (grid == 0) {
        if (n_in != 23 || ws_size < WS_END) { fprintf(stderr, "kernel_launch: unexpected n_in %d / ws_size %zu\n", n_in, ws_size); grid = -1; return; }
        int dev = 0, cus = 0, per_cu = 0;
        if (hipGetDevice(&dev) != hipSuccess || hipDeviceGetAttribute(&cus, hipDeviceAttributeMultiprocessorCount, dev) != hipSuccess) { grid = -1; return; }
        if (hipFuncSetAttribute((const void*)mk_fwd, hipFuncAttributeMaxDynamicSharedMemorySize, LDS_BYTES) != hipSuccess) { fprintf(stderr, "kernel_launch: hipFuncSetAttribute failed\n"); grid = -1; return; }
        if (hipOccupancyMaxActiveBlocksPerMultiprocessor(&per_cu, (const void*)mk_fwd, NWAVES * 64, LDS_BYTES) != hipSuccess || per_cu < 1) { fprintf(stderr, "kernel_launch: occupancy query says %d blocks/CU\n", per_cu); }
        (void)hipGetLastError();
        grid = cus;
    }
    if (grid < 0) return;
    (void)hipMemsetAsync((char*)d_ws + WS_CTL, 0, CTL_ZERO_BYTES, stream);
    Args a{};
    for (int i = 0; i < 23; ++i) a.in[i] = (const float*)d_in[i];
    a.out = (float*)d_out; a.ws = (unsigned char*)d_ws;
#if MK_PER_PHASE
    for (int p = 0; p < NPHASE; ++p) { a.ph_lo = p; a.ph_hi = p + 1; hipLaunchKernelGGL(mk_fwd, dim3(grid), dim3(NWAVES * 64), LDS_BYTES, stream, a); }
#else
    a.ph_lo = 0; a.ph_hi = NPHASE;
    hipLaunchKernelGGL(mk_fwd, dim3(grid), dim3(NWAVES * 64), LDS_BYTES, stream, a);
#endif
}
```

```cpp
#include <hip/hip_runtime.h>
#include <cstdio>
#include <cstdint>
namespace pg8 {
#define PG8_LAS __attribute__((address_space(3)))
typedef unsigned short bf16_t;
typedef short bf16x8 __attribute__((ext_vector_type(8)));
typedef float f32x4 __attribute__((ext_vector_type(4)));
typedef unsigned u32x4 __attribute__((ext_vector_type(4)));
constexpr int BM = 256, BK = 64, HALF = 128, HTB = HALF * BK * 2  , STAGE_BYTES = 8 * HTB, NXCD = 8, WGM = 8;

__host__ __device__ __forceinline__ int lds_byte(int r, int c) { const int st = (r >> 4) * 2 + (c >> 5), rr = r & 15, cc = c & 31, ob = rr * 64 + cc * 2; return st * 1024 + (ob ^ (((ob >> 9) & 1) << 5)); }
__host__ __device__ __forceinline__ void stage_rc(int b, int& R, int& C) { const int st = b / 1024, sb = b % 1024, swz = sb ^ (((sb >> 9) & 1) << 5); R = (st >> 1) * 16 + swz / 64; C = (st & 1) * 32 + (swz % 64) / 2; }
__host__ __device__ __forceinline__ int perm32(int rho) { const int n = rho >> 4, i = rho & 15; return 8 * (i >> 2) + 4 * n + (i & 3); }

struct Unit { int pm, pn; };
struct Gemm { const bf16_t* A; const bf16_t* Bt; int M, N, K; };

struct StaticOrder {
    int nM, nN, nwg, G, c;
    __host__ __device__ void init(int M, int N, int G_, int c_) { nM = M / BM; nN = N / BM; nwg = nM * nN; G = G_; c = c_; }
    __host__ __device__ bool next(int i, Unit& u) const {
        const long L = (long)i * G + c; if (L >= nwg) return false;
        int wgid = (int)L; { const int q = nwg / NXCD, r = nwg % NXCD, xcd = wgid % NXCD, off = wgid / NXCD; wgid = (xcd < r ? xcd * (q + 1) : r * (q + 1) + (xcd - r) * q) + off; }
        const int nig = WGM * nN, gid = wgid / nig, fm = gid * WGM, gsz = (nM - fm) < WGM ? (nM - fm) : WGM;
        u.pm = fm + ((wgid % nig) % gsz); u.pn = (wgid % nig) / gsz; return true;
    }
    __device__ __forceinline__ void a_ready(const Unit&) const {}
    __device__ __forceinline__ void done(const Unit&) const {}
};
__device__ __forceinline__ unsigned cvt_pk_bf16(float lo, float hi) { unsigned r; asm volatile("v_cvt_pk_bf16_f32 %0, %1, %2" : "=v"(r) : "v"(lo), "v"(hi)); return r; }
typedef float f32x2 __attribute__((ext_vector_type(2)));
typedef unsigned u32x2 __attribute__((ext_vector_type(2)));
__device__ __forceinline__ float frcp(float x) { return __builtin_amdgcn_rcpf(x); }
__device__ __forceinline__ float fsilu(float x) { return x * frcp(1.f + __expf(-x)); }
__device__ __forceinline__ u32x4 pack8(const f32x4& v0, const f32x4& v1) { u32x4 w; w.x = cvt_pk_bf16(v0[0], v0[1]); w.y = cvt_pk_bf16(v0[2], v0[3]); w.z = cvt_pk_bf16(v1[0], v1[1]); w.w = cvt_pk_bf16(v1[2], v1[3]); return w; }
constexpr float QX_SCALE = 0.125f * 1.4426950408889634f;
struct EpiIn {
    static constexpr bool PERM = true, AFTER_DRAIN = false;
    float* U; bf16_t* Q; float* LOGF; bf16_t* KK; bf16_t* V; bf16_t* G; bf16_t* QX; const float* lbl;
    __device__ __forceinline__ void operator()(const f32x4 (&acc)[2][2][4][2], const Unit& u, int wr, int wc, int fr, int fq) const {
        const int row0 = u.pm * BM + wr * 64 + fr, pn = u.pn, cl = wc * 32 + 8 * fq;
        if (pn == 0) {
#pragma unroll
            for (int ai = 0; ai < 2; ++ai)
#pragma unroll
                for (int m = 0; m < 4; ++m) { float* rowp = U + (size_t)(row0 + ai * HALF + m * 16) * 256 + cl;
#pragma unroll
                    for (int bj = 0; bj < 2; ++bj) { *(f32x4*)(rowp + bj * HALF) = acc[ai][bj][m][0]; *(f32x4*)(rowp + bj * HALF + 4) = acc[ai][bj][m][1]; } }
        } else if (pn == 3 || pn == 4) {
            const int c0 = (pn - 3) * 256 + cl;
            f32x4 oml[2][2];
#pragma unroll
            for (int bj = 0; bj < 2; ++bj)
#pragma unroll
                for (int n = 0; n < 2; ++n) { const f32x4 l0 = *(const f32x4*)(lbl + c0 + bj * HALF + 4 * n), l1 = *(const f32x4*)(lbl + 512 + c0 + bj * HALF + 4 * n);
#pragma unroll
                    for (int e = 0; e < 4; ++e) oml[bj][n][e] = frcp(1.f + __expf(l0[e] - l1[e])); }
#pragma unroll
            for (int ai = 0; ai < 2; ++ai)
#pragma unroll
                for (int m = 0; m < 4; ++m) { const size_t ro = (size_t)(row0 + ai * HALF + m * 16) * 512 + c0;
#pragma unroll
                    for (int bj = 0; bj < 2; ++bj) { f32x4 kk[2], lf[2];
#pragma unroll
                        for (int n = 0; n < 2; ++n)
#pragma unroll
                            for (int e = 0; e < 4; ++e) { const float x = acc[ai][bj][m][n][e]; const float k = oml[bj][n][e] * frcp(1.f + __expf(x)); kk[n][e] = k; lf[n][e] = __logf(1.f - k); }
                        *(f32x4*)(LOGF + ro + bj * HALF) = lf[0]; *(f32x4*)(LOGF + ro + bj * HALF + 4) = lf[1];
                        *(u32x4*)(KK + ro + bj * HALF) = pack8(kk[0], kk[1]); } }
        } else {
            bf16_t* base; int ldc, cb, mode;
            if (pn <= 2) { base = Q; ldc = 512; cb = (pn - 1) * 256; mode = 1; }
            else if (pn <= 6) { base = V; ldc = 512; cb = (pn - 5) * 256; mode = 0; }
            else if (pn <= 8) { base = G; ldc = 512; cb = (pn - 7) * 256; mode = 1; }
            else { base = QX; ldc = 256; cb = 0; mode = 2; }
#pragma unroll
            for (int ai = 0; ai < 2; ++ai)
#pragma unroll
                for (int m = 0; m < 4; ++m) { bf16_t* rowp = base + (size_t)(row0 + ai * HALF + m * 16) * ldc + cb + cl;
#pragma unroll
                    for (int bj = 0; bj < 2; ++bj) { f32x4 v0 = acc[ai][bj][m][0], v1 = acc[ai][bj][m][1];
                        if (mode == 1) {
#pragma unroll
                            for (int e = 0; e < 4; ++e) { v0[e] = fsilu(v0[e]); v1[e] = fsilu(v1[e]); } }
                        else if (mode == 2) { v0 = v0 * QX_SCALE; v1 = v1 * QX_SCALE; }
                        *(u32x4*)(rowp + bj * HALF) = pack8(v0, v1); } }
        }
    }
};
struct EpiKV {
    static constexpr bool PERM = true, AFTER_DRAIN = false;
    float* MK; float* MV; bf16_t* KVB;
    __device__ __forceinline__ void operator()(const f32x4 (&acc)[2][2][4][2], const Unit& u, int wr, int wc, int fr, int fq) const {
        const int row0 = u.pm * BM + wr * 64 + fr, cl = wc * 32 + 8 * fq; float* of = u.pn ? MV : MK;
#pragma unroll
        for (int ai = 0; ai < 2; ++ai)
#pragma unroll
            for (int m = 0; m < 4; ++m) { const size_t r = (size_t)(row0 + ai * HALF + m * 16);
#pragma unroll
                for (int bj = 0; bj < 2; ++bj) { *(f32x4*)(of + r * 256 + cl + bj * HALF) = acc[ai][bj][m][0]; *(f32x4*)(of + r * 256 + cl + bj * HALF + 4) = acc[ai][bj][m][1];
                    *(u32x4*)(KVB + r * 512 + u.pn * 256 + cl + bj * HALF) = pack8(acc[ai][bj][m][0], acc[ai][bj][m][1]); } }
    }
};
struct EpiRes {
    static constexpr bool PERM = true, AFTER_DRAIN = false;
    const float* r0; const float* r1; int split; float* out;
    __device__ __forceinline__ void operator()(const f32x4 (&acc)[2][2][4][2], const Unit& u, int wr, int wc, int fr, int fq) const {
        const int row0 = u.pm * BM + wr * 64 + fr, cl = u.pn * BM + wc * 32 + 8 * fq;
#pragma unroll
        for (int ai = 0; ai < 2; ++ai)
#pragma unroll
            for (int m = 0; m < 4; ++m) { const int r = row0 + ai * HALF + m * 16; const float* rp = (r < split ? r0 + (size_t)r * 1024 : r1 + (size_t)(r - split) * 1024) + cl; float* op = out + (size_t)r * 1024 + cl;
#pragma unroll
                for (int bj = 0; bj < 2; ++bj)
#pragma unroll
                    for (int n = 0; n < 2; ++n) { const f32x4 x = *(const f32x4*)(rp + bj * HALF + 4 * n); *(f32x4*)(op + bj * HALF + 4 * n) = acc[ai][bj][m][n] + x; } }
    }
};
struct EpiPlanes {
    static constexpr bool PERM = true, AFTER_DRAIN = false;
    bf16_t* P0; bf16_t* P1; int tiles_per_plane, ldc;
    __device__ __forceinline__ void operator()(const f32x4 (&acc)[2][2][4][2], const Unit& u, int wr, int wc, int fr, int fq) const {
        const int row0 = u.pm * BM + wr * 64 + fr; const bool second = u.pn >= tiles_per_plane; bf16_t* base = second ? P1 : P0; const int cl = (second ? u.pn - tiles_per_plane : u.pn) * BM + wc * 32 + 8 * fq;
#pragma unroll
        for (int ai = 0; ai < 2; ++ai)
#pragma unroll
            for (int m = 0; m < 4; ++m) { bf16_t* rowp = base + (size_t)(row0 + ai * HALF + m * 16) * ldc + cl;
#pragma unroll
                for (int bj = 0; bj < 2; ++bj) *(u32x4*)(rowp + bj * HALF) = pack8(acc[ai][bj][m][0], acc[ai][bj][m][1]); }
    }
};
struct EpiOut2 {
    static constexpr bool PERM = true, AFTER_DRAIN = false;
    const float* r0; const float* r1; int split; float* out; bf16_t* XB; float* ROWSS;
    __device__ __forceinline__ void operator()(const f32x4 (&acc)[2][2][4][2], const Unit& u, int wr, int wc, int fr, int fq) const {
        const int row0 = u.pm * BM + wr * 64 + fr, cl = u.pn * BM + wc * 32 + 8 * fq;
#pragma unroll
        for (int ai = 0; ai < 2; ++ai)
#pragma unroll
            for (int m = 0; m < 4; ++m) { const int r = row0 + ai * HALF + m * 16; const float* rp = (r < split ? r0 + (size_t)r * 1024 : r1 + (size_t)(r - split) * 1024) + cl;
                float ss = 0.f;
#pragma unroll
                for (int bj = 0; bj < 2; ++bj) { f32x4 v[2];
#pragma unroll
                    for (int n = 0; n < 2; ++n) { v[n] = acc[ai][bj][m][n] + *(const f32x4*)(rp + bj * HALF + 4 * n);
                        ss += (v[n][0] * v[n][0] + v[n][1] * v[n][1]) + (v[n][2] * v[n][2] + v[n][3] * v[n][3]); }
                    *(u32x4*)(XB + (size_t)r * 1024 + cl + bj * HALF) = pack8(v[0], v[1]); }
                ss += __shfl_xor(ss, 16); ss += __shfl_xor(ss, 32);
                if (fq == 0) ROWSS[(size_t)r * 16 + u.pn * 4 + wc] = ss; }
    }
};
struct EpiUpConv {
    static constexpr bool PERM = true, AFTER_DRAIN = false;
    const float* ROWSS; const float* ROWSS_S; const float* conv_w; const float* conv_b; const float* state_conv; bf16_t* HID; float* EA; float* EB; float* o_conv_p; float* o_conv_s; PG8_LAS float* xch;
    static constexpr int FF = 2816;
    __device__ __forceinline__ static float gelu_t(float x) { const float u2 = 1.5957691216057308f * (x + 0.044715f * x * x * x); return x * frcp(1.f + __expf(-u2)); }
    __device__ __forceinline__ void operator()(const f32x4 (&acc)[2][2][4][2], const Unit& u, int wr, int wc, int fr, int fq) const {
        const int lane = fq * 16 + fr, row0 = u.pm * BM + wr * 64 + fr, j0 = u.pn * 128 + wc * 32 + 8 * fq;
        const bool smp = u.pm >= 64;
        float rstd[2][4];
#pragma unroll
        for (int ai = 0; ai < 2; ++ai)
#pragma unroll
            for (int m = 0; m < 4; ++m) { const int r = row0 + ai * HALF + m * 16; float s;
                if (!smp) { const f32x4 p = *(const f32x4*)(ROWSS + (size_t)r * 16 + 4 * fq); s = (p[0] + p[1]) + (p[2] + p[3]); }
                else { const f32x4 p = *(const f32x4*)(ROWSS_S + (size_t)(r - 16384) * 32 + 8 * fq), q = *(const f32x4*)(ROWSS_S + (size_t)(r - 16384) * 32 + 8 * fq + 4); s = ((p[0] + p[1]) + (p[2] + p[3])) + ((q[0] + q[1]) + (q[2] + q[3])); }
                s += __shfl_xor(s, 16); s += __shfl_xor(s, 32); rstd[ai][m] = 1.0f / sqrtf(s * (1.f / 1024.f) + 1e-6f); }
        if (!smp) {
            if (fr >= 14) {
#pragma unroll
                for (int ai = 0; ai < 2; ++ai)
#pragma unroll
                    for (int n = 0; n < 2; ++n) *(PG8_LAS f32x4*)(xch + ((((ai * 2 + wr) * 4 + wc) * 4 + fq) * 2 + (fr - 14)) * 8 + 4 * n) = acc[ai][0][3][n] * rstd[ai][3]; }
            asm volatile("s_waitcnt lgkmcnt(0)" ::: "memory"); __builtin_amdgcn_s_barrier(); asm volatile("" ::: "memory");
        }
        const int src1 = (lane & 48) | ((fr + 15) & 15), src2 = (lane & 48) | ((fr + 14) & 15);
#pragma unroll
        for (int n = 0; n < 2; ++n) {
            const f32x4 cb = *(const f32x4*)(conv_b + j0 + 4 * n), w0 = *(const f32x4*)(conv_w + j0 + 4 * n), w1 = *(const f32x4*)(conv_w + FF + j0 + 4 * n), w2 = *(const f32x4*)(conv_w + 2 * FF + j0 + 4 * n);
#pragma unroll
            for (int ai = 0; ai < 2; ++ai) {
                f32x4 pa = (f32x4){0.f, 0.f, 0.f, 0.f};
                if (!smp && fr >= 14 && (wr == 1 || ai == 1)) { const int sai = wr == 1 ? ai : 0, swr = wr == 1 ? 0 : 1;
                    pa = *(const PG8_LAS f32x4*)(xch + ((((sai * 2 + swr) * 4 + wc) * 4 + fq) * 2 + (fr - 14)) * 8 + 4 * n); }
#pragma unroll
                for (int m = 0; m < 4; ++m) {
                    const int r = row0 + ai * HALF + m * 16; const float rs = rstd[ai][m];
                    const f32x4 a = acc[ai][0][m][n] * rs, b = acc[ai][1][m][n] * rs; f32x4 p1, p2;
                    if (!smp) {
#pragma unroll
                        for (int e2 = 0; e2 < 4; ++e2) { const float s1 = fr == 15 ? pa[e2] : a[e2], s2 = fr >= 14 ? pa[e2] : a[e2]; p1[e2] = __shfl(s1, src1); p2[e2] = __shfl(s2, src2); }
                        if (ai == 0 && wr == 0 && m == 0 && fr < 2) { *(f32x4*)(EA + ((size_t)u.pm * 4 + fr) * FF + j0 + 4 * n) = a; *(f32x4*)(EB + ((size_t)u.pm * 2 + fr) * FF + j0 + 4 * n) = b; }
                        if (ai == 1 && wr == 1 && m == 3 && fr >= 14) { *(f32x4*)(EA + ((size_t)u.pm * 4 + 2 + (fr - 14)) * FF + j0 + 4 * n) = a;
                            if ((u.pm & 7) == 7) *(f32x4*)(o_conv_p + ((size_t)(u.pm >> 3) * 2 + (fr - 14)) * FF + j0 + 4 * n) = a; }
                    } else {
                        const int t = fr & 7, bb = (r - 16384) >> 3;
#pragma unroll
                        for (int e2 = 0; e2 < 4; ++e2) { p1[e2] = __shfl(a[e2], src1); p2[e2] = __shfl(a[e2], src2); }
                        if (t < 2) { const f32x4 h1 = *(const f32x4*)(state_conv + ((size_t)bb * 2 + 1) * FF + j0 + 4 * n);
                            if (t == 0) { p1 = h1; p2 = *(const f32x4*)(state_conv + ((size_t)bb * 2) * FF + j0 + 4 * n); } else p2 = h1; }
                        if (t >= 6) *(f32x4*)(o_conv_s + ((size_t)bb * 2 + (t - 6)) * FF + j0 + 4 * n) = a;
                    }
                    f32x4 hv;
#pragma unroll
                    for (int e2 = 0; e2 < 4; ++e2) { const float c = cb[e2] + w0[e2] * p2[e2] + w1[e2] * p1[e2] + w2[e2] * a[e2]; hv[e2] = gelu_t(c) * b[e2]; }
                    *(u32x2*)(HID + (size_t)r * FF + j0 + 4 * n) = (u32x2){cvt_pk_bf16(hv[0], hv[1]), cvt_pk_bf16(hv[2], hv[3])};
                    pa = a;
                }
            }
        }
    }
};
struct EpiResB {
    static constexpr bool PERM = true, AFTER_DRAIN = false;
    const bf16_t* XB; float* out;
    __device__ __forceinline__ void operator()(const f32x4 (&acc)[2][2][4][2], const Unit& u, int wr, int wc, int fr, int fq) const {
        const int row0 = u.pm * BM + wr * 64 + fr, cl = u.pn * BM + wc * 32 + 8 * fq;
#pragma unroll
        for (int ai = 0; ai < 2; ++ai)
#pragma unroll
            for (int m = 0; m < 4; ++m) { const int r = row0 + ai * HALF + m * 16; float* op = out + (size_t)r * 1024 + cl;
#pragma unroll
                for (int bj = 0; bj < 2; ++bj) { const u32x4 xb = *(const u32x4*)(XB + (size_t)r * 1024 + cl + bj * HALF);
                    f32x4 x0, x1;
                    x0[0] = __builtin_bit_cast(float, xb[0] << 16); x0[1] = __builtin_bit_cast(float, xb[0] & 0xffff0000u); x0[2] = __builtin_bit_cast(float, xb[1] << 16); x0[3] = __builtin_bit_cast(float, xb[1] & 0xffff0000u);
                    x1[0] = __builtin_bit_cast(float, xb[2] << 16); x1[1] = __builtin_bit_cast(float, xb[2] & 0xffff0000u); x1[2] = __builtin_bit_cast(float, xb[3] << 16); x1[3] = __builtin_bit_cast(float, xb[3] & 0xffff0000u);
                    *(f32x4*)(op + bj * HALF) = acc[ai][bj][m][0] + x0; *(f32x4*)(op + bj * HALF + 4) = acc[ai][bj][m][1] + x1; } }
    }
};
template <class Epi, class Sched, bool ALIGN_EPI = false, bool SP2 = false>
__device__ __forceinline__ void gemm_phase(PG8_LAS unsigned char* lds, const Gemm g, const Sched& S, const Epi& E) {
    const int tid = threadIdx.x, wid = __builtin_amdgcn_readfirstlane(tid >> 6), lane = tid & 63, wr = wid >> 2, wc = wid & 3, fr = lane & 15, fq = lane >> 4;
    const int K = g.K, nt = K / BK;
    unsigned voffA[2], voffB[2];
#pragma unroll
    for (int i = 0; i < 2; ++i) { int R, C; stage_rc(tid * 16 + i * 8192, R, C); const int Rb = Epi::PERM ? ((R & ~31) + perm32(R & 31)) : R;
        voffA[i] = (unsigned)(R * K + C) * 2u; voffB[i] = (unsigned)(Rb * K + C) * 2u; }
    const size_t kstep = (size_t)(BK * 2);
    const size_t hstep = (size_t)HALF * K * 2;
    const size_t tstep = 2 * hstep;
    const unsigned ldsw = (unsigned)wid * 1024u;
    const int aoff = lds_byte(wr * 64 + fr, fq * 8), boff = lds_byte(wc * 32 + fr, fq * 8);
#define PG8_SA(b, h) (((b) * 2 + (h)) * HTB)
#define PG8_SB(b, h) ((4 + (b) * 2 + (h)) * HTB)
#define PG8_STAGE(bufoff, gbase, voff) do { _Pragma("unroll") for (int _i = 0; _i < 2; ++_i) \
        __builtin_amdgcn_global_load_lds((const unsigned*)((const char*)(gbase) + (voff)[_i]), (PG8_LAS unsigned*)(lds + (bufoff) + ldsw + _i * 8192), 16, 0, 0); } while (0)
#define PG8_LDA(dst, b, h) do { _Pragma("unroll") for (int m = 0; m < 4; ++m) _Pragma("unroll") for (int k = 0; k < 2; ++k) dst[m][k] = *(const PG8_LAS bf16x8*)(lds + PG8_SA(b, h) + aoff + m * 2048 + k * 1024); } while (0)
#define PG8_LDB(dst, b, h) do { _Pragma("unroll") for (int n = 0; n < 2; ++n) _Pragma("unroll") for (int k = 0; k < 2; ++k) dst[n][k] = *(const PG8_LAS bf16x8*)(lds + PG8_SB(b, h) + boff + n * 2048 + k * 1024); } while (0)
#define PG8_MMA(ai, bj, At, Bt) do { __builtin_amdgcn_s_setprio(1); _Pragma("unroll") for (int m = 0; m < 4; ++m) _Pragma("unroll") for (int n = 0; n < 2; ++n) _Pragma("unroll") for (int k = 0; k < 2; ++k) \
        acc[ai][bj][m][n] = __builtin_amdgcn_mfma_f32_16x16x32_bf16(Bt[n][k], At[m][k], acc[ai][bj][m][n], 0, 0, 0); __builtin_amdgcn_s_setprio(0); } while (0)
#define PG8_WAIT_V(n) asm volatile("s_waitcnt vmcnt(" #n ")" ::: "memory")
#define PG8_WAIT_L(n) asm volatile("s_waitcnt lgkmcnt(" #n ")" ::: "memory")
#define PG8_BAR __builtin_amdgcn_s_barrier()
#define PG8_SCHED __builtin_amdgcn_sched_barrier(0)
    Unit cur, nxt; int ui = 0;
    if (!S.next(0, cur)) return;
    f32x4 acc[2][2][4][2];
#pragma unroll
    for (int a = 0; a < 2; ++a)
#pragma unroll
        for (int b = 0; b < 2; ++b)
#pragma unroll
            for (int m = 0; m < 4; ++m)
#pragma unroll
                for (int n = 0; n < 2; ++n) acc[a][b][m][n] = (f32x4){0.f, 0.f, 0.f, 0.f};
    bf16x8 At[4][2], B0[2][2], B1[2][2];
    const char* cA = (const char*)g.A + (size_t)cur.pm * tstep; const char* cB = (const char*)g.Bt + (size_t)cur.pn * tstep;
    S.a_ready(cur);
    if constexpr (SP2) {
        PG8_STAGE(PG8_SB(0, 0), cB, voffB); PG8_STAGE(PG8_SB(0, 1), cB + hstep, voffB); PG8_STAGE(PG8_SA(0, 0), cA, voffA); PG8_STAGE(PG8_SA(0, 1), cA + hstep, voffA);
        if (wr == 1) PG8_BAR;
        PG8_WAIT_V(2); PG8_BAR;
        PG8_STAGE(PG8_SB(1, 0), cB + kstep, voffB); PG8_STAGE(PG8_SA(1, 0), cA + kstep, voffA); PG8_STAGE(PG8_SB(1, 1), cB + hstep + kstep, voffB);
        PG8_WAIT_V(6); PG8_BAR;
    } else {
        PG8_STAGE(PG8_SB(0, 0), cB, voffB); PG8_STAGE(PG8_SA(0, 0), cA, voffA); PG8_STAGE(PG8_SB(0, 1), cB + hstep, voffB); PG8_STAGE(PG8_SA(0, 1), cA + hstep, voffA);
        if (wr == 1) PG8_BAR;
        PG8_WAIT_V(4); PG8_BAR;
        PG8_STAGE(PG8_SB(1, 0), cB + kstep, voffB); PG8_STAGE(PG8_SA(1, 0), cA + kstep, voffA); PG8_STAGE(PG8_SB(1, 1), cB + hstep + kstep, voffB);
        PG8_WAIT_V(6); PG8_BAR;
    }
    for (;;) {
        const bool has_next = S.next(ui + 1, nxt);
        const char* nA = has_next ? (const char*)g.A + (size_t)nxt.pm * tstep : cA; const char* nB = has_next ? (const char*)g.Bt + (size_t)nxt.pn * tstep : cB;
        for (int t = 0; t < nt; t += 2) {
            const bool last = (t == nt - 2);
            const char* a1 = cA + (size_t)(t + 1) * kstep;
            const char* a2 = last ? nA : cA + (size_t)(t + 2) * kstep; const char* b2 = last ? nB : cB + (size_t)(t + 2) * kstep;
            const char* a3 = a2 + kstep; const char* b3 = b2 + kstep;
            if (last && has_next) S.a_ready(nxt);
            if constexpr (SP2) {
            PG8_LDB(B0, 0, 0); PG8_LDB(B1, 0, 1); PG8_SCHED; PG8_LDA(At, 0, 0); PG8_STAGE(PG8_SA(1, 1), a1 + hstep, voffA);
            PG8_WAIT_V(8); PG8_WAIT_L(0); PG8_BAR; PG8_MMA(0, 0, At, B0); PG8_MMA(0, 1, At, B1); PG8_BAR; PG8_SCHED;
            PG8_LDA(At, 0, 1); PG8_STAGE(PG8_SB(0, 0), b2, voffB); PG8_STAGE(PG8_SB(0, 1), b2 + hstep, voffB); PG8_STAGE(PG8_SA(0, 0), a2, voffA);
            PG8_WAIT_V(8); PG8_WAIT_L(0); PG8_BAR; PG8_MMA(1, 0, At, B0); PG8_MMA(1, 1, At, B1); PG8_BAR; PG8_SCHED;
            PG8_LDB(B0, 1, 0); PG8_LDB(B1, 1, 1); PG8_SCHED; PG8_LDA(At, 1, 0); PG8_STAGE(PG8_SA(0, 1), a2 + hstep, voffA);
            PG8_WAIT_V(8); PG8_WAIT_L(0); PG8_BAR; PG8_MMA(0, 0, At, B0); PG8_MMA(0, 1, At, B1); PG8_BAR; PG8_SCHED;
            PG8_LDA(At, 1, 1); PG8_STAGE(PG8_SB(1, 0), b3, voffB); PG8_STAGE(PG8_SB(1, 1), b3 + hstep, voffB); PG8_STAGE(PG8_SA(1, 0), a3, voffA);
            PG8_WAIT_V(8); PG8_WAIT_L(0); PG8_BAR; PG8_MMA(1, 0, At, B0); PG8_MMA(1, 1, At, B1); PG8_BAR; PG8_SCHED;
            } else {
            PG8_LDB(B0, 0, 0); PG8_SCHED; PG8_LDA(At, 0, 0); PG8_STAGE(PG8_SA(1, 1), a1 + hstep, voffA);
            PG8_WAIT_L(8); PG8_BAR; PG8_WAIT_L(0); PG8_MMA(0, 0, At, B0); PG8_BAR; PG8_SCHED;
            PG8_LDB(B1, 0, 1); PG8_STAGE(PG8_SB(0, 0), b2, voffB);
            PG8_BAR; PG8_WAIT_L(0); PG8_MMA(0, 1, At, B1); PG8_BAR;
            PG8_LDA(At, 0, 1); PG8_STAGE(PG8_SA(0, 0), a2, voffA);
            PG8_BAR; PG8_WAIT_L(0); PG8_MMA(1, 0, At, B0); PG8_BAR; PG8_SCHED;
            PG8_STAGE(PG8_SB(0, 1), b2 + hstep, voffB);
            PG8_WAIT_V(6); PG8_BAR; PG8_MMA(1, 1, At, B1); PG8_BAR;
            PG8_LDB(B0, 1, 0); PG8_SCHED; PG8_LDA(At, 1, 0); PG8_STAGE(PG8_SA(0, 1), a2 + hstep, voffA);
            PG8_WAIT_L(8); PG8_BAR; PG8_WAIT_L(0); PG8_MMA(0, 0, At, B0); PG8_BAR; PG8_SCHED;
            PG8_LDB(B1, 1, 1); PG8_STAGE(PG8_SB(1, 0), b3, voffB);
            PG8_BAR; PG8_WAIT_L(0); PG8_MMA(0, 1, At, B1); PG8_BAR;
            PG8_LDA(At, 1, 1); PG8_STAGE(PG8_SA(1, 0), a3, voffA);
            PG8_BAR; PG8_WAIT_L(0); PG8_MMA(1, 0, At, B0); PG8_BAR; PG8_SCHED;
            PG8_STAGE(PG8_SB(1, 1), b3 + hstep, voffB);
            PG8_WAIT_V(6); PG8_BAR; PG8_MMA(1, 1, At, B1); PG8_BAR;
            }
        }
        if constexpr (ALIGN_EPI) { if (wr == 0) PG8_BAR; }
        if constexpr (!Epi::AFTER_DRAIN) { E(acc, cur, wr, wc, fr, fq); S.done(cur); }
        if (!has_next) break;
#pragma unroll
        for (int a = 0; a < 2; ++a)
#pragma unroll
            for (int b = 0; b < 2; ++b)
#pragma unroll
                for (int m = 0; m < 4; ++m)
#pragma unroll
                    for (int n = 0; n < 2; ++n) acc[a][b][m][n] = (f32x4){0.f, 0.f, 0.f, 0.f};
        cur = nxt; cA = nA; cB = nB; ++ui;
        if constexpr (ALIGN_EPI) { if (wr == 1) PG8_BAR; }
    }
    PG8_WAIT_V(0);
    if constexpr (!ALIGN_EPI) { if (wr == 0) PG8_BAR; }
    PG8_BAR;
    if constexpr (Epi::AFTER_DRAIN) { E.fused(acc, cur, wr, wc, fr, fq, lds, wid, lane); S.done(cur); }
#undef PG8_SA
#undef PG8_SB
#undef PG8_STAGE
#undef PG8_LDA
#undef PG8_LDB
#undef PG8_MMA
#undef PG8_WAIT_V
#undef PG8_WAIT_L
#undef PG8_BAR
#undef PG8_SCHED
}
}
#define GAS __attribute__((address_space(1)))
#define LAS __attribute__((address_space(3)))
typedef unsigned short bf16;
typedef unsigned v4u __attribute__((ext_vector_type(4)));
typedef float f32x4 __attribute__((ext_vector_type(4)));
typedef short bf16x8 __attribute__((ext_vector_type(8)));
typedef GAS unsigned gu32;
typedef GAS unsigned long long gu64;
#define RLX_AGENT __ATOMIC_RELAXED, __HIP_MEMORY_SCOPE_AGENT
#define LDS_WAIT() asm volatile("s_waitcnt lgkmcnt(0)" ::: "memory")
#define VM_WAIT() asm volatile("s_waitcnt vmcnt(0)" ::: "memory")
__device__ __forceinline__ unsigned long long rt() { return __builtin_amdgcn_s_memrealtime(); }
__device__ __forceinline__ unsigned f2bf(float f) { unsigned u = __builtin_bit_cast(unsigned, f); return (u + 0x7fffu + ((u >> 16) & 1u)) >> 16; }
__device__ __forceinline__ unsigned pk2(float lo, float hi) { return f2bf(lo) | (f2bf(hi) << 16); }

#define XB_TMO      128
#define XB_XCNT(j)  (256  + 64 * (j))
#define XB_XSUB(j)  (1280 + 64 * (j))
#define XB_XGEN(j)  (2304 + 64 * (j))
#define XB_TOP      3328
#define XB_TOPGEN   3392
#define XCD_BAR_WORDS 3456
#define XB_SPIN_CAP (1u << 18)

__device__ __forceinline__ unsigned xb_ld(unsigned* p)              { return __hip_atomic_load(p, __ATOMIC_RELAXED, __HIP_MEMORY_SCOPE_AGENT); }
__device__ __forceinline__ unsigned xb_add(unsigned* p, unsigned v) { return __hip_atomic_fetch_add(p, v, __ATOMIC_RELAXED, __HIP_MEMORY_SCOPE_AGENT); }
__device__ __forceinline__ unsigned xb_xcc_id() { return (unsigned)__builtin_amdgcn_s_getreg((3 << 11) | 20) & 0xFu; }
#define XB_SPIN(cond, bar) do { unsigned _sp = 0; while (cond) { __builtin_amdgcn_s_sleep(1); \
    if ((++_sp & 255u) == 0u) { if (xb_ld(&(bar)[XB_TMO])) break; if (_sp > XB_SPIN_CAP) { atomicAdd(&(bar)[XB_TMO], 1u); break; } } } } while (0)

struct XcdBarrier {
    unsigned* bar; unsigned x;
    volatile LAS unsigned* st;
};

__device__ __forceinline__ XcdBarrier xcd_barrier_post(unsigned* bar, volatile LAS unsigned* st) {
    XcdBarrier b; b.bar = bar; b.x = xb_xcc_id(); b.st = st;
    if (threadIdx.x == 0) (void)xb_add(&bar[XB_XCNT(b.x)], 1u);
    return b;
}
__device__ __forceinline__ void xcd_barrier_complete(unsigned* bar, unsigned x, unsigned& nloc, unsigned& nx) {
    const unsigned G = gridDim.x * gridDim.y * gridDim.z;
    unsigned sum, cnt, mine, sp = 0u;
    for (;;) {
        sum = 0u; cnt = 0u; mine = 0u;
#pragma unroll
        for (unsigned j = 0; j < 16; ++j) { const unsigned c = xb_ld(&bar[XB_XCNT(j)]); sum += c; cnt += (c > 0u) ? 1u : 0u; mine = (j == x) ? c : mine; }
        if (sum == G) break;
        __builtin_amdgcn_s_sleep(1);
        if ((++sp & 255u) == 0u) { if (xb_ld(&bar[XB_TMO])) break; if (sp > XB_SPIN_CAP) { atomicAdd(&bar[XB_TMO], 1u); break; } }
    }
    nloc = mine > 0u ? mine : 1u; nx = cnt > 0u ? cnt : 1u;
}

__device__ __forceinline__ void xcd_barrier(const XcdBarrier& b) {
    asm volatile("s_waitcnt vmcnt(0)" ::: "memory");
    __syncthreads();
    if (threadIdx.x == 0) {
        unsigned* bar = b.bar;
        __builtin_amdgcn_s_waitcnt(0);
        unsigned nloc = b.st[0], nx = b.st[1];
        if (nloc == 0u) { xcd_barrier_complete(bar, b.x, nloc, nx); b.st[0] = nloc; b.st[1] = nx; }
        const unsigned old = xb_add(&bar[XB_XSUB(b.x)], 1u);
        const unsigned gen = old / nloc;
        if (old + 1u == (gen + 1u) * nloc) {
            __builtin_amdgcn_fence(__ATOMIC_RELEASE, "agent");
            asm volatile("s_waitcnt vmcnt(0)" ::: "memory");
            const unsigned og = xb_add(&bar[XB_TOP], 1u);
            const unsigned tg = og / nx;
            if (og + 1u == (tg + 1u) * nx) xb_add(&bar[XB_TOPGEN], 1u);
            else XB_SPIN(xb_ld(&bar[XB_TOPGEN]) == tg, bar);
            __builtin_amdgcn_fence(__ATOMIC_ACQUIRE, "agent");
            xb_add(&bar[XB_XGEN(b.x)], 1u);
            asm volatile("s_waitcnt vmcnt(0)" ::: "memory");
        } else {
            XB_SPIN(xb_ld(&bar[XB_XGEN(b.x)]) == gen, bar);
            __builtin_amdgcn_fence(__ATOMIC_ACQUIRE, "agent");
            asm volatile("s_waitcnt vmcnt(0)" ::: "memory");
        }
    }
    __syncthreads();
}
__device__ __forceinline__ float wave_sum(float v) {
#pragma unroll
    for (int o = 1; o < 64; o <<= 1) v += __shfl_xor(v, o);
    return v;
}
__device__ __forceinline__ void p0_transpose_item(const float* W, int K, int N, bf16* WT, int row_off, LAS float* scr, int item, int lane) {
    const int nblk = N / 32, kb = item / nblk, nb = item % nblk, k0 = 64 * kb, n0 = 32 * nb;
    { const int kk = lane >> 3, n4 = (lane & 7) * 4; f32x4 v[8];
#pragma unroll
      for (int i = 0; i < 8; ++i) v[i] = *(const GAS f32x4*)(W + (size_t)(k0 + kk + 8 * i) * N + n0 + n4);
#pragma unroll
      for (int i = 0; i < 8; ++i) { LAS float* d = scr + (kk + 8 * i) * 33 + n4; d[0] = v[i][0]; d[1] = v[i][1]; d[2] = v[i][2]; d[3] = v[i][3]; } }
    LDS_WAIT(); asm volatile("" ::: "memory");
    const int c = lane & 7;
#pragma unroll
    for (int j = 0; j < 4; ++j) { const int n = (lane >> 3) + 8 * j; const LAS float* s = scr + (8 * c) * 33 + n;
        v4u o; o.x = pk2(s[0 * 33], s[1 * 33]); o.y = pk2(s[2 * 33], s[3 * 33]); o.z = pk2(s[4 * 33], s[5 * 33]); o.w = pk2(s[6 * 33], s[7 * 33]);
        *(GAS v4u*)(WT + (size_t)(row_off + n0 + n) * K + k0 + 8 * c) = o; }
    LDS_WAIT(); asm volatile("" ::: "memory");
}
constexpr int NWAVES = 8;
constexpr int D = 1024, TP = 16384, TS = 1024, MT = TP + TS, MEMR = 2048, DIN = 2560, DFF = 2816, NMEM = 256;
constexpr float EPS = 1e-6f;
#ifndef MK_PER_PHASE
#define MK_PER_PHASE 0
#endif
constexpr int NPHASE = 9;
constexpr size_t MiB = 1u << 20;
constexpr size_t WS_CTL = 0, CTL_ZERO_BYTES = 64 * 1024;
constexpr size_t WS_WIN = 1 * MiB, WS_WKV = 6 * MiB, WS_WOUT = 7 * MiB, WS_WUP = 9 * MiB, WS_WDN = 20 * MiB;
constexpr size_t WS_XN = 26 * MiB;
constexpr size_t WS_XNM = 60 * MiB;
constexpr size_t WS_KVB = 64 * MiB;
constexpr size_t WS_HU = 66 * MiB, WS_HD = 82 * MiB;
constexpr size_t WS_MIX = 83 * MiB;
constexpr size_t WS_U = 117 * MiB, WS_Q = 134 * MiB, WS_LOGF = 151 * MiB, WS_KK = 185 * MiB, WS_V = 202 * MiB, WS_G = 219 * MiB, WS_QX = 236 * MiB;
constexpr size_t WS_EA = 64 * MiB, WS_EB = 68 * MiB, WS_ROWSS = 70 * MiB, WS_ROWSS_S = 72 * MiB;
constexpr size_t WS_PA = 64 * MiB, WS_PB = 158 * MiB;
constexpr size_t WS_END = 256 * MiB;
static_assert(WS_QX + (size_t)MT * 256 * 2 <= WS_END && WS_PB + (size_t)MT * DFF * 2 <= WS_END && WS_PA + (size_t)MT * DFF * 2 <= WS_PB, "d_ws map");
constexpr int CW_BAR = 4096;
constexpr int RING_BYTES = 131072, LDSCTL_OFF = RING_BYTES, MISC_OFF = LDSCTL_OFF + 320, LDS_BYTES = 147456;

struct Args { const float* in[23]; float* out; unsigned char* ws; int ph_lo, ph_hi; };
struct Frame {
    LAS unsigned char* lds; int tid, lane, wave, G;
    const float *x_prompt, *x_sample, *mem_prompt, *state_pool, *state_hgrn, *state_conv, *cache_k, *cache_v, *ln1_g, *w_in, *pool_w, *pool_scale, *lb_logits, *onorm_g, *mem_norm_g, *w_mem_kv, *w_out, *ln2_g, *w_up, *conv_w, *conv_b, *w_down, *lnf_g;
    float *y, *o_pool_p, *o_hgrn_p, *o_conv_p, *o_mk, *o_mv, *o_pool_s, *o_hgrn_s, *o_conv_s;
    bf16 *WIN, *WKV, *WOUT, *WUP, *WDN, *XN, *XNM, *KVB, *MIX, *Q, *KK, *V, *GS, *QX, *PA, *PB;
    float *U, *LOGF, *EA, *EB, *ROWSS, *ROWSS_S;
};
typedef unsigned u32x2v __attribute__((ext_vector_type(2)));
__device__ __forceinline__ float bf2f(bf16 h) { return __builtin_bit_cast(float, (unsigned)h << 16); }
__device__ __forceinline__ float frcp_(float x) { return __builtin_amdgcn_rcpf(x); }
__device__ __forceinline__ float wave_max(float v) {
#pragma unroll
    for (int o = 1; o < 64; o <<= 1) v = fmaxf(v, __shfl_xor(v, o));
    return v;
}
__device__ __forceinline__ void rms_row_to_bf16(int lane, const float* xrow, const float* g, bf16* orow) {
    const GAS f32x4* xr = (const GAS f32x4*)xrow + lane; const GAS f32x4* gr = (const GAS f32x4*)g + lane;
    f32x4 v[4]; float s = 0.f;
#pragma unroll
    for (int j = 0; j < 4; ++j) { v[j] = xr[64 * j]; s += (v[j].x * v[j].x + v[j].y * v[j].y) + (v[j].z * v[j].z + v[j].w * v[j].w); }
    const float rstd = 1.f / sqrtf(wave_sum(s) * (1.f / D) + EPS);
    GAS unsigned long long* o8 = (GAS unsigned long long*)orow + lane;
#pragma unroll
    for (int j = 0; j < 4; ++j) { const f32x4 gg = gr[64 * j]; o8[64 * j] = (unsigned long long)pk2(v[j].x * rstd * gg.x, v[j].y * rstd * gg.y) | ((unsigned long long)pk2(v[j].z * rstd * gg.z, v[j].w * rstd * gg.w) << 32); }
}
__device__ __forceinline__ void p0_transpose_item2(const float* W, int K, int N, bf16* WT, int dst_row0, const float* gain, LAS float* scr, int kb, int nb, int lane) {
    const int k0 = 64 * kb, n0 = 32 * nb;
    { const int kk = lane >> 3, n4 = (lane & 7) * 4; f32x4 v[8];
#pragma unroll
      for (int i = 0; i < 8; ++i) v[i] = *(const GAS f32x4*)(W + (size_t)(k0 + kk + 8 * i) * N + n0 + n4);
#pragma unroll
      for (int i = 0; i < 8; ++i) { LAS float* d = scr + (kk + 8 * i) * 33 + n4; d[0] = v[i][0]; d[1] = v[i][1]; d[2] = v[i][2]; d[3] = v[i][3]; } }
    LDS_WAIT(); asm volatile("" ::: "memory");
    const int c = lane & 7; float gg[8];
#pragma unroll
    for (int e = 0; e < 8; ++e) gg[e] = gain[k0 + 8 * c + e];
#pragma unroll
    for (int j = 0; j < 4; ++j) { const int n = (lane >> 3) + 8 * j; const LAS float* s = scr + (8 * c) * 33 + n;
        v4u o; o.x = pk2(s[0 * 33] * gg[0], s[1 * 33] * gg[1]); o.y = pk2(s[2 * 33] * gg[2], s[3 * 33] * gg[3]); o.z = pk2(s[4 * 33] * gg[4], s[5 * 33] * gg[5]); o.w = pk2(s[6 * 33] * gg[6], s[7 * 33] * gg[7]);
        *(GAS v4u*)(WT + (size_t)(dst_row0 + n) * K + k0 + 8 * c) = o; }
    LDS_WAIT(); asm volatile("" ::: "memory");
}
__device__ __forceinline__ void p0_prologue(Frame& F) {
    LAS float* scr = (LAS float*)(F.lds + F.wave * 16384);
    const int gw = blockIdx.x * NWAVES + F.wave, NGW = F.G * NWAVES;
    constexpr int I_IN = (D / 64) * (DIN / 32), I_KV = (D / 64) * (512 / 32);
    for (int it = gw; it < I_IN + I_KV; it += NGW) {
        if (it < I_IN) p0_transpose_item(F.w_in, D, DIN, F.WIN, 0, scr, it, F.lane);
        else p0_transpose_item(F.w_mem_kv, D, 512, F.WKV, 0, scr, it - I_IN, F.lane);
    }
    for (int m = gw; m < MT + MEMR; m += NGW) {
        if (m < TP) rms_row_to_bf16(F.lane, F.x_prompt + (size_t)m * D, F.ln1_g, F.XN + (size_t)m * D);
        else if (m < MT) rms_row_to_bf16(F.lane, F.x_sample + (size_t)(m - TP) * D, F.ln1_g, F.XN + (size_t)m * D);
        else rms_row_to_bf16(F.lane, F.mem_prompt + (size_t)(m - MT) * D, F.mem_norm_g, F.XNM + (size_t)(m - MT) * D);
    }
}
__device__ __forceinline__ void p0_late(Frame& F, int gw, int NGW) {
    LAS float* scr = (LAS float*)(F.lds + F.wave * 16384);
    constexpr int I_OUT = (D / 64) * (D / 32), I_UP = (D / 64) * (2 * DFF / 32), I_DN = (DFF / 64) * (D / 32);
    for (int it = gw; it < I_OUT + I_UP + I_DN; it += NGW) {
        int r = it;
        if (r < I_OUT) { if (r >= 4 * (D / 32)) p0_transpose_item(F.w_out, D, D, F.WOUT, 0, scr, r, F.lane); continue; } r -= I_OUT;
        if (r < I_UP) { const int nblk = 2 * DFF / 32, kb = r / nblk, nb = r % nblk, n0 = 32 * nb, j = n0 < DFF ? n0 : n0 - DFF;
            p0_transpose_item2(F.w_up, D, 2 * DFF, F.WUP, (j >> 7) * 256 + (j & 127) + (n0 < DFF ? 0 : 128), F.ln2_g, scr, kb, nb, F.lane); continue; } r -= I_UP;
        p0_transpose_item(F.w_down, DFF, D, F.WDN, 0, scr, r, F.lane);
    }
    for (int it = gw; it < 2048; it += NGW) { const int g = it >> 9, c2 = (it >> 4) & 31, n = (it & 15) * 64 + F.lane;
        const float* p0 = F.pool_w + (size_t)g * 4096 + (2 * c2) * 64; const float* p1 = p0 + 64; float o0 = 0.f, o1 = 0.f;
#pragma unroll
        for (int dd = 0; dd < 64; ++dd) { const float sw = F.pool_scale[64 * g + dd] * F.w_out[(size_t)(64 * g + dd) * D + n]; o0 += p0[dd] * sw; o1 += p1[dd] * sw; }
        *(GAS unsigned*)(F.WOUT + (size_t)n * D + 64 * g + 2 * c2) = pk2(o0, o1); }
}
__device__ __forceinline__ void pool_phase(Frame& F) {
    const int total = (MT / 8) * 64;
    for (int i = blockIdx.x * 512 + F.tid; i < total; i += F.G * 512) {
        const int r0 = (i >> 6) * 8, c = (i & 63) * 4, g = c >> 6; const bool smp = r0 >= TP; const int rr = smp ? r0 - TP : r0; const int b = smp ? rr >> 3 : rr >> 11, t0 = smp ? 0 : rr & 2047;
        const float* ub = F.U + (size_t)(r0 - t0) * 256 + c;
        f32x4 x[23];
#pragma unroll
        for (int k = 0; k < 23; ++k) { const int tau = t0 - 15 + k;
            if (tau >= 0) x[k] = *(const GAS f32x4*)(ub + (size_t)tau * 256); else if (smp) x[k] = *(const GAS f32x4*)(F.state_pool + ((size_t)b * 15 + 15 + tau) * 256 + c); else x[k] = (f32x4){0.f, 0.f, 0.f, 0.f}; }
        f32x4 s2[23], s4[23], s8[23], s16[8];
#pragma unroll
        for (int k = 1; k < 23; ++k) s2[k] = x[k] + x[k - 1];
#pragma unroll
        for (int k = 3; k < 23; ++k) s4[k] = s2[k] + s2[k - 2];
#pragma unroll
        for (int k = 7; k < 23; ++k) s8[k] = s4[k] + s4[k - 4];
#pragma unroll
        for (int k = 0; k < 8; ++k) s16[k] = s8[15 + k] + s8[7 + k];
        const float wf = (float)(2 << g);
#pragma unroll
        for (int k = 0; k < 8; ++k) { const int t = t0 + k;
            const f32x4 s = g == 0 ? s2[15 + k] : g == 1 ? s4[15 + k] : g == 2 ? s8[15 + k] : s16[k];
            const float cnt = smp ? wf : fminf(wf, (float)(t + 1));
            const f32x4 dd = s * (1.f / cnt) - x[15 + k];
            *(GAS u32x2v*)(F.MIX + (size_t)(r0 + k) * D + c) = (u32x2v){pk2(dd[0], dd[1]), pk2(dd[2], dd[3])}; }
        if (smp || t0 == 2040) { float* np = (smp ? F.o_pool_s : F.o_pool_p) + (size_t)b * 15 * 256 + c;
#pragma unroll
            for (int k = 0; k < 15; ++k) *(GAS f32x4*)(np + k * 256) = x[8 + k]; }
    }
}
__device__ __forceinline__ void hgrn_naive_phase(Frame& F) {
    LAS float* qs = (LAS float*)F.lds; LAS float* fs = qs + 128; LAS float* ks = fs + 128; LAS float* part = ks + 128; LAS float* red = part + 512;
    const int tid = F.tid, dv = tid & 127, qd = tid >> 7;
    for (int u = blockIdx.x; u < 32 + 512; u += F.G) {
        const bool smp = u >= 32; const int bh = smp ? u - 32 : u, b = bh >> 2, h = bh & 3, L = smp ? 8 : 2048, row0 = smp ? TP + b * 8 : b * 2048;
        float S[32];
#pragma unroll
        for (int j = 0; j < 32; ++j) S[j] = smp ? F.state_hgrn[(((size_t)b * 4 + h) * 128 + qd * 32 + j) * 128 + dv] : 0.f;
        for (int t = 0; t < L; ++t) {
            const size_t ro = (size_t)(row0 + t) * 512 + h * 128;
            if (tid < 128) { qs[tid] = bf2f(F.Q[ro + tid]); fs[tid] = __expf(F.LOGF[ro + tid]); ks[tid] = bf2f(F.KK[ro + tid]); }
            const float v = bf2f(F.V[ro + dv]);
            __syncthreads();
            float op = 0.f;
#pragma unroll
            for (int j = 0; j < 32; ++j) { const int dk = qd * 32 + j; S[j] = fs[dk] * S[j] + ks[dk] * v; op += qs[dk] * S[j]; }
            part[qd * 128 + dv] = op;
            __syncthreads();
            const float o = (part[dv] + part[128 + dv]) + (part[256 + dv] + part[384 + dv]);
            const float ss = wave_sum(o * o);
            if (F.lane == 0) red[F.wave] = ss;
            __syncthreads();
            if (qd == 0) { const float tot = red[0] + red[1];
                F.MIX[(size_t)(row0 + t) * D + 256 + h * 128 + dv] = (bf16)f2bf(o * (1.f / sqrtf(tot * (1.f / 128.f) + EPS)) * F.onorm_g[h * 128 + dv] * bf2f(F.GS[ro + dv])); }
        }
        float* so = (smp ? F.o_hgrn_s : F.o_hgrn_p) + ((size_t)b * 4 + h) * 128 * 128;
#pragma unroll
        for (int j = 0; j < 32; ++j) so[(size_t)(qd * 32 + j) * 128 + dv] = S[j];
        __syncthreads();
    }
}
__device__ __forceinline__ void xattn_naive_phase(Frame& F) {
    const int half = F.tid >> 8, t2 = F.tid & 255, wv = t2 >> 6;
    LAS float* q = (LAS float*)F.lds + half * 1024; LAS float* p = q + 64; LAS float* red = p + 256; LAS float* po = red + 8;
    for (int it = blockIdx.x; it < MT * 2; it += F.G) {
        const int item = it * 2 + half, r = item >> 2, h = item & 3; const bool smp = r >= TP; const int b = smp ? (r - TP) >> 3 : r >> 11;
        if (t2 < 64) q[t2] = bf2f(F.QX[(size_t)r * 256 + h * 64 + t2]);
        __syncthreads();
        float s = 0.f;
        if (smp) { const float* kr = F.cache_k + ((size_t)b * NMEM + t2) * 256 + h * 64; for (int d = 0; d < 64; ++d) s += q[d] * kr[d]; }
        else { const bf16* kr = F.KVB + ((size_t)b * NMEM + t2) * 512 + h * 64; for (int d = 0; d < 64; ++d) s += q[d] * bf2f(kr[d]); }
        float m = wave_max(s);
        if (F.lane == 0) red[wv] = m;
        __syncthreads();
        m = fmaxf(fmaxf(red[0], red[1]), fmaxf(red[2], red[3]));
        const float e = exp2f(s - m);
        p[t2] = e;
        float sum = wave_sum(e);
        __syncthreads();
        if (F.lane == 0) red[wv] = sum;
        __syncthreads();
        sum = (red[0] + red[1]) + (red[2] + red[3]);
        const int d = t2 & 63, pt = t2 >> 6; float o = 0.f;
        if (smp) { for (int mm = pt * 64; mm < pt * 64 + 64; ++mm) o += p[mm] * F.cache_v[((size_t)b * NMEM + mm) * 256 + h * 64 + d]; }
        else { for (int mm = pt * 64; mm < pt * 64 + 64; ++mm) o += p[mm] * bf2f(F.KVB[((size_t)b * NMEM + mm) * 512 + 256 + h * 64 + d]); }
        po[pt * 64 + d] = o;
        __syncthreads();
        if (t2 < 64) F.MIX[(size_t)r * D + 768 + h * 64 + t2] = (bf16)f2bf(((po[t2] + po[64 + t2]) + (po[128 + t2] + po[192 + t2])) / sum);
        __syncthreads();
    }
}
__device__ __forceinline__ void norm2_phase(Frame& F) {
    const int gw = blockIdx.x * NWAVES + F.wave, NGW = F.G * NWAVES;
    for (int m = gw; m < MT; m += NGW) rms_row_to_bf16(F.lane, F.y + (size_t)m * D, F.ln2_g, F.XN + (size_t)m * D);
}
__device__ __forceinline__ void final_norm_phase(Frame& F) {
    const int gw = blockIdx.x * NWAVES + F.wave, NGW = F.G * NWAVES;
    for (int m = gw; m < MT; m += NGW) {
        GAS f32x4* xr = (GAS f32x4*)(F.y + (size_t)m * D) + F.lane; const GAS f32x4* gr = (const GAS f32x4*)F.lnf_g + F.lane;
        f32x4 v[4]; float s = 0.f;
#pragma unroll
        for (int j = 0; j < 4; ++j) { v[j] = xr[64 * j]; s += (v[j].x * v[j].x + v[j].y * v[j].y) + (v[j].z * v[j].z + v[j].w * v[j].w); }
        const float rstd = 1.f / sqrtf(wave_sum(s) * (1.f / D) + EPS);
#pragma unroll
        for (int j = 0; j < 4; ++j) xr[64 * j] = v[j] * rstd * gr[64 * j];
    }
}
__device__ __forceinline__ float gelu_tanh(float x) { const float u2 = 1.5957691216057308f * (x + 0.044715f * x * x * x); return x * frcp_(1.f + __expf(-u2)); }
__device__ __forceinline__ void conv_fixup_phase(Frame& F) {
    const int total = 56 * 2 * (DFF / 4);
    for (int i = blockIdx.x * 512 + F.tid; i < total; i += F.G * 512) {
        const int j = (i % (DFF / 4)) * 4, k = (i / (DFF / 4)) & 1, q = i / (DFF / 2), pm = (q / 7) * 8 + 1 + (q % 7);
        const f32x4 a0 = *(const GAS f32x4*)(F.EA + ((size_t)pm * 4 + k) * DFF + j);
        const f32x4 a1 = k == 0 ? *(const GAS f32x4*)(F.EA + ((size_t)(pm - 1) * 4 + 3) * DFF + j) : *(const GAS f32x4*)(F.EA + ((size_t)pm * 4 + 0) * DFF + j);
        const f32x4 a2 = k == 0 ? *(const GAS f32x4*)(F.EA + ((size_t)(pm - 1) * 4 + 2) * DFF + j) : *(const GAS f32x4*)(F.EA + ((size_t)(pm - 1) * 4 + 3) * DFF + j);
        const f32x4 bv = *(const GAS f32x4*)(F.EB + ((size_t)pm * 2 + k) * DFF + j);
        const f32x4 cb = *(const GAS f32x4*)(F.conv_b + j), w0 = *(const GAS f32x4*)(F.conv_w + j), w1 = *(const GAS f32x4*)(F.conv_w + DFF + j), w2 = *(const GAS f32x4*)(F.conv_w + 2 * DFF + j);
        float h[4];
#pragma unroll
        for (int e = 0; e < 4; ++e) h[e] = gelu_tanh(cb[e] + w0[e] * a2[e] + w1[e] * a1[e] + w2[e] * a0[e]) * bv[e];
        *(GAS u32x2v*)(F.PB + (size_t)(pm * 256 + k) * DFF + j) = (u32x2v){pk2(h[0], h[1]), pk2(h[2], h[3])};
    }
}
__device__ __forceinline__ void conv_phase(Frame& F) {
    const int total = MT * (DFF / 8);
    for (int i = blockIdx.x * 512 + F.tid; i < total; i += F.G * 512) {
        const int r = i / (DFF / 8), j0 = (i % (DFF / 8)) * 8; const bool smp = r >= TP; const int rr = smp ? r - TP : r; const int b = smp ? rr >> 3 : rr >> 11, t = smp ? rr & 7 : rr & 2047, L = smp ? 8 : 2048;
        const v4u a0p = *(const GAS v4u*)(F.PA + (size_t)r * DFF + j0); const v4u bp = *(const GAS v4u*)(F.PB + (size_t)r * DFF + j0);
        float a0[8], a1[8], a2[8], bb[8];
#pragma unroll
        for (int e = 0; e < 4; ++e) { a0[2 * e] = __builtin_bit_cast(float, a0p[e] << 16); a0[2 * e + 1] = __builtin_bit_cast(float, a0p[e] & 0xffff0000u); bb[2 * e] = __builtin_bit_cast(float, bp[e] << 16); bb[2 * e + 1] = __builtin_bit_cast(float, bp[e] & 0xffff0000u); }
        if (t >= 1) { const v4u p = *(const GAS v4u*)(F.PA + (size_t)(r - 1) * DFF + j0);
#pragma unroll
            for (int e = 0; e < 4; ++e) { a1[2 * e] = __builtin_bit_cast(float, p[e] << 16); a1[2 * e + 1] = __builtin_bit_cast(float, p[e] & 0xffff0000u); } }
        else {
#pragma unroll
            for (int e = 0; e < 8; ++e) a1[e] = smp ? F.state_conv[((size_t)b * 2 + 1) * DFF + j0 + e] : 0.f; }
        if (t >= 2) { const v4u p = *(const GAS v4u*)(F.PA + (size_t)(r - 2) * DFF + j0);
#pragma unroll
            for (int e = 0; e < 4; ++e) { a2[2 * e] = __builtin_bit_cast(float, p[e] << 16); a2[2 * e + 1] = __builtin_bit_cast(float, p[e] & 0xffff0000u); } }
        else {
#pragma unroll
            for (int e = 0; e < 8; ++e) a2[e] = smp ? F.state_conv[((size_t)b * 2 + t) * DFF + j0 + e] : 0.f; }
        float h[8];
#pragma unroll
        for (int e = 0; e < 8; ++e) { const int j = j0 + e; const float c = F.conv_b[j] + F.conv_w[j] * a2[e] + F.conv_w[DFF + j] * a1[e] + F.conv_w[2 * DFF + j] * a0[e]; h[e] = gelu_tanh(c) * bb[e]; }
        v4u o; o.x = pk2(h[0], h[1]); o.y = pk2(h[2], h[3]); o.z = pk2(h[4], h[5]); o.w = pk2(h[6], h[7]);
        *(GAS v4u*)(F.PB + (size_t)r * DFF + j0) = o;
        if (t == L - 1) { float* nc = (smp ? F.o_conv_s : F.o_conv_p) + (size_t)b * 2 * DFF + j0;
#pragma unroll
            for (int e = 0; e < 8; ++e) { nc[e] = a1[e]; nc[DFF + e] = a0[e]; } }
    }
}
__device__ __forceinline__ int sw512(int row, int ch) { return row * 512 + ((ch ^ (row & 15)) << 4); }
__device__ __forceinline__ int sw256(int row, int ch) { return row * 256 + ((ch ^ (row & 15)) << 4); }
__device__ __forceinline__ int sw128(int row, int ch) { return row * 128 + ((ch ^ ((row >> 1) & 7)) << 4); }
__device__ __forceinline__ bf16x8 ldfrag(const LAS unsigned char* p) { return *(const LAS bf16x8*)p; }
__device__ __forceinline__ f32x4 mma16(bf16x8 a, bf16x8 b, f32x4 c) { return __builtin_amdgcn_mfma_f32_16x16x32_bf16(a, b, c, 0, 0, 0); }
constexpr int HG_NU = 8 * 4 * 8;
constexpr float A_CLAMP = -80.f;

__device__ __forceinline__ int sw512b(int row, int ch) { return row * 512 + ((ch ^ ((row ^ (row >> 3)) & 15)) << 4); }
__device__ __forceinline__ void hgrn_passA(Frame& F, f32x4* HU, float* HD) {
    LAS unsigned char* KT = F.lds;
    LAS unsigned char* VT = F.lds + 65536;
    LAS float* segtot = (LAS float*)F.lds;
    const int tid = F.tid, c8 = tid & 15, tq = tid >> 4, w = F.wave, lane = F.lane, l15 = lane & 15, lq = lane >> 4;
    for (int u = blockIdx.x; u < HG_NU; u += F.G) {
        const int sc = u & 7, bh = u >> 3, b = bh >> 2, h = bh & 3;
        const size_t rbase = (size_t)(b * 2048 + sc * 256 + tq * 8) * 512 + h * 128 + 8 * c8;
        f32x4 lf[8][2]; v4u kq[8], vq[8];
#pragma unroll
        for (int i = 0; i < 8; ++i) { lf[i][0] = *(const GAS f32x4*)(F.LOGF + rbase + (size_t)i * 512); lf[i][1] = *(const GAS f32x4*)(F.LOGF + rbase + (size_t)i * 512 + 4);
            kq[i] = *(const GAS v4u*)(F.KK + rbase + (size_t)i * 512); }
#pragma unroll
        for (int i = 1; i < 8; ++i) { lf[i][0] += lf[i - 1][0]; lf[i][1] += lf[i - 1][1]; }
        *(LAS f32x4*)(segtot + tq * 128 + 8 * c8) = lf[7][0]; *(LAS f32x4*)(segtot + tq * 128 + 8 * c8 + 4) = lf[7][1];
        __syncthreads();
        f32x4 off[2] = {(f32x4){0.f, 0.f, 0.f, 0.f}, (f32x4){0.f, 0.f, 0.f, 0.f}}, aend[2] = {(f32x4){0.f, 0.f, 0.f, 0.f}, (f32x4){0.f, 0.f, 0.f, 0.f}};
#pragma unroll 8
        for (int s2 = 0; s2 < 32; ++s2) { const f32x4 t0 = *(const LAS f32x4*)(segtot + s2 * 128 + 8 * c8), t1 = *(const LAS f32x4*)(segtot + s2 * 128 + 8 * c8 + 4);
            aend[0] += t0; aend[1] += t1; if (s2 < tq) { off[0] += t0; off[1] += t1; } }
        __syncthreads();
        if (tq == 0) { f32x4 d0, d1;
#pragma unroll
            for (int e = 0; e < 4; ++e) { d0[e] = __expf(aend[0][e]); d1[e] = __expf(aend[1][e]); }
            *(GAS f32x4*)(HD + (size_t)u * 128 + 8 * c8) = d0; *(GAS f32x4*)(HD + (size_t)u * 128 + 8 * c8 + 4) = d1; }
#pragma unroll
        for (int jh = 0; jh < 2; ++jh) {
            unsigned ke[4][4];
#pragma unroll
            for (int i = 0; i < 8; ++i)
#pragma unroll
                for (int jj = 0; jj < 4; ++jj) { const int j = 4 * jh + jj; const float kk = __builtin_bit_cast(float, (j & 1) ? (kq[i][j >> 1] & 0xffff0000u) : (kq[i][j >> 1] << 16));
                    const float ev = kk * __expf(aend[jh][jj] - (off[jh][jj] + lf[i][jh][jj])); const unsigned bits = f2bf(ev);
                    if (i & 1) ke[jj][i >> 1] |= bits << 16; else ke[jj][i >> 1] = bits; }
#pragma unroll
            for (int jj = 0; jj < 4; ++jj) *(LAS v4u*)(KT + sw512b(8 * c8 + 4 * jh + jj, tq)) = (v4u){ke[jj][0], ke[jj][1], ke[jj][2], ke[jj][3]};
            __builtin_amdgcn_sched_barrier(0);
            if (jh == 0) {
#pragma unroll
                for (int i = 0; i < 8; ++i) vq[i] = *(const GAS v4u*)(F.V + rbase + (size_t)i * 512);
            }
        }
#pragma unroll
        for (int j = 0; j < 8; ++j) {
            unsigned vv[4];
#pragma unroll
            for (int p = 0; p < 4; ++p) { const unsigned lo = (j & 1) ? (vq[2 * p][j >> 1] >> 16) : (vq[2 * p][j >> 1] & 0xffffu), hi = (j & 1) ? (vq[2 * p + 1][j >> 1] & 0xffff0000u) : (vq[2 * p + 1][j >> 1] << 16); vv[p] = lo | hi; }
            *(LAS v4u*)(VT + sw512b(8 * c8 + j, tq)) = (v4u){vv[0], vv[1], vv[2], vv[3]}; }
        __syncthreads();
        f32x4 acc[8];
#pragma unroll
        for (int n = 0; n < 8; ++n) acc[n] = (f32x4){0.f, 0.f, 0.f, 0.f};
#pragma unroll
        for (int ks = 0; ks < 8; ++ks) {
            const bf16x8 af = ldfrag(KT + sw512b(16 * w + l15, 4 * ks + lq));
#pragma unroll
            for (int n = 0; n < 8; ++n) acc[n] = mma16(af, ldfrag(VT + sw512b(16 * n + l15, 4 * ks + lq)), acc[n]);
        }
#pragma unroll
        for (int n = 0; n < 8; ++n) HU[(((size_t)u * 8 + w) * 8 + n) * 64 + lane] = acc[n];
        __syncthreads();
    }
}

#define PC_LOAD_LF(LF, ckk) do { const size_t rb_ = (size_t)(b * 2048 + sc * 256 + (ckk) * 64 + seg * 16) * 512 + h * 128 + c; \
    _Pragma("unroll") for (int i = 0; i < 16; ++i) LF[i] = F.LOGF[rb_ + (size_t)i * 512]; } while (0)
#define PC_LOAD_QKV(QQ, KQ, VQ, ckk) do { const size_t rb_ = (size_t)(b * 2048 + sc * 256 + (ckk) * 64 + seg * 16) * 512 + h * 128 + c; \
    _Pragma("unroll") for (int i = 0; i < 16; ++i) { QQ[i] = F.Q[rb_ + (size_t)i * 512]; KQ[i] = F.KK[rb_ + (size_t)i * 512]; VQ[i] = F.V[rb_ + (size_t)i * 512]; } } while (0)
#define PC_CHUNK(ck, LF, QQ, KQ, VQ, NLF, NQQ, NKQ, NVQ) do { \
    const int trow0 = b * 2048 + sc * 256 + (ck) * 64; \
    _Pragma("unroll") for (int n = 0; n < 8; ++n) { const int dv = 16 * n + l15; *(LAS u32x2v*)(ST + sw256(dv, 2 * w + (lq >> 1)) + 8 * (lq & 1)) = (u32x2v){pk2(S[n][0], S[n][1]), pk2(S[n][2], S[n][3])}; } \
    float a[16]; { float run = 0.f; _Pragma("unroll") for (int i = 0; i < 16; ++i) { run += LF[i]; a[i] = run; } } \
    segtot[seg * 128 + c] = a[15]; \
    __syncthreads(); \
    float off = 0.f, aend = 0.f; \
    _Pragma("unroll") for (int s2 = 0; s2 < 4; ++s2) { const float v_ = segtot[s2 * 128 + c]; aend += v_; if (s2 < seg) off += v_; } \
    if (seg == 0) AE[c] = aend; \
    unsigned ke[8], vv[8]; \
    _Pragma("unroll") for (int i = 0; i < 16; ++i) { \
        const float At = fmaxf(off + a[i], A_CLAMP); const float q = bf2f(QQ[i]), k = bf2f(KQ[i]); \
        const float eA = __expf(At), eN = __expf(-At), eE = __expf(aend - (off + a[i])); const int t = seg * 16 + i; \
        *(LAS bf16*)(QA + sw256(t, c >> 3) + 2 * (c & 7)) = (bf16)f2bf(q * eA); *(LAS bf16*)(KA + sw256(t, c >> 3) + 2 * (c & 7)) = (bf16)f2bf(k * eN); \
        const unsigned kev = f2bf(k * eE), vvv = (unsigned)VQ[i]; \
        if (i & 1) { ke[i >> 1] |= kev << 16; vv[i >> 1] |= vvv << 16; } else { ke[i >> 1] = kev; vv[i >> 1] = vvv; } } \
    *(LAS v4u*)(KET + sw128(c, 2 * seg)) = (v4u){ke[0], ke[1], ke[2], ke[3]}; *(LAS v4u*)(KET + sw128(c, 2 * seg + 1)) = (v4u){ke[4], ke[5], ke[6], ke[7]}; \
    *(LAS v4u*)(VT + sw128(c, 2 * seg)) = (v4u){vv[0], vv[1], vv[2], vv[3]}; *(LAS v4u*)(VT + sw128(c, 2 * seg + 1)) = (v4u){vv[4], vv[5], vv[6], vv[7]}; \
    __syncthreads(); \
    _Pragma("unroll") for (int j = 0; j < 2; ++j) { const int sb = 2 * wh + j; f32x4 p = (f32x4){0.f, 0.f, 0.f, 0.f}; \
        if (sb <= tb) { _Pragma("unroll") for (int ks = 0; ks < 4; ++ks) p = mma16(ldfrag(QA + sw256(16 * tb + l15, 4 * ks + lq)), ldfrag(KA + sw256(16 * sb + l15, 4 * ks + lq)), p); } \
        _Pragma("unroll") for (int i = 0; i < 4; ++i) { const int t = 16 * tb + 4 * lq + i, s = 16 * sb + l15; const float pv = (s <= t) ? p[i] : 0.f; \
            *(LAS bf16*)(PS + sw128(t, s >> 3) + 2 * (s & 7)) = (bf16)f2bf(pv); } } \
    __syncthreads(); \
    bf16 gq[4][4]; \
    _Pragma("unroll") for (int i = 0; i < 4; ++i) _Pragma("unroll") for (int n = 0; n < 4; ++n) gq[i][n] = F.GS[(size_t)(trow0 + 16 * tb + 4 * lq + i) * 512 + h * 128 + 16 * (4 * wh + n) + l15]; \
    f32x4 o[4]; \
    _Pragma("unroll") for (int n = 0; n < 4; ++n) o[n] = (f32x4){0.f, 0.f, 0.f, 0.f}; \
    _Pragma("unroll") for (int ks = 0; ks < 2; ++ks) { const bf16x8 af = ldfrag(PS + sw128(16 * tb + l15, 4 * ks + lq)); \
        _Pragma("unroll") for (int n = 0; n < 4; ++n) o[n] = mma16(af, ldfrag(VT + sw128(16 * (4 * wh + n) + l15, 4 * ks + lq)), o[n]); } \
    _Pragma("unroll") for (int ks = 0; ks < 4; ++ks) { const bf16x8 af = ldfrag(QA + sw256(16 * tb + l15, 4 * ks + lq)); \
        _Pragma("unroll") for (int n = 0; n < 4; ++n) o[n] = mma16(af, ldfrag(ST + sw256(16 * (4 * wh + n) + l15, 4 * ks + lq)), o[n]); } \
    if ((ck) < 3) { const f32x4 d4 = *(const LAS f32x4*)(AE + 16 * w + 4 * lq); f32x4 dc; \
        _Pragma("unroll") for (int i = 0; i < 4; ++i) dc[i] = __expf(d4[i]); \
        _Pragma("unroll") for (int n = 0; n < 8; ++n) S[n] = S[n] * dc; \
        _Pragma("unroll") for (int ks = 0; ks < 2; ++ks) { const bf16x8 af = ldfrag(KET + sw128(16 * w + l15, 4 * ks + lq)); \
            _Pragma("unroll") for (int n = 0; n < 8; ++n) S[n] = mma16(af, ldfrag(VT + sw128(16 * n + l15, 4 * ks + lq)), S[n]); } } \
    if ((ck) < 3) { PC_LOAD_LF(NLF, (ck) + 1); PC_LOAD_QKV(NQQ, NKQ, NVQ, (ck) + 1); } \
    f32x4 ss = (f32x4){0.f, 0.f, 0.f, 0.f}; \
    _Pragma("unroll") for (int n = 0; n < 4; ++n) ss += o[n] * o[n]; \
    _Pragma("unroll") for (int i = 0; i < 4; ++i) { float v_ = ss[i]; v_ += __shfl_xor(v_, 1); v_ += __shfl_xor(v_, 2); v_ += __shfl_xor(v_, 4); v_ += __shfl_xor(v_, 8); ss[i] = v_; } \
    if (l15 == 0) { _Pragma("unroll") for (int i = 0; i < 4; ++i) RS[(16 * tb + 4 * lq + i) * 2 + wh] = ss[i]; } \
    __syncthreads(); \
    _Pragma("unroll") for (int i = 0; i < 4; ++i) { const int t = 16 * tb + 4 * lq + i; const float tot = RS[t * 2] + RS[t * 2 + 1]; const float rs = 1.f / sqrtf(tot * (1.f / 128.f) + EPS); \
        const size_t r = (size_t)(trow0 + t); \
        _Pragma("unroll") for (int n = 0; n < 4; ++n) { const int dv = 16 * (4 * wh + n) + l15; \
            F.MIX[r * D + 256 + h * 128 + dv] = (bf16)f2bf(o[n][i] * rs * og[n] * bf2f(gq[i][n])); } } \
  } while (0)
__device__ __forceinline__ void hgrn_passC(Frame& F, const f32x4* HU, const float* HD) {
    LAS unsigned char* QA = F.lds;
    LAS unsigned char* KA = F.lds + 16384;
    LAS unsigned char* KET = F.lds + 32768;
    LAS unsigned char* VT = F.lds + 49152;
    LAS unsigned char* PS = F.lds + 65536;
    LAS unsigned char* ST = F.lds + 73728;
    LAS float* AE = (LAS float*)(F.lds + 106496);
    LAS float* segtot = AE + 128;
    LAS float* RS = segtot + 512;
    const int tid = F.tid, c = tid & 127, seg = tid >> 7, w = F.wave, lane = F.lane, l15 = lane & 15, lq = lane >> 4;
    const int tb = w >> 1, wh = w & 1;
    for (int u = blockIdx.x; u < HG_NU; u += F.G) {
        const int sc = u & 7, bh = u >> 3, b = bh >> 2, h = bh & 3;
        float lfA[16], lfB[16]; bf16 qA_[16], kA_[16], vA_[16], qB_[16], kB_[16], vB_[16];
        PC_LOAD_LF(lfA, 0); PC_LOAD_QKV(qA_, kA_, vA_, 0);
        float og[4];
#pragma unroll
        for (int n = 0; n < 4; ++n) og[n] = F.onorm_g[h * 128 + 16 * (4 * wh + n) + l15];
        f32x4 S[8];
#pragma unroll
        for (int n = 0; n < 8; ++n) S[n] = (f32x4){0.f, 0.f, 0.f, 0.f};
        for (int p = 0; p < sc; ++p) { const int up = (bh << 3) + p; const f32x4 d4 = *(const f32x4*)(HD + (size_t)up * 128 + 16 * w + 4 * lq);
#pragma unroll
            for (int n = 0; n < 8; ++n) S[n] = S[n] * d4 + HU[(((size_t)up * 8 + w) * 8 + n) * 64 + lane]; }
        if (sc == 7) { const f32x4 d4 = *(const f32x4*)(HD + (size_t)u * 128 + 16 * w + 4 * lq); float* so = F.o_hgrn_p + (size_t)bh * 128 * 128;
#pragma unroll
            for (int n = 0; n < 8; ++n) { const f32x4 fin = S[n] * d4 + HU[(((size_t)u * 8 + w) * 8 + n) * 64 + lane];
#pragma unroll
                for (int i = 0; i < 4; ++i) so[(size_t)(16 * w + 4 * lq + i) * 128 + 16 * n + l15] = fin[i]; } }
        PC_CHUNK(0, lfA, qA_, kA_, vA_, lfB, qB_, kB_, vB_);
        PC_CHUNK(1, lfB, qB_, kB_, vB_, lfA, qA_, kA_, vA_);
        PC_CHUNK(2, lfA, qA_, kA_, vA_, lfB, qB_, kB_, vB_);
        PC_CHUNK(3, lfB, qB_, kB_, vB_, lfA, qA_, kA_, vA_);
        __syncthreads();
    }
}
#undef PC_LOAD_LF
#undef PC_LOAD_QKV
#undef PC_CHUNK

__device__ __forceinline__ void hgrn_sample(Frame& F) {
    LAS float* qs = (LAS float*)F.lds; LAS float* fs = qs + 1024; LAS float* ks = fs + 1024;
    LAS float* part = ks + 1024;
    LAS float* red = part + 4096;
    const int tid = F.tid, dv = tid & 127, qd = tid >> 7;
    for (int u = blockIdx.x; u < 512; u += F.G) {
        const int b = u >> 2, h = u & 3, row0 = TP + b * 8;
        float S[32];
#pragma unroll
        for (int j = 0; j < 32; ++j) S[j] = F.state_hgrn[(((size_t)b * 4 + h) * 128 + qd * 32 + j) * 128 + dv];
#pragma unroll
        for (int i = 0; i < 2; ++i) { const int idx = tid + 512 * i, t = idx >> 7, cc = idx & 127; const size_t ro = (size_t)(row0 + t) * 512 + h * 128 + cc;
            qs[idx] = bf2f(F.Q[ro]); fs[idx] = __expf(F.LOGF[ro]); ks[idx] = bf2f(F.KK[ro]); }
        float v[8];
#pragma unroll
        for (int t = 0; t < 8; ++t) v[t] = bf2f(F.V[(size_t)(row0 + t) * 512 + h * 128 + dv]);
        __syncthreads();
#pragma unroll
        for (int t = 0; t < 8; ++t) { float op = 0.f;
#pragma unroll
            for (int j4 = 0; j4 < 8; ++j4) { const f32x4 f4 = *(const LAS f32x4*)(fs + t * 128 + qd * 32 + 4 * j4), k4 = *(const LAS f32x4*)(ks + t * 128 + qd * 32 + 4 * j4), q4 = *(const LAS f32x4*)(qs + t * 128 + qd * 32 + 4 * j4);
#pragma unroll
                for (int e = 0; e < 4; ++e) { float s = f4[e] * S[4 * j4 + e] + k4[e] * v[t]; S[4 * j4 + e] = s; op += q4[e] * s; } }
            part[(qd * 8 + t) * 128 + dv] = op; }
        float* so = F.o_hgrn_s + ((size_t)b * 4 + h) * 128 * 128;
#pragma unroll
        for (int j = 0; j < 32; ++j) so[(size_t)(qd * 32 + j) * 128 + dv] = S[j];
        __syncthreads();
        float o2[2];
#pragma unroll
        for (int i = 0; i < 2; ++i) { const int idx = tid + 512 * i, t = idx >> 7, d2 = idx & 127;
            const float o = (part[(0 * 8 + t) * 128 + d2] + part[(1 * 8 + t) * 128 + d2]) + (part[(2 * 8 + t) * 128 + d2] + part[(3 * 8 + t) * 128 + d2]);
            o2[i] = o; const float ssq = wave_sum(o * o); if (F.lane == 0) red[i * 8 + F.wave] = ssq; }
        __syncthreads();
#pragma unroll
        for (int i = 0; i < 2; ++i) { const int idx = tid + 512 * i, t = idx >> 7, d2 = idx & 127; const float tot = red[i * 8 + (F.wave & ~1)] + red[i * 8 + (F.wave | 1)];
            const size_t r = (size_t)(row0 + t);
            F.MIX[r * D + 256 + h * 128 + d2] = (bf16)f2bf(o2[i] * (1.f / sqrtf(tot * (1.f / 128.f) + EPS)) * F.onorm_g[h * 128 + d2] * bf2f(F.GS[r * 512 + h * 128 + d2])); }
        __syncthreads();
    }
}
__device__ __forceinline__ bf16x8 frag_from(unsigned a, unsigned b, unsigned c, unsigned d) { return __builtin_bit_cast(bf16x8, (v4u){a, b, c, d}); }
__device__ __forceinline__ void xattn_prompt(Frame& F) {
    LAS unsigned char* KS = F.lds;
    LAS unsigned char* VT = F.lds + 32768;
    const int tid = F.tid, w = F.wave, lane = F.lane, l15 = lane & 15, lq = lane >> 4;
    for (int u = blockIdx.x; u < 256; u += F.G) {
        const int qb = u & 7, bh = u >> 3, b = bh >> 2, h = bh & 3;
        { const int kv = tid >> 1, half = tid & 1; const bf16* src = F.KVB + (size_t)(b * 256 + kv) * 512 + h * 64 + half * 32;
#pragma unroll
          for (int j = 0; j < 4; ++j) { const int cidx = 4 * half + j; *(LAS v4u*)(KS + ((((kv >> 4) * 2 + (cidx >> 2)) * 64 + 16 * (cidx & 3) + (kv & 15)) << 4)) = *(const GAS v4u*)(src + 8 * j); } }
        { const int d = tid & 63, kvg = tid >> 6; const bf16* src = F.KVB + (size_t)(b * 256 + 32 * kvg) * 512 + 256 + h * 64 + d;
          unsigned x[32];
#pragma unroll
          for (int i = 0; i < 32; ++i) x[i] = (unsigned)src[(size_t)i * 512];
#pragma unroll
          for (int q4 = 0; q4 < 4; ++q4) *(LAS v4u*)(VT + ((((d >> 4) * 8 + kvg) * 64 + 16 * q4 + (d & 15)) << 4)) =
              (v4u){x[4 * q4] | (x[4 * q4 + 1] << 16), x[4 * q4 + 2] | (x[4 * q4 + 3] << 16), x[16 + 4 * q4] | (x[16 + 4 * q4 + 1] << 16), x[16 + 4 * q4 + 2] | (x[16 + 4 * q4 + 3] << 16)}; }
        __syncthreads();
        const LAS unsigned char* kl = KS + lane * 16; const LAS unsigned char* vl = VT + lane * 16;
#pragma unroll 1
        for (int blk = 0; blk < 2; ++blk) {
            const int q0 = b * 2048 + qb * 256 + 32 * w + 16 * blk;
            bf16x8 qf[2];
#pragma unroll
            for (int ks = 0; ks < 2; ++ks) qf[ks] = *(const GAS bf16x8*)(F.QX + (size_t)(q0 + l15) * 256 + h * 64 + 32 * ks + 8 * lq);
            f32x4 s[16];
#pragma unroll
            for (int kt = 0; kt < 16; ++kt) { s[kt] = mma16(ldfrag(kl + (kt * 2 + 0) * 1024), qf[0], (f32x4){0.f, 0.f, 0.f, 0.f}); s[kt] = mma16(ldfrag(kl + (kt * 2 + 1) * 1024), qf[1], s[kt]);
                if ((kt & 3) == 3) __builtin_amdgcn_sched_barrier(0); }
            float m = s[0][0];
#pragma unroll
            for (int kt = 0; kt < 16; ++kt)
#pragma unroll
                for (int i = 0; i < 4; ++i) m = fmaxf(m, s[kt][i]);
            m = fmaxf(m, __shfl_xor(m, 16)); m = fmaxf(m, __shfl_xor(m, 32));
            float l = 0.f;
#pragma unroll
            for (int kt = 0; kt < 16; ++kt)
#pragma unroll
                for (int i = 0; i < 4; ++i) { const float p = exp2f(s[kt][i] - m); s[kt][i] = p; l += p; }
            l += __shfl_xor(l, 16); l += __shfl_xor(l, 32);
            const float inv = 1.f / l;
            f32x4 o[4];
#pragma unroll
            for (int dt = 0; dt < 4; ++dt) o[dt] = (f32x4){0.f, 0.f, 0.f, 0.f};
#pragma unroll
            for (int ks = 0; ks < 8; ++ks) {
                const f32x4 p0 = s[2 * ks] * inv, p1 = s[2 * ks + 1] * inv;
                const bf16x8 bfr = frag_from(pk2(p0[0], p0[1]), pk2(p0[2], p0[3]), pk2(p1[0], p1[1]), pk2(p1[2], p1[3]));
#pragma unroll
                for (int dt = 0; dt < 4; ++dt) o[dt] = mma16(ldfrag(vl + (dt * 8 + ks) * 1024), bfr, o[dt]);
                __builtin_amdgcn_sched_barrier(0);
            }
#pragma unroll
            for (int dt = 0; dt < 4; ++dt) *(GAS u32x2v*)(F.MIX + (size_t)(q0 + l15) * D + 768 + h * 64 + 16 * dt + 4 * lq) = (u32x2v){pk2(o[dt][0], o[dt][1]), pk2(o[dt][2], o[dt][3])};
        }
        __syncthreads();
    }
}
__device__ __forceinline__ void xattn_sample(Frame& F) {
    LAS float* MX = (LAS float*)F.lds; LAS float* LS = MX + 128; LAS float* OP = LS + 128;
    const int tid = F.tid, w = F.wave, lane = F.lane, l15 = lane & 15, lq = lane >> 4;
    for (int u = blockIdx.x; u < 512; u += F.G) {
        const int b = u >> 2, h = u & 3, row0 = TP + 8 * b;
        bf16x8 qf[2];
#pragma unroll
        for (int ks = 0; ks < 2; ++ks) qf[ks] = *(const GAS bf16x8*)(F.QX + (size_t)(row0 + (l15 & 7)) * 256 + h * 64 + 32 * ks + 8 * lq);
        f32x4 s[2];
#pragma unroll
        for (int t2 = 0; t2 < 2; ++t2) { s[t2] = (f32x4){0.f, 0.f, 0.f, 0.f};
#pragma unroll
            for (int ks = 0; ks < 2; ++ks) { const float* kp = F.cache_k + (((size_t)b * 256 + 32 * w + 16 * t2 + l15) * 4 + h) * 64 + 32 * ks + 8 * lq;
                const f32x4 x0 = *(const GAS f32x4*)kp, x1 = *(const GAS f32x4*)(kp + 4);
                s[t2] = mma16(frag_from(pk2(x0[0], x0[1]), pk2(x0[2], x0[3]), pk2(x1[0], x1[1]), pk2(x1[2], x1[3])), qf[ks], s[t2]); } }
        float vv[4][8];
#pragma unroll
        for (int dt = 0; dt < 4; ++dt)
#pragma unroll
            for (int j = 0; j < 8; ++j) vv[dt][j] = F.cache_v[(((size_t)b * 256 + 32 * w + 16 * (j >> 2) + 4 * lq + (j & 3)) * 4 + h) * 64 + 16 * dt + l15];
        float m = fmaxf(fmaxf(fmaxf(s[0][0], s[0][1]), fmaxf(s[0][2], s[0][3])), fmaxf(fmaxf(s[1][0], s[1][1]), fmaxf(s[1][2], s[1][3])));
        m = fmaxf(m, __shfl_xor(m, 16)); m = fmaxf(m, __shfl_xor(m, 32));
        if (lq == 0) MX[w * 16 + l15] = m;
        __syncthreads();
        m = MX[l15];
#pragma unroll
        for (int w2 = 1; w2 < 8; ++w2) m = fmaxf(m, MX[w2 * 16 + l15]);
        float l = 0.f;
#pragma unroll
        for (int t2 = 0; t2 < 2; ++t2)
#pragma unroll
            for (int i = 0; i < 4; ++i) { const float p = exp2f(s[t2][i] - m); s[t2][i] = p; l += p; }
        l += __shfl_xor(l, 16); l += __shfl_xor(l, 32);
        if (lq == 0) LS[w * 16 + l15] = l;
        const bf16x8 bfr = frag_from(pk2(s[0][0], s[0][1]), pk2(s[0][2], s[0][3]), pk2(s[1][0], s[1][1]), pk2(s[1][2], s[1][3]));
#pragma unroll
        for (int dt = 0; dt < 4; ++dt) {
            const f32x4 o = mma16(frag_from(pk2(vv[dt][0], vv[dt][1]), pk2(vv[dt][2], vv[dt][3]), pk2(vv[dt][4], vv[dt][5]), pk2(vv[dt][6], vv[dt][7])), bfr, (f32x4){0.f, 0.f, 0.f, 0.f});
#pragma unroll
            for (int i = 0; i < 4; ++i) OP[(w * 64 + 16 * dt + 4 * lq + i) * 16 + l15] = o[i];
        }
        __syncthreads();
        { const int q = tid >> 6, d = tid & 63; float o = 0.f, ll = 0.f;
#pragma unroll
          for (int w2 = 0; w2 < 8; ++w2) { o += OP[(w2 * 64 + d) * 16 + q]; ll += LS[w2 * 16 + q]; }
          F.MIX[(size_t)(row0 + q) * D + 768 + h * 64 + d] = (bf16)f2bf(o / ll); }
        __syncthreads();
    }
}
template <class Epi> __device__ __forceinline__ void small_piece(const bf16* A, const bf16* Bt, int K, int w, int lane, const Epi& epi) {
    const int rb = w >> 1, cb = w & 1, l15 = lane & 15, lq = lane >> 4;
    const bf16* ap = A + (size_t)(16 * rb + l15) * K + 8 * lq;
    const bf16* bp0 = Bt + (size_t)(32 * cb + l15) * K + 8 * lq; const bf16* bp1 = bp0 + (size_t)16 * K;
    f32x4 acc0 = (f32x4){0.f, 0.f, 0.f, 0.f}, acc1 = (f32x4){0.f, 0.f, 0.f, 0.f};
    const int ng = K / 256;
    bf16x8 xa[8], wa0[8], wa1[8], xb[8], wb0[8], wb1[8];
#define SP_LOAD(X, W0, W1, gi) do { const int o_ = 256 * (gi); _Pragma("unroll") for (int j = 0; j < 8; ++j) { X[j] = *(const GAS bf16x8*)(ap + o_ + 32 * j); W0[j] = *(const GAS bf16x8*)(bp0 + o_ + 32 * j); W1[j] = *(const GAS bf16x8*)(bp1 + o_ + 32 * j); } } while (0)
#define SP_MMA(X, W0, W1) do { _Pragma("unroll") for (int j = 0; j < 8; ++j) { acc0 = mma16(W0[j], X[j], acc0); acc1 = mma16(W1[j], X[j], acc1); } } while (0)
    SP_LOAD(xa, wa0, wa1, 0);
    int g = 0;
#pragma unroll 1
    for (; g + 1 < ng; g += 2) {
        SP_LOAD(xb, wb0, wb1, g + 1);
        SP_MMA(xa, wa0, wa1);
        SP_LOAD(xa, wa0, wa1, (g + 2 < ng ? g + 2 : ng - 1));
        SP_MMA(xb, wb0, wb1);
    }
    if (g < ng) SP_MMA(xa, wa0, wa1);
#undef SP_LOAD
#undef SP_MMA
    epi(acc0, acc1, 16 * rb + l15, 32 * cb + 4 * lq, cb, lq);
}
__device__ __forceinline__ void out_sample_piece(Frame& F) {
    const int p = blockIdx.x; if (p >= 256) return; const int pr = p >> 4, pc = p & 15;
    auto epi = [&](const f32x4& a0, const f32x4& a1, int r, int c, int cb, int lq) {
        const int rs = 64 * pr + r, col = 64 * pc + c; const float* xr = F.x_sample + (size_t)rs * D + col; bf16* xo = F.XN + (size_t)(TP + rs) * D + col;
        const f32x4 v0 = a0 + *(const GAS f32x4*)xr, v1 = a1 + *(const GAS f32x4*)(xr + 16);
        *(GAS u32x2v*)xo = (u32x2v){pk2(v0[0], v0[1]), pk2(v0[2], v0[3])}; *(GAS u32x2v*)(xo + 16) = (u32x2v){pk2(v1[0], v1[1]), pk2(v1[2], v1[3])};
        float ss = ((v0[0] * v0[0] + v0[1] * v0[1]) + (v0[2] * v0[2] + v0[3] * v0[3])) + ((v1[0] * v1[0] + v1[1] * v1[1]) + (v1[2] * v1[2] + v1[3] * v1[3]));
        ss += __shfl_xor(ss, 16); ss += __shfl_xor(ss, 32);
        if (lq == 0) F.ROWSS_S[(size_t)rs * 32 + pc * 2 + cb] = ss; };
    small_piece(F.MIX + (size_t)(TP + 64 * pr) * D, F.WOUT + (size_t)(64 * pc) * D, D, F.wave, F.lane, epi);
}
__device__ __forceinline__ void down_sample_piece(Frame& F) {
    const int p = blockIdx.x; if (p >= 256) return; const int pr = p >> 4, pc = p & 15;
    auto epi = [&](const f32x4& a0, const f32x4& a1, int r, int c, int cb, int lq) {
        float* yo = F.y + (size_t)(TP + 64 * pr + r) * D + 64 * pc + c; const bf16* xi = F.XN + (size_t)(TP + 64 * pr + r) * D + 64 * pc + c;
        const u32x2v b0 = *(const GAS u32x2v*)xi, b1 = *(const GAS u32x2v*)(xi + 16);
        const f32x4 r0 = (f32x4){__builtin_bit_cast(float, b0.x << 16), __builtin_bit_cast(float, b0.x & 0xffff0000u), __builtin_bit_cast(float, b0.y << 16), __builtin_bit_cast(float, b0.y & 0xffff0000u)};
        const f32x4 r1 = (f32x4){__builtin_bit_cast(float, b1.x << 16), __builtin_bit_cast(float, b1.x & 0xffff0000u), __builtin_bit_cast(float, b1.y << 16), __builtin_bit_cast(float, b1.y & 0xffff0000u)};
        const f32x4 v0 = a0 + r0, v1 = a1 + r1;
        *(GAS f32x4*)yo = v0; *(GAS f32x4*)(yo + 16) = v1; };
    small_piece(F.PB + (size_t)(TP + 64 * pr) * DFF, F.WDN + (size_t)(64 * pc) * DFF, DFF, F.wave, F.lane, epi);
}
__global__ void __launch_bounds__(NWAVES * 64, 2) mk_fwd(Args args) {
    extern __shared__ __attribute__((aligned(16))) unsigned char lds[];
    Frame F;
    F.lds = (LAS unsigned char*)lds;
    F.tid = threadIdx.x; F.lane = F.tid & 63; F.wave = __builtin_amdgcn_readfirstlane(F.tid >> 6); F.G = gridDim.x;
    volatile LAS unsigned* MISC = (volatile LAS unsigned*)(F.lds + MISC_OFF);
    unsigned char* ws = args.ws;
    gu32* ctl = (gu32*)(ws + WS_CTL);
    F.x_prompt = args.in[0]; F.x_sample = args.in[1]; F.mem_prompt = args.in[2]; F.state_pool = args.in[3]; F.state_hgrn = args.in[4]; F.state_conv = args.in[5];
    F.cache_k = args.in[6]; F.cache_v = args.in[7]; F.ln1_g = args.in[8]; F.w_in = args.in[9]; F.pool_w = args.in[10]; F.pool_scale = args.in[11]; F.lb_logits = args.in[12];
    F.onorm_g = args.in[13]; F.mem_norm_g = args.in[14]; F.w_mem_kv = args.in[15]; F.w_out = args.in[16]; F.ln2_g = args.in[17]; F.w_up = args.in[18]; F.conv_w = args.in[19];
    F.conv_b = args.in[20]; F.w_down = args.in[21]; F.lnf_g = args.in[22];
    float* out = args.out;
    F.y = out; F.o_pool_p = out + (size_t)MT * D; F.o_hgrn_p = F.o_pool_p + 8 * 15 * 256; F.o_conv_p = F.o_hgrn_p + 8 * 4 * 128 * 128; F.o_mk = F.o_conv_p + 8 * 2 * DFF;
    F.o_mv = F.o_mk + MEMR * 256; F.o_pool_s = F.o_mv + MEMR * 256; F.o_hgrn_s = F.o_pool_s + 128 * 15 * 256; F.o_conv_s = F.o_hgrn_s + (size_t)128 * 4 * 128 * 128;
    F.WIN = (bf16*)(ws + WS_WIN); F.WKV = (bf16*)(ws + WS_WKV); F.WOUT = (bf16*)(ws + WS_WOUT); F.WUP = (bf16*)(ws + WS_WUP); F.WDN = (bf16*)(ws + WS_WDN);
    F.XN = (bf16*)(ws + WS_XN); F.XNM = (bf16*)(ws + WS_XNM); F.KVB = (bf16*)(ws + WS_KVB); F.MIX = (bf16*)(ws + WS_MIX);
    F.U = (float*)(ws + WS_U); F.Q = (bf16*)(ws + WS_Q); F.LOGF = (float*)(ws + WS_LOGF); F.KK = (bf16*)(ws + WS_KK); F.V = (bf16*)(ws + WS_V); F.GS = (bf16*)(ws + WS_G); F.QX = (bf16*)(ws + WS_QX);
    F.PA = (bf16*)(ws + WS_PA); F.PB = (bf16*)(ws + WS_PB); F.EA = (float*)(ws + WS_EA); F.EB = (float*)(ws + WS_EB); F.ROWSS = (float*)(ws + WS_ROWSS); F.ROWSS_S = (float*)(ws + WS_ROWSS_S);
    for (int u = F.tid; u < (LDS_BYTES - LDSCTL_OFF) / 4; u += NWAVES * 64) ((LAS unsigned*)(F.lds + LDSCTL_OFF))[u] = 0u;
    __syncthreads();
    const int lo = args.ph_lo, hi = args.ph_hi;
    XcdBarrier bar; bar.bar = (unsigned*)(ctl + CW_BAR); bar.x = 0; bar.st = nullptr;
    if (hi - lo > 1) bar = xcd_barrier_post((unsigned*)(ctl + CW_BAR), MISC + 8);
#define IN(k) (lo <= (k) && (k) < hi)
#if defined(PROBE_A)
    volatile LAS unsigned long long* TSW = (volatile LAS unsigned long long*)(F.lds + LDSCTL_OFF + 512);
    if (blockIdx.x == 0 && F.tid == 0) TSW[0] = __builtin_amdgcn_s_memrealtime();
#define SEAM(k) do { if (IN(k) && IN((k) + 1)) xcd_barrier(bar); if (blockIdx.x == 0 && F.tid == 0) TSW[(k) + 1] = __builtin_amdgcn_s_memrealtime(); } while (0)
#else
#define SEAM(k) do { if (IN(k) && IN((k) + 1)) xcd_barrier(bar); } while (0)
#endif

    if (IN(0)) { p0_prologue(F); } SEAM(0);
    if (IN(1)) {
        { pg8::Gemm g{F.XN, F.WIN, MT, DIN, D}; pg8::StaticOrder S; S.init(MT, DIN, F.G, (int)blockIdx.x);
          pg8::EpiIn E{F.U, F.Q, F.LOGF, F.KK, F.V, F.GS, F.QX, F.lb_logits};
          pg8::gemm_phase<pg8::EpiIn, pg8::StaticOrder, true, true>(F.lds, g, S, E); }
        { pg8::Gemm g{F.XNM, F.WKV, MEMR, 512, D}; pg8::StaticOrder S; S.init(MEMR, 512, F.G, (int)((blockIdx.x + F.G - 168 % F.G) % F.G));
          pg8::EpiKV E{F.o_mk, F.o_mv, F.KVB};
          pg8::gemm_phase<pg8::EpiKV, pg8::StaticOrder, true, true>(F.lds, g, S, E); }
        { const int first = (int)((long)(MT / 256) * (DIN / 256) - 2L * F.G); const int nb2 = F.G - first;
          if (first >= 0 && nb2 > 0) { if ((int)blockIdx.x >= first) p0_late(F, ((int)blockIdx.x - first) * NWAVES + F.wave, nb2 * NWAVES); }
          else p0_late(F, (int)blockIdx.x * NWAVES + F.wave, F.G * NWAVES); }
    } SEAM(1);
#if defined(PROBE_A)
#define SUBSTAMP(k) do { if (blockIdx.x == 0 && F.tid == 0) TSW[k] = __builtin_amdgcn_s_memrealtime(); } while (0)
#else
#define SUBSTAMP(k) do { } while (0)
#endif
    if (IN(2)) { pool_phase(F); SUBSTAMP(26); hgrn_passA(F, (f32x4*)(ws + WS_HU), (float*)(ws + WS_HD)); SUBSTAMP(27); hgrn_sample(F); SUBSTAMP(28); xattn_prompt(F); SUBSTAMP(29); xattn_sample(F); SUBSTAMP(30); } SEAM(2);
    if (IN(3)) { hgrn_passC(F, (const f32x4*)(ws + WS_HU), (const float*)(ws + WS_HD)); } SEAM(3);
    if (IN(4)) {
        pg8::Gemm g{F.MIX, F.WOUT, TP, D, D}; pg8::StaticOrder S; S.init(TP, D, F.G, (int)blockIdx.x);
        pg8::EpiOut2 E{F.x_prompt, F.x_sample, TP, F.y, F.XN, F.ROWSS};
        pg8::gemm_phase<pg8::EpiOut2, pg8::StaticOrder, true, true>(F.lds, g, S, E);
#if defined(PROBE_A)
        if (blockIdx.x == 0 && F.tid == 0) TSW[20] = __builtin_amdgcn_s_memrealtime();
        if (F.tid == 0) atomicMax((unsigned long long*)(ws + WS_CTL + 32768 + 128), (unsigned long long)__builtin_amdgcn_s_memrealtime());
#endif
        out_sample_piece(F);
#if defined(PROBE_A)
        if (F.tid == 0) atomicMax((unsigned long long*)(ws + WS_CTL + 32768 + 192), (unsigned long long)__builtin_amdgcn_s_memrealtime());
#endif
    } SEAM(4);
    if (IN(5)) {
        pg8::Gemm g{F.XN, F.WUP, MT, 2 * DFF, D}; pg8::StaticOrder S; S.init(MT, 2 * DFF, F.G, (int)blockIdx.x);
        pg8::EpiUpConv E{F.ROWSS, F.ROWSS_S, F.conv_w, F.conv_b, F.state_conv, F.PB, F.EA, F.EB, F.o_conv_p, F.o_conv_s, (LAS float*)(F.lds + RING_BYTES + 4096)};
        pg8::gemm_phase<pg8::EpiUpConv, pg8::StaticOrder, true, true>(F.lds, g, S, E);
    } SEAM(5);
    if (IN(6)) { conv_fixup_phase(F); } SEAM(6);
    if (IN(7)) {
        pg8::Gemm g{F.PB, F.WDN, TP, D, DFF}; pg8::StaticOrder S; S.init(TP, D, F.G, (int)blockIdx.x);
        pg8::EpiResB E{F.XN, F.y};
        pg8::gemm_phase<pg8::EpiResB, pg8::StaticOrder, true, true>(F.lds, g, S, E);
#if defined(PROBE_A)
        if (blockIdx.x == 0 && F.tid == 0) TSW[21] = __builtin_amdgcn_s_memrealtime();
        if (F.tid == 0) atomicMax((unsigned long long*)(ws + WS_CTL + 32768), (unsigned long long)__builtin_amdgcn_s_memrealtime());
#endif
        down_sample_piece(F);
#if defined(PROBE_A)
        if (F.tid == 0) atomicMax((unsigned long long*)(ws + WS_CTL + 32768 + 64), (unsigned long long)__builtin_amdgcn_s_memrealtime());
#endif
    } SEAM(7);
    if (IN(8)) { final_norm_phase(F); }
#if defined(PROBE_A)
    __syncthreads();
    if (blockIdx.x == 0 && F.tid == 0) { TSW[NPHASE] = __builtin_amdgcn_s_memrealtime();
        TSW[22] = __hip_atomic_load((unsigned long long*)(ws + WS_CTL + 32768), __ATOMIC_RELAXED, __HIP_MEMORY_SCOPE_AGENT); TSW[23] = __hip_atomic_load((unsigned long long*)(ws + WS_CTL + 32768 + 64), __ATOMIC_RELAXED, __HIP_MEMORY_SCOPE_AGENT); TSW[24] = __hip_atomic_load((unsigned long long*)(ws + WS_CTL + 32768 + 128), __ATOMIC_RELAXED, __HIP_MEMORY_SCOPE_AGENT); TSW[25] = __hip_atomic_load((unsigned long long*)(ws + WS_CTL + 32768 + 192), __ATOMIC_RELAXED, __HIP_MEMORY_SCOPE_AGENT);
        const unsigned long long wait = (TSW[PROBE_B] - TSW[PROBE_A]) * 512ull, t0 = __builtin_amdgcn_s_memrealtime();
        while (__builtin_amdgcn_s_memrealtime() - t0 < wait) __builtin_amdgcn_s_sleep(32); }
#endif
#undef IN
#undef SEAM
}

extern "C" void kernel_launch(void* const* d_in, const int* in_sizes, int n_in, void* d_out, int out_size, void* d_ws, size_t ws_size, hipStream_t stream) {
    static int grid = 0;
    if (grid == 0) {
        if (n_in != 23 || ws_size < WS_END) { fprintf(stderr, "kernel_launch: unexpected n_in %d / ws_size %zu\n", n_in, ws_size); grid = -1; return; }
        int dev = 0, cus = 0, per_cu = 0;
        if (hipGetDevice(&dev) != hipSuccess || hipDeviceGetAttribute(&cus, hipDeviceAttributeMultiprocessorCount, dev) != hipSuccess) { grid = -1; return; }
        if (hipFuncSetAttribute((const void*)mk_fwd, hipFuncAttributeMaxDynamicSharedMemorySize, LDS_BYTES) != hipSuccess) { fprintf(stderr, "kernel_launch: hipFuncSetAttribute failed\n"); grid = -1; return; }
        if (hipOccupancyMaxActiveBlocksPerMultiprocessor(&per_cu, (const void*)mk_fwd, NWAVES * 64, LDS_BYTES) != hipSuccess || per_cu < 1) { fprintf(stderr, "kernel_launch: occupancy query says %d blocks/CU\n", per_cu); }
        (void)hipGetLastError();
        grid = cus;
    }
    if (grid < 0) return;
    (void)hipMemsetAsync((char*)d_ws + WS_CTL, 0, CTL_ZERO_BYTES, stream);
    Args a{};
    for (int i = 0; i < 23; ++i) a.in[i] = (const float*)d_in[i];
    a.out = (float*)d_out; a.ws = (unsigned char*)d_ws;
#if MK_PER_PHASE
    for (int p = 0; p < NPHASE; ++p) { a.ph_lo = p; a.ph_hi = p + 1; hipLaunchKernelGGL(mk_fwd, dim3(grid), dim3(NWAVES * 64), LDS_BYTES, stream, a); }
#else
    a.ph_lo = 0; a.ph_hi = NPHASE;
    hipLaunchKernelGGL(mk_fwd, dim3(grid), dim3(NWAVES * 64), LDS_BYTES, stream, a);
#endif
}
```

```cpp
#include <hip/hip_runtime.h>
#include <cstdio>
#include <cstdint>
namespace pg8 {
#define PG8_LAS __attribute__((address_space(3)))
typedef unsigned short bf16_t;
typedef short bf16x8 __attribute__((ext_vector_type(8)));
typedef float f32x4 __attribute__((ext_vector_type(4)));
typedef unsigned u32x4 __attribute__((ext_vector_type(4)));
constexpr int BM = 256, BK = 64, HALF = 128, HTB = HALF * BK * 2  , STAGE_BYTES = 8 * HTB, NXCD = 8, WGM = 8;

__host__ __device__ __forceinline__ int lds_byte(int r, int c) { const int st = (r >> 4) * 2 + (c >> 5), rr = r & 15, cc = c & 31, ob = rr * 64 + cc * 2; return st * 1024 + (ob ^ (((ob >> 9) & 1) << 5)); }
__host__ __device__ __forceinline__ void stage_rc(int b, int& R, int& C) { const int st = b / 1024, sb = b % 1024, swz = sb ^ (((sb >> 9) & 1) << 5); R = (st >> 1) * 16 + swz / 64; C = (st & 1) * 32 + (swz % 64) / 2; }
__host__ __device__ __forceinline__ int perm32(int rho) { const int n = rho >> 4, i = rho & 15; return 8 * (i >> 2) + 4 * n + (i & 3); }

struct Unit { int pm, pn; };
struct Gemm { const bf16_t* A; const bf16_t* Bt; int M, N, K; };

struct StaticOrder {
    int nM, nN, nwg, G, c;
    __host__ __device__ void init(int M, int N, int G_, int c_) { nM = M / BM; nN = N / BM; nwg = nM * nN; G = G_; c = c_; }
    __host__ __device__ bool next(int i, Unit& u) const {
        const long L = (long)i * G + c; if (L >= nwg) return false;
        int wgid = (int)L; { const int q = nwg / NXCD, r = nwg % NXCD, xcd = wgid % NXCD, off = wgid / NXCD; wgid = (xcd < r ? xcd * (q + 1) : r * (q + 1) + (xcd - r) * q) + off; }
        const int nig = WGM * nN, gid = wgid / nig, fm = gid * WGM, gsz = (nM - fm) < WGM ? (nM - fm) : WGM;
        u.pm = fm + ((wgid % nig) % gsz); u.pn = (wgid % nig) / gsz; return true;
    }
    __device__ __forceinline__ void a_ready(const Unit&) const {}
    __device__ __forceinline__ void done(const Unit&) const {}
};
__device__ __forceinline__ unsigned cvt_pk_bf16(float lo, float hi) { unsigned r; asm volatile("v_cvt_pk_bf16_f32 %0, %1, %2" : "=v"(r) : "v"(lo), "v"(hi)); return r; }
typedef float f32x2 __attribute__((ext_vector_type(2)));
typedef unsigned u32x2 __attribute__((ext_vector_type(2)));
__device__ __forceinline__ float frcp(float x) { return __builtin_amdgcn_rcpf(x); }
__device__ __forceinline__ float fsilu(float x) { return x * frcp(1.f + __expf(-x)); }
__device__ __forceinline__ u32x4 pack8(const f32x4& v0, const f32x4& v1) { u32x4 w; w.x = cvt_pk_bf16(v0[0], v0[1]); w.y = cvt_pk_bf16(v0[2], v0[3]); w.z = cvt_pk_bf16(v1[0], v1[1]); w.w = cvt_pk_bf16(v1[2], v1[3]); return w; }
constexpr float QX_SCALE = 0.125f * 1.4426950408889634f;
struct EpiIn {
    static constexpr bool PERM = true, AFTER_DRAIN = false;
    float* U; bf16_t* Q; float* LOGF; bf16_t* KK; bf16_t* V; bf16_t* G; bf16_t* QX; const float* lbl;
    __device__ __forceinline__ void operator()(const f32x4 (&acc)[2][2][4][2], const Unit& u, int wr, int wc, int fr, int fq) const {
        const int row0 = u.pm * BM + wr * 64 + fr, pn = u.pn, cl = wc * 32 + 8 * fq;
        if (pn == 0) {
#pragma unroll
            for (int ai = 0; ai < 2; ++ai)
#pragma unroll
                for (int m = 0; m < 4; ++m) { float* rowp = U + (size_t)(row0 + ai * HALF + m * 16) * 256 + cl;
#pragma unroll
                    for (int bj = 0; bj < 2; ++bj) { *(f32x4*)(rowp + bj * HALF) = acc[ai][bj][m][0]; *(f32x4*)(rowp + bj * HALF + 4) = acc[ai][bj][m][1]; } }
        } else if (pn == 3 || pn == 4) {
            const int c0 = (pn - 3) * 256 + cl;
            f32x4 oml[2][2];
#pragma unroll
            for (int bj = 0; bj < 2; ++bj)
#pragma unroll
                for (int n = 0; n < 2; ++n) { const f32x4 l0 = *(const f32x4*)(lbl + c0 + bj * HALF + 4 * n), l1 = *(const f32x4*)(lbl + 512 + c0 + bj * HALF + 4 * n);
#pragma unroll
                    for (int e = 0; e < 4; ++e) oml[bj][n][e] = frcp(1.f + __expf(l0[e] - l1[e])); }
#pragma unroll
            for (int ai = 0; ai < 2; ++ai)
#pragma unroll
                for (int m = 0; m < 4; ++m) { const size_t ro = (size_t)(row0 + ai * HALF + m * 16) * 512 + c0;
#pragma unroll
                    for (int bj = 0; bj < 2; ++bj) { f32x4 kk[2], lf[2];
#pragma unroll
                        for (int n = 0; n < 2; ++n)
#pragma unroll
                            for (int e = 0; e < 4; ++e) { const float x = acc[ai][bj][m][n][e]; const float k = oml[bj][n][e] * frcp(1.f + __expf(x)); kk[n][e] = k; lf[n][e] = __logf(1.f - k); }
                        *(f32x4*)(LOGF + ro + bj * HALF) = lf[0]; *(f32x4*)(LOGF + ro + bj * HALF + 4) = lf[1];
                        *(u32x4*)(KK + ro + bj * HALF) = pack8(kk[0], kk[1]); } }
        } else {
            bf16_t* base; int ldc, cb, mode;
            if (pn <= 2) { base = Q; ldc = 512; cb = (pn - 1) * 256; mode = 1; }
            else if (pn <= 6) { base = V; ldc = 512; cb = (pn - 5) * 256; mode = 0; }
            else if (pn <= 8) { base = G; ldc = 512; cb = (pn - 7) * 256; mode = 1; }
            else { base = QX; ldc = 256; cb = 0; mode = 2; }
#pragma unroll
            for (int ai = 0; ai < 2; ++ai)
#pragma unroll
                for (int m = 0; m < 4; ++m) { bf16_t* rowp = base + (size_t)(row0 + ai * HALF + m * 16) * ldc + cb + cl;
#pragma unroll
                    for (int bj = 0; bj < 2; ++bj) { f32x4 v0 = acc[ai][bj][m][0], v1 = acc[ai][bj][m][1];
                        if (mode == 1) {
#pragma unroll
                            for (int e = 0; e < 4; ++e) { v0[e] = fsilu(v0[e]); v1[e] = fsilu(v1[e]); } }
                        else if (mode == 2) { v0 = v0 * QX_SCALE; v1 = v1 * QX_SCALE; }
                        *(u32x4*)(rowp + bj * HALF) = pack8(v0, v1); } }
        }
    }
};
struct EpiKV {
    static constexpr bool PERM = true, AFTER_DRAIN = false;
    float* MK; float* MV; bf16_t* KVB;
    __device__ __forceinline__ void operator()(const f32x4 (&acc)[2][2][4][2], const Unit& u, int wr, int wc, int fr, int fq) const {
        const int row0 = u.pm * BM + wr * 64 + fr, cl = wc * 32 + 8 * fq; float* of = u.pn ? MV : MK;
#pragma unroll
        for (int ai = 0; ai < 2; ++ai)
#pragma unroll
            for (int m = 0; m < 4; ++m) { const size_t r = (size_t)(row0 + ai * HALF + m * 16);
#pragma unroll
                for (int bj = 0; bj < 2; ++bj) { *(f32x4*)(of + r * 256 + cl + bj * HALF) = acc[ai][bj][m][0]; *(f32x4*)(of + r * 256 + cl + bj * HALF + 4) = acc[ai][bj][m][1];
                    *(u32x4*)(KVB + r * 512 + u.pn * 256 + cl + bj * HALF) = pack8(acc[ai][bj][m][0], acc[ai][bj][m][1]); } }
    }
};
struct EpiRes {
    static constexpr bool PERM = true, AFTER_DRAIN = false;
    const float* r0; const float* r1; int split; float* out;
    __device__ __forceinline__ void operator()(const f32x4 (&acc)[2][2][4][2], const Unit& u, int wr, int wc, int fr, int fq) const {
        const int row0 = u.pm * BM + wr * 64 + fr, cl = u.pn * BM + wc * 32 + 8 * fq;
#pragma unroll
        for (int ai = 0; ai < 2; ++ai)
#pragma unroll
            for (int m = 0; m < 4; ++m) { const int r = row0 + ai * HALF + m * 16; const float* rp = (r < split ? r0 + (size_t)r * 1024 : r1 + (size_t)(r - split) * 1024) + cl; float* op = out + (size_t)r * 1024 + cl;
#pragma unroll
                for (int bj = 0; bj < 2; ++bj)
#pragma unroll
                    for (int n = 0; n < 2; ++n) { const f32x4 x = *(const f32x4*)(rp + bj * HALF + 4 * n); *(f32x4*)(op + bj * HALF + 4 * n) = acc[ai][bj][m][n] + x; } }
    }
};
struct EpiPlanes {
    static constexpr bool PERM = true, AFTER_DRAIN = false;
    bf16_t* P0; bf16_t* P1; int tiles_per_plane, ldc;
    __device__ __forceinline__ void operator()(const f32x4 (&acc)[2][2][4][2], const Unit& u, int wr, int wc, int fr, int fq) const {
        const int row0 = u.pm * BM + wr * 64 + fr; const bool second = u.pn >= tiles_per_plane; bf16_t* base = second ? P1 : P0; const int cl = (second ? u.pn - tiles_per_plane : u.pn) * BM + wc * 32 + 8 * fq;
#pragma unroll
        for (int ai = 0; ai < 2; ++ai)
#pragma unroll
            for (int m = 0; m < 4; ++m) { bf16_t* rowp = base + (size_t)(row0 + ai * HALF + m * 16) * ldc + cl;
#pragma unroll
                for (int bj = 0; bj < 2; ++bj) *(u32x4*)(rowp + bj * HALF) = pack8(acc[ai][bj][m][0], acc[ai][bj][m][1]); }
    }
};
struct EpiOut2 {
    static constexpr bool PERM = true, AFTER_DRAIN = false;
    const float* r0; const float* r1; int split; float* out; bf16_t* XB; float* ROWSS;
    __device__ __forceinline__ void operator()(const f32x4 (&acc)[2][2][4][2], const Unit& u, int wr, int wc, int fr, int fq) const {
        const int row0 = u.pm * BM + wr * 64 + fr, cl = u.pn * BM + wc * 32 + 8 * fq;
#pragma unroll
        for (int ai = 0; ai < 2; ++ai)
#pragma unroll
            for (int m = 0; m < 4; ++m) { const int r = row0 + ai * HALF + m * 16; const float* rp = (r < split ? r0 + (size_t)r * 1024 : r1 + (size_t)(r - split) * 1024) + cl;
                float ss = 0.f;
#pragma unroll
                for (int bj = 0; bj < 2; ++bj) { f32x4 v[2];
#pragma unroll
                    for (int n = 0; n < 2; ++n) { v[n] = acc[ai][bj][m][n] + *(const f32x4*)(rp + bj * HALF + 4 * n);
                        ss += (v[n][0] * v[n][0] + v[n][1] * v[n][1]) + (v[n][2] * v[n][2] + v[n][3] * v[n][3]); }
                    *(u32x4*)(XB + (size_t)r * 1024 + cl + bj * HALF) = pack8(v[0], v[1]); }
                ss += __shfl_xor(ss, 16); ss += __shfl_xor(ss, 32);
                if (fq == 0) ROWSS[(size_t)r * 16 + u.pn * 4 + wc] = ss; }
    }
};
struct EpiUpConv {
    static constexpr bool PERM = true, AFTER_DRAIN = false;
    const float* ROWSS; const float* ROWSS_S; const float* conv_w; const float* conv_b; const float* state_conv; bf16_t* HID; float* EA; float* EB; float* o_conv_p; float* o_conv_s; PG8_LAS float* xch;
    static constexpr int FF = 2816;
    __device__ __forceinline__ static float gelu_t(float x) { const float u2 = 1.5957691216057308f * (x + 0.044715f * x * x * x); return x * frcp(1.f + __expf(-u2)); }
    __device__ __forceinline__ void operator()(const f32x4 (&acc)[2][2][4][2], const Unit& u, int wr, int wc, int fr, int fq) const {
        const int lane = fq * 16 + fr, row0 = u.pm * BM + wr * 64 + fr, j0 = u.pn * 128 + wc * 32 + 8 * fq;
        const bool smp = u.pm >= 64;
        float rstd[2][4];
#pragma unroll
        for (int ai = 0; ai < 2; ++ai)
#pragma unroll
            for (int m = 0; m < 4; ++m) { const int r = row0 + ai * HALF + m * 16; float s;
                if (!smp) { const f32x4 p = *(const f32x4*)(ROWSS + (size_t)r * 16 + 4 * fq); s = (p[0] + p[1]) + (p[2] + p[3]); }
                else { const f32x4 p = *(const f32x4*)(ROWSS_S + (size_t)(r - 16384) * 32 + 8 * fq), q = *(const f32x4*)(ROWSS_S + (size_t)(r - 16384) * 32 + 8 * fq + 4); s = ((p[0] + p[1]) + (p[2] + p[3])) + ((q[0] + q[1]) + (q[2] + q[3])); }
                s += __shfl_xor(s, 16); s += __shfl_xor(s, 32); rstd[ai][m] = 1.0f / sqrtf(s * (1.f / 1024.f) + 1e-6f); }
        if (!smp) {
            if (fr >= 14) {
#pragma unroll
                for (int ai = 0; ai < 2; ++ai)
#pragma unroll
                    for (int n = 0; n < 2; ++n) *(PG8_LAS f32x4*)(xch + ((((ai * 2 + wr) * 4 + wc) * 4 + fq) * 2 + (fr - 14)) * 8 + 4 * n) = acc[ai][0][3][n] * rstd[ai][3]; }
            asm volatile("s_waitcnt lgkmcnt(0)" ::: "memory"); __builtin_amdgcn_s_barrier(); asm volatile("" ::: "memory");
        }
        const int src1 = (lane & 48) | ((fr + 15) & 15), src2 = (lane & 48) | ((fr + 14) & 15);
#pragma unroll
        for (int n = 0; n < 2; ++n) {
            const f32x4 cb = *(const f32x4*)(conv_b + j0 + 4 * n), w0 = *(const f32x4*)(conv_w + j0 + 4 * n), w1 = *(const f32x4*)(conv_w + FF + j0 + 4 * n), w2 = *(const f32x4*)(conv_w + 2 * FF + j0 + 4 * n);
#pragma unroll
            for (int ai = 0; ai < 2; ++ai) {
                f32x4 pa = (f32x4){0.f, 0.f, 0.f, 0.f};
                if (!smp && fr >= 14 && (wr == 1 || ai == 1)) { const int sai = wr == 1 ? ai : 0, swr = wr == 1 ? 0 : 1;
                    pa = *(const PG8_LAS f32x4*)(xch + ((((sai * 2 + swr) * 4 + wc) * 4 + fq) * 2 + (fr - 14)) * 8 + 4 * n); }
#pragma unroll
                for (int m = 0; m < 4; ++m) {
                    const int r = row0 + ai * HALF + m * 16; const float rs = rstd[ai][m];
                    const f32x4 a = acc[ai][0][m][n] * rs, b = acc[ai][1][m][n] * rs; f32x4 p1, p2;
                    if (!smp) {
#pragma unroll
                        for (int e2 = 0; e2 < 4; ++e2) { const float s1 = fr == 15 ? pa[e2] : a[e2], s2 = fr >= 14 ? pa[e2] : a[e2]; p1[e2] = __shfl(s1, src1); p2[e2] = __shfl(s2, src2); }
                        if (ai == 0 && wr == 0 && m == 0 && fr < 2) { *(f32x4*)(EA + ((size_t)u.pm * 4 + fr) * FF + j0 + 4 * n) = a; *(f32x4*)(EB + ((size_t)u.pm * 2 + fr) * FF + j0 + 4 * n) = b; }
                        if (ai == 1 && wr == 1 && m == 3 && fr >= 14) { *(f32x4*)(EA + ((size_t)u.pm * 4 + 2 + (fr - 14)) * FF + j0 + 4 * n) = a;
                            if ((u.pm & 7) == 7) *(f32x4*)(o_conv_p + ((size_t)(u.pm >> 3) * 2 + (fr - 14)) * FF + j0 + 4 * n) = a; }
                    } else {
                        const int t = fr & 7, bb = (r - 16384) >> 3;
#pragma unroll
                        for (int e2 = 0; e2 < 4; ++e2) { p1[e2] = __shfl(a[e2], src1); p2[e2] = __shfl(a[e2], src2); }
                        if (t < 2) { const f32x4 h1 = *(const f32x4*)(state_conv + ((size_t)bb * 2 + 1) * FF + j0 + 4 * n);
                            if (t == 0) { p1 = h1; p2 = *(const f32x4*)(state_conv + ((size_t)bb * 2) * FF + j0 + 4 * n); } else p2 = h1; }
                        if (t >= 6) *(f32x4*)(o_conv_s + ((size_t)bb * 2 + (t - 6)) * FF + j0 + 4 * n) = a;
                    }
                    f32x4 hv;
#pragma unroll
                    for (int e2 = 0; e2 < 4; ++e2) { const float c = cb[e2] + w0[e2] * p2[e2] + w1[e2] * p1[e2] + w2[e2] * a[e2]; hv[e2] = gelu_t(c) * b[e2]; }
                    *(u32x2*)(HID + (size_t)r * FF + j0 + 4 * n) = (u32x2){cvt_pk_bf16(hv[0], hv[1]), cvt_pk_bf16(hv[2], hv[3])};
                    pa = a;
                }
            }
        }
    }
};
struct EpiResB {
    static constexpr bool PERM = true, AFTER_DRAIN = false;
    const bf16_t* XB; float* out;
    __device__ __forceinline__ void operator()(const f32x4 (&acc)[2][2][4][2], const Unit& u, int wr, int wc, int fr, int fq) const {
        const int row0 = u.pm * BM + wr * 64 + fr, cl = u.pn * BM + wc * 32 + 8 * fq;
#pragma unroll
        for (int ai = 0; ai < 2; ++ai)
#pragma unroll
            for (int m = 0; m < 4; ++m) { const int r = row0 + ai * HALF + m * 16; float* op = out + (size_t)r * 1024 + cl;
#pragma unroll
                for (int bj = 0; bj < 2; ++bj) { const u32x4 xb = *(const u32x4*)(XB + (size_t)r * 1024 + cl + bj * HALF);
                    f32x4 x0, x1;
                    x0[0] = __builtin_bit_cast(float, xb[0] << 16); x0[1] = __builtin_bit_cast(float, xb[0] & 0xffff0000u); x0[2] = __builtin_bit_cast(float, xb[1] << 16); x0[3] = __builtin_bit_cast(float, xb[1] & 0xffff0000u);
                    x1[0] = __builtin_bit_cast(float, xb[2] << 16); x1[1] = __builtin_bit_cast(float, xb[2] & 0xffff0000u); x1[2] = __builtin_bit_cast(float, xb[3] << 16); x1[3] = __builtin_bit_cast(float, xb[3] & 0xffff0000u);
                    *(f32x4*)(op + bj * HALF) = acc[ai][bj][m][0] + x0; *(f32x4*)(op + bj * HALF + 4) = acc[ai][bj][m][1] + x1; } }
    }
};
template <class Epi, class Sched, bool ALIGN_EPI = false, bool SP2 = false>
__device__ __forceinline__ void gemm_phase(PG8_LAS unsigned char* lds, const Gemm g, const Sched& S, const Epi& E) {
    const int tid = threadIdx.x, wid = __builtin_amdgcn_readfirstlane(tid >> 6), lane = tid & 63, wr = wid >> 2, wc = wid & 3, fr = lane & 15, fq = lane >> 4;
    const int K = g.K, nt = K / BK;
    unsigned voffA[2], voffB[2];
#pragma unroll
    for (int i = 0; i < 2; ++i) { int R, C; stage_rc(tid * 16 + i * 8192, R, C); const int Rb = Epi::PERM ? ((R & ~31) + perm32(R & 31)) : R;
        voffA[i] = (unsigned)(R * K + C) * 2u; voffB[i] = (unsigned)(Rb * K + C) * 2u; }
    const size_t kstep = (size_t)(BK * 2);
    const size_t hstep = (size_t)HALF * K * 2;
    const size_t tstep = 2 * hstep;
    const unsigned ldsw = (unsigned)wid * 1024u;
    const int aoff = lds_byte(wr * 64 + fr, fq * 8), boff = lds_byte(wc * 32 + fr, fq * 8);
#define PG8_SA(b, h) (((b) * 2 + (h)) * HTB)
#define PG8_SB(b, h) ((4 + (b) * 2 + (h)) * HTB)
#define PG8_STAGE(bufoff, gbase, voff) do { _Pragma("unroll") for (int _i = 0; _i < 2; ++_i) \
        __builtin_amdgcn_global_load_lds((const unsigned*)((const char*)(gbase) + (voff)[_i]), (PG8_LAS unsigned*)(lds + (bufoff) + ldsw + _i * 8192), 16, 0, 0); } while (0)
#define PG8_LDA(dst, b, h) do { _Pragma("unroll") for (int m = 0; m < 4; ++m) _Pragma("unroll") for (int k = 0; k < 2; ++k) dst[m][k] = *(const PG8_LAS bf16x8*)(lds + PG8_SA(b, h) + aoff + m * 2048 + k * 1024); } while (0)
#define PG8_LDB(dst, b, h) do { _Pragma("unroll") for (int n = 0; n < 2; ++n) _Pragma("unroll") for (int k = 0; k < 2; ++k) dst[n][k] = *(const PG8_LAS bf16x8*)(lds + PG8_SB(b, h) + boff + n * 2048 + k * 1024); } while (0)
#define PG8_MMA(ai, bj, At, Bt) do { __builtin_amdgcn_s_setprio(1); _Pragma("unroll") for (int m = 0; m < 4; ++m) _Pragma("unroll") for (int n = 0; n < 2; ++n) _Pragma("unroll") for (int k = 0; k < 2; ++k) \
        acc[ai][bj][m][n] = __builtin_amdgcn_mfma_f32_16x16x32_bf16(Bt[n][k], At[m][k], acc[ai][bj][m][n], 0, 0, 0); __builtin_amdgcn_s_setprio(0); } while (0)
#define PG8_WAIT_V(n) asm volatile("s_waitcnt vmcnt(" #n ")" ::: "memory")
#define PG8_WAIT_L(n) asm volatile("s_waitcnt lgkmcnt(" #n ")" ::: "memory")
#define PG8_BAR __builtin_amdgcn_s_barrier()
#define PG8_SCHED __builtin_amdgcn_sched_barrier(0)
    Unit cur, nxt; int ui = 0;
    if (!S.next(0, cur)) return;
    f32x4 acc[2][2][4][2];
#pragma unroll
    for (int a = 0; a < 2; ++a)
#pragma unroll
        for (int b = 0; b < 2; ++b)
#pragma unroll
            for (int m = 0; m < 4; ++m)
#pragma unroll
                for (int n = 0; n < 2; ++n) acc[a][b][m][n] = (f32x4){0.f, 0.f, 0.f, 0.f};
    bf16x8 At[4][2], B0[2][2], B1[2][2];
    const char* cA = (const char*)g.A + (size_t)cur.pm * tstep; const char* cB = (const char*)g.Bt + (size_t)cur.pn * tstep;
    S.a_ready(cur);
    if constexpr (SP2) {
        PG8_STAGE(PG8_SB(0, 0), cB, voffB); PG8_STAGE(PG8_SB(0, 1), cB + hstep, voffB); PG8_STAGE(PG8_SA(0, 0), cA, voffA); PG8_STAGE(PG8_SA(0, 1), cA + hstep, voffA);
        if (wr == 1) PG8_BAR;
        PG8_WAIT_V(2); PG8_BAR;
        PG8_STAGE(PG8_SB(1, 0), cB + kstep, voffB); PG8_STAGE(PG8_SA(1, 0), cA + kstep, voffA); PG8_STAGE(PG8_SB(1, 1), cB + hstep + kstep, voffB);
        PG8_WAIT_V(6); PG8_BAR;
    } else {
        PG8_STAGE(PG8_SB(0, 0), cB, voffB); PG8_STAGE(PG8_SA(0, 0), cA, voffA); PG8_STAGE(PG8_SB(0, 1), cB + hstep, voffB); PG8_STAGE(PG8_SA(0, 1), cA + hstep, voffA);
        if (wr == 1) PG8_BAR;
        PG8_WAIT_V(4); PG8_BAR;
        PG8_STAGE(PG8_SB(1, 0), cB + kstep, voffB); PG8_STAGE(PG8_SA(1, 0), cA + kstep, voffA); PG8_STAGE(PG8_SB(1, 1), cB + hstep + kstep, voffB);
        PG8_WAIT_V(6); PG8_BAR;
    }
    for (;;) {
        const bool has_next = S.next(ui + 1, nxt);
        const char* nA = has_next ? (const char*)g.A + (size_t)nxt.pm * tstep : cA; const char* nB = has_next ? (const char*)g.Bt + (size_t)nxt.pn * tstep : cB;
        for (int t = 0; t < nt; t += 2) {
            const bool last = (t == nt - 2);
            const char* a1 = cA + (size_t)(t + 1) * kstep;
            const char* a2 = last ? nA : cA + (size_t)(t + 2) * kstep; const char* b2 = last ? nB : cB + (size_t)(t + 2) * kstep;
            const char* a3 = a2 + kstep; const char* b3 = b2 + kstep;
            if (last && has_next) S.a_ready(nxt);
            if constexpr (SP2) {
            PG8_LDB(B0, 0, 0); PG8_LDB(B1, 0, 1); PG8_SCHED; PG8_LDA(At, 0, 0); PG8_STAGE(PG8_SA(1, 1), a1 + hstep, voffA);
            PG8_WAIT_V(8); PG8_WAIT_L(0); PG8_BAR; PG8_MMA(0, 0, At, B0); PG8_MMA(0, 1, At, B1); PG8_BAR; PG8_SCHED;
            PG8_LDA(At, 0, 1); PG8_STAGE(PG8_SB(0, 0), b2, voffB); PG8_STAGE(PG8_SB(0, 1), b2 + hstep, voffB); PG8_STAGE(PG8_SA(0, 0), a2, voffA);
            PG8_WAIT_V(8); PG8_WAIT_L(0); PG8_BAR; PG8_MMA(1, 0, At, B0); PG8_MMA(1, 1, At, B1); PG8_BAR; PG8_SCHED;
            PG8_LDB(B0, 1, 0); PG8_LDB(B1, 1, 1); PG8_SCHED; PG8_LDA(At, 1, 0); PG8_STAGE(PG8_SA(0, 1), a2 + hstep, voffA);
            PG8_WAIT_V(8); PG8_WAIT_L(0); PG8_BAR; PG8_MMA(0, 0, At, B0); PG8_MMA(0, 1, At, B1); PG8_BAR; PG8_SCHED;
            PG8_LDA(At, 1, 1); PG8_STAGE(PG8_SB(1, 0), b3, voffB); PG8_STAGE(PG8_SB(1, 1), b3 + hstep, voffB); PG8_STAGE(PG8_SA(1, 0), a3, voffA);
            PG8_WAIT_V(8); PG8_WAIT_L(0); PG8_BAR; PG8_MMA(1, 0, At, B0); PG8_MMA(1, 1, At, B1); PG8_BAR; PG8_SCHED;
            } else {
            PG8_LDB(B0, 0, 0); PG8_SCHED; PG8_LDA(At, 0, 0); PG8_STAGE(PG8_SA(1, 1), a1 + hstep, voffA);
            PG8_WAIT_L(8); PG8_BAR; PG8_WAIT_L(0); PG8_MMA(0, 0, At, B0); PG8_BAR; PG8_SCHED;
            PG8_LDB(B1, 0, 1); PG8_STAGE(PG8_SB(0, 0), b2, voffB);
            PG8_BAR; PG8_WAIT_L(0); PG8_MMA(0, 1, At, B1); PG8_BAR;
            PG8_LDA(At, 0, 1); PG8_STAGE(PG8_SA(0, 0), a2, voffA);
            PG8_BAR; PG8_WAIT_L(0); PG8_MMA(1, 0, At, B0); PG8_BAR; PG8_SCHED;
            PG8_STAGE(PG8_SB(0, 1), b2 + hstep, voffB);
            PG8_WAIT_V(6); PG8_BAR; PG8_MMA(1, 1, At, B1); PG8_BAR;
            PG8_LDB(B0, 1, 0); PG8_SCHED; PG8_LDA(At, 1, 0); PG8_STAGE(PG8_SA(0, 1), a2 + hstep, voffA);
            PG8_WAIT_L(8); PG8_BAR; PG8_WAIT_L(0); PG8_MMA(0, 0, At, B0); PG8_BAR; PG8_SCHED;
            PG8_LDB(B1, 1, 1); PG8_STAGE(PG8_SB(1, 0), b3, voffB);
            PG8_BAR; PG8_WAIT_L(0); PG8_MMA(0, 1, At, B1); PG8_BAR;
            PG8_LDA(At, 1, 1); PG8_STAGE(PG8_SA(1, 0), a3, voffA);
            PG8_BAR; PG8_WAIT_L(0); PG8_MMA(1, 0, At, B0); PG8_BAR; PG8_SCHED;
            PG8_STAGE(PG8_SB(1, 1), b3 + hstep, voffB);
            PG8_WAIT_V(6); PG8_BAR; PG8_MMA(1, 1, At, B1); PG8_BAR;
            }
        }
        if constexpr (ALIGN_EPI) { if (wr == 0) PG8_BAR; }
        if constexpr (!Epi::AFTER_DRAIN) { E(acc, cur, wr, wc, fr, fq); S.done(cur); }
        if (!has_next) break;
#pragma unroll
        for (int a = 0; a < 2; ++a)
#pragma unroll
            for (int b = 0; b < 2; ++b)
#pragma unroll
                for (int m = 0; m < 4; ++m)
#pragma unroll
                    for (int n = 0; n < 2; ++n) acc[a][b][m][n] = (f32x4){0.f, 0.f, 0.f, 0.f};
        cur = nxt; cA = nA; cB = nB; ++ui;
        if constexpr (ALIGN_EPI) { if (wr == 1) PG8_BAR; }
    }
    PG8_WAIT_V(0);
    if constexpr (!ALIGN_EPI) { if (wr == 0) PG8_BAR; }
    PG8_BAR;
    if constexpr (Epi::AFTER_DRAIN) { E.fused(acc, cur, wr, wc, fr, fq, lds, wid, lane); S.done(cur); }
#undef PG8_SA
#undef PG8_SB
#undef PG8_STAGE
#undef PG8_LDA
#undef PG8_LDB
#undef PG8_MMA
#undef PG8_WAIT_V
#undef PG8_WAIT_L
#undef PG8_BAR
#undef PG8_SCHED
}
}
#define GAS __attribute__((address_space(1)))
#define LAS __attribute__((address_space(3)))
typedef unsigned short bf16;
typedef unsigned v4u __attribute__((ext_vector_type(4)));
typedef float f32x4 __attribute__((ext_vector_type(4)));
typedef short bf16x8 __attribute__((ext_vector_type(8)));
typedef GAS unsigned gu32;
typedef GAS unsigned long long gu64;
#define RLX_AGENT __ATOMIC_RELAXED, __HIP_MEMORY_SCOPE_AGENT
#define LDS_WAIT() asm volatile("s_waitcnt lgkmcnt(0)" ::: "memory")
#define VM_WAIT() asm volatile("s_waitcnt vmcnt(0)" ::: "memory")
__device__ __forceinline__ unsigned long long rt() { return __builtin_amdgcn_s_memrealtime(); }
__device__ __forceinline__ unsigned f2bf(float f) { unsigned u = __builtin_bit_cast(unsigned, f); return (u + 0x7fffu + ((u >> 16) & 1u)) >> 16; }
__device__ __forceinline__ unsigned pk2(float lo, float hi) { return f2bf(lo) | (f2bf(hi) << 16); }

#define XB_TMO      128
#define XB_XCNT(j)  (256  + 64 * (j))
#define XB_XSUB(j)  (1280 + 64 * (j))
#define XB_XGEN(j)  (2304 + 64 * (j))
#define XB_TOP      3328
#define XB_TOPGEN   3392
#define XCD_BAR_WORDS 3456
#define XB_SPIN_CAP (1u << 18)

__device__ __forceinline__ unsigned xb_ld(unsigned* p)              { return __hip_atomic_load(p, __ATOMIC_RELAXED, __HIP_MEMORY_SCOPE_AGENT); }
__device__ __forceinline__ unsigned xb_add(unsigned* p, unsigned v) { return __hip_atomic_fetch_add(p, v, __ATOMIC_RELAXED, __HIP_MEMORY_SCOPE_AGENT); }
__device__ __forceinline__ unsigned xb_xcc_id() { return (unsigned)__builtin_amdgcn_s_getreg((3 << 11) | 20) & 0xFu; }
#define XB_SPIN(cond, bar) do { unsigned _sp = 0; while (cond) { __builtin_amdgcn_s_sleep(1); \
    if ((++_sp & 255u) == 0u) { if (xb_ld(&(bar)[XB_TMO])) break; if (_sp > XB_SPIN_CAP) { atomicAdd(&(bar)[XB_TMO], 1u); break; } } } } while (0)

struct XcdBarrier {
    unsigned* bar; unsigned x;
    volatile LAS unsigned* st;
};

__device__ __forceinline__ XcdBarrier xcd_barrier_post(unsigned* bar, volatile LAS unsigned* st) {
    XcdBarrier b; b.bar = bar; b.x = xb_xcc_id(); b.st = st;
    if (threadIdx.x == 0) (void)xb_add(&bar[XB_XCNT(b.x)], 1u);
    return b;
}
__device__ __forceinline__ void xcd_barrier_complete(unsigned* bar, unsigned x, unsigned& nloc, unsigned& nx) {
    const unsigned G = gridDim.x * gridDim.y * gridDim.z;
    unsigned sum, cnt, mine, sp = 0u;
    for (;;) {
        sum = 0u; cnt = 0u; mine = 0u;
#pragma unroll
        for (unsigned j = 0; j < 16; ++j) { const unsigned c = xb_ld(&bar[XB_XCNT(j)]); sum += c; cnt += (c > 0u) ? 1u : 0u; mine = (j == x) ? c : mine; }
        if (sum == G) break;
        __builtin_amdgcn_s_sleep(1);
        if ((++sp & 255u) == 0u) { if (xb_ld(&bar[XB_TMO])) break; if (sp > XB_SPIN_CAP) { atomicAdd(&bar[XB_TMO], 1u); break; } }
    }
    nloc = mine > 0u ? mine : 1u; nx = cnt > 0u ? cnt : 1u;
}

__device__ __forceinline__ void xcd_barrier(const XcdBarrier& b) {
    asm volatile("s_waitcnt vmcnt(0)" ::: "memory");
    __syncthreads();
    if (threadIdx.x == 0) {
        unsigned* bar = b.bar;
        __builtin_amdgcn_s_waitcnt(0);
        unsigned nloc = b.st[0], nx = b.st[1];
        if (nloc == 0u) { xcd_barrier_complete(bar, b.x, nloc, nx); b.st[0] = nloc; b.st[1] = nx; }
        const unsigned old = xb_add(&bar[XB_XSUB(b.x)], 1u);
        const unsigned gen = old / nloc;
        if (old + 1u == (gen + 1u) * nloc) {
            __builtin_amdgcn_fence(__ATOMIC_RELEASE, "agent");
            asm volatile("s_waitcnt vmcnt(0)" ::: "memory");
            const unsigned og = xb_add(&bar[XB_TOP], 1u);
            const unsigned tg = og / nx;
            if (og + 1u == (tg + 1u) * nx) xb_add(&bar[XB_TOPGEN], 1u);
            else XB_SPIN(xb_ld(&bar[XB_TOPGEN]) == tg, bar);
            __builtin_amdgcn_fence(__ATOMIC_ACQUIRE, "agent");
            xb_add(&bar[XB_XGEN(b.x)], 1u);
            asm volatile("s_waitcnt vmcnt(0)" ::: "memory");
        } else {
            XB_SPIN(xb_ld(&bar[XB_XGEN(b.x)]) == gen, bar);
            __builtin_amdgcn_fence(__ATOMIC_ACQUIRE, "agent");
            asm volatile("s_waitcnt vmcnt(0)" ::: "memory");
        }
    }
    __syncthreads();
}
__device__ __forceinline__ float wave_sum(float v) {
#pragma unroll
    for (int o = 1; o < 64; o <<= 1) v += __shfl_xor(v, o);
    return v;
}
__device__ __forceinline__ void p0_transpose_item(const float* W, int K, int N, bf16* WT, int row_off, LAS float* scr, int item, int lane) {
    const int nblk = N / 32, kb = item / nblk, nb = item % nblk, k0 = 64 * kb, n0 = 32 * nb;
    { const int kk = lane >> 3, n4 = (lane & 7) * 4; f32x4 v[8];
#pragma unroll
      for (int i = 0; i < 8; ++i) v[i] = *(const GAS f32x4*)(W + (size_t)(k0 + kk + 8 * i) * N + n0 + n4);
#pragma unroll
      for (int i = 0; i < 8; ++i) { LAS float* d = scr + (kk + 8 * i) * 33 + n4; d[0] = v[i][0]; d[1] = v[i][1]; d[2] = v[i][2]; d[3] = v[i][3]; } }
    LDS_WAIT(); asm volatile("" ::: "memory");
    const int c = lane & 7;
#pragma unroll
    for (int j = 0; j < 4; ++j) { const int n = (lane >> 3) + 8 * j; const LAS float* s = scr + (8 * c) * 33 + n;
        v4u o; o.x = pk2(s[0 * 33], s[1 * 33]); o.y = pk2(s[2 * 33], s[3 * 33]); o.z = pk2(s[4 * 33], s[5 * 33]); o.w = pk2(s[6 * 33], s[7 * 33]);
        *(GAS v4u*)(WT + (size_t)(row_off + n0 + n) * K + k0 + 8 * c) = o; }
    LDS_WAIT(); asm volatile("" ::: "memory");
}
constexpr int NWAVES = 8;
constexpr int D = 1024, TP = 16384, TS = 1024, MT = TP + TS, MEMR = 2048, DIN = 2560, DFF = 2816, NMEM = 256;
constexpr float EPS = 1e-6f;
#ifndef MK_PER_PHASE
#define MK_PER_PHASE 0
#endif
constexpr int NPHASE = 9;
constexpr size_t MiB = 1u << 20;
constexpr size_t WS_CTL = 0, CTL_ZERO_BYTES = 64 * 1024;
constexpr size_t WS_WIN = 1 * MiB, WS_WKV = 6 * MiB, WS_WOUT = 7 * MiB, WS_WUP = 9 * MiB, WS_WDN = 20 * MiB;
constexpr size_t WS_XN = 26 * MiB;
constexpr size_t WS_XNM = 60 * MiB;
constexpr size_t WS_KVB = 64 * MiB;
constexpr size_t WS_HU = 66 * MiB, WS_HD = 82 * MiB;
constexpr size_t WS_MIX = 83 * MiB;
constexpr size_t WS_U = 117 * MiB, WS_Q = 134 * MiB, WS_LOGF = 151 * MiB, WS_KK = 185 * MiB, WS_V = 202 * MiB, WS_G = 219 * MiB, WS_QX = 236 * MiB;
constexpr size_t WS_EA = 64 * MiB, WS_EB = 68 * MiB, WS_ROWSS = 70 * MiB, WS_ROWSS_S = 72 * MiB;
constexpr size_t WS_PA = 64 * MiB, WS_PB = 158 * MiB;
constexpr size_t WS_END = 256 * MiB;
static_assert(WS_QX + (size_t)MT * 256 * 2 <= WS_END && WS_PB + (size_t)MT * DFF * 2 <= WS_END && WS_PA + (size_t)MT * DFF * 2 <= WS_PB, "d_ws map");
constexpr int CW_BAR = 4096;
constexpr int RING_BYTES = 131072, LDSCTL_OFF = RING_BYTES, MISC_OFF = LDSCTL_OFF + 320, LDS_BYTES = 147456;

struct Args { const float* in[23]; float* out; unsigned char* ws; int ph_lo, ph_hi; };
struct Frame {
    LAS unsigned char* lds; int tid, lane, wave, G;
    const float *x_prompt, *x_sample, *mem_prompt, *state_pool, *state_hgrn, *state_conv, *cache_k, *cache_v, *ln1_g, *w_in, *pool_w, *pool_scale, *lb_logits, *onorm_g, *mem_norm_g, *w_mem_kv, *w_out, *ln2_g, *w_up, *conv_w, *conv_b, *w_down, *lnf_g;
    float *y, *o_pool_p, *o_hgrn_p, *o_conv_p, *o_mk, *o_mv, *o_pool_s, *o_hgrn_s, *o_conv_s;
    bf16 *WIN, *WKV, *WOUT, *WUP, *WDN, *XN, *XNM, *KVB, *MIX, *Q, *KK, *V, *GS, *QX, *PA, *PB;
    float *U, *LOGF, *EA, *EB, *ROWSS, *ROWSS_S;
};
typedef unsigned u32x2v __attribute__((ext_vector_type(2)));
__device__ __forceinline__ float bf2f(bf16 h) { return __builtin_bit_cast(float, (unsigned)h << 16); }
__device__ __forceinline__ float frcp_(float x) { return __builtin_amdgcn_rcpf(x); }
__device__ __forceinline__ float wave_max(float v) {
#pragma unroll
    for (int o = 1; o < 64; o <<= 1) v = fmaxf(v, __shfl_xor(v, o));
    return v;
}
__device__ __forceinline__ void rms_row_to_bf16(int lane, const float* xrow, const float* g, bf16* orow) {
    const GAS f32x4* xr = (const GAS f32x4*)xrow + lane; const GAS f32x4* gr = (const GAS f32x4*)g + lane;
    f32x4 v[4]; float s = 0.f;
#pragma unroll
    for (int j = 0; j < 4; ++j) { v[j] = xr[64 * j]; s += (v[j].x * v[j].x + v[j].y * v[j].y) + (v[j].z * v[j].z + v[j].w * v[j].w); }
    const float rstd = 1.f / sqrtf(wave_sum(s) * (1.f / D) + EPS);
    GAS unsigned long long* o8 = (GAS unsigned long long*)orow + lane;
#pragma unroll
    for (int j = 0; j < 4; ++j) { const f32x4 gg = gr[64 * j]; o8[64 * j] = (unsigned long long)pk2(v[j].x * rstd * gg.x, v[j].y * rstd * gg.y) | ((unsigned long long)pk2(v[j].z * rstd * gg.z, v[j].w * rstd * gg.w) << 32); }
}
__device__ __forceinline__ void p0_transpose_item2(const float* W, int K, int N, bf16* WT, int dst_row0, const float* gain, LAS float* scr, int kb, int nb, int lane) {
    const int k0 = 64 * kb, n0 = 32 * nb;
    { const int kk = lane >> 3, n4 = (lane & 7) * 4; f32x4 v[8];
#pragma unroll
      for (int i = 0; i < 8; ++i) v[i] = *(const GAS f32x4*)(W + (size_t)(k0 + kk + 8 * i) * N + n0 + n4);
#pragma unroll
      for (int i = 0; i < 8; ++i) { LAS float* d = scr + (kk + 8 * i) * 33 + n4; d[0] = v[i][0]; d[1] = v[i][1]; d[2] = v[i][2]; d[3] = v[i][3]; } }
    LDS_WAIT(); asm volatile("" ::: "memory");
    const int c = lane & 7; float gg[8];
#pragma unroll
    for (int e = 0; e < 8; ++e) gg[e] = gain[k0 + 8 * c + e];
#pragma unroll
    for (int j = 0; j < 4; ++j) { const int n = (lane >> 3) + 8 * j; const LAS float* s = scr + (8 * c) * 33 + n;
        v4u o; o.x = pk2(s[0 * 33] * gg[0], s[1 * 33] * gg[1]); o.y = pk2(s[2 * 33] * gg[2], s[3 * 33] * gg[3]); o.z = pk2(s[4 * 33] * gg[4], s[5 * 33] * gg[5]); o.w = pk2(s[6 * 33] * gg[6], s[7 * 33] * gg[7]);
        *(GAS v4u*)(WT + (size_t)(dst_row0 + n) * K + k0 + 8 * c) = o; }
    LDS_WAIT(); asm volatile("" ::: "memory");
}
__device__ __forceinline__ void p0_prologue(Frame& F) {
    LAS float* scr = (LAS float*)(F.lds + F.wave * 16384);
    const int gw = blockIdx.x * NWAVES + F.wave, NGW = F.G * NWAVES;
    constexpr int I_IN = (D / 64) * (DIN / 32), I_KV = (D / 64) * (512 / 32), I_UP = (D / 64) * (2 * DFF / 32);
    for (int it = gw; it < I_IN + I_KV + I_UP; it += NGW) {
        if (it < I_IN) p0_transpose_item(F.w_in, D, DIN, F.WIN, 0, scr, it, F.lane);
        else if (it < I_IN + I_KV) p0_transpose_item(F.w_mem_kv, D, 512, F.WKV, 0, scr, it - I_IN, F.lane);
        else { const int r = it - I_IN - I_KV, nblk = 2 * DFF / 32, kb = r / nblk, nb = r % nblk, n0 = 32 * nb, j = n0 < DFF ? n0 : n0 - DFF;
            p0_transpose_item2(F.w_up, D, 2 * DFF, F.WUP, (j >> 7) * 256 + (j & 127) + (n0 < DFF ? 0 : 128), F.ln2_g, scr, kb, nb, F.lane); }
    }
    auto row_src = [&](int m) -> const float* { return m < TP ? F.x_prompt + (size_t)m * D : m < MT ? F.x_sample + (size_t)(m - TP) * D : F.mem_prompt + (size_t)(m - MT) * D; };
    auto row_dst = [&](int m) -> bf16* { return m < MT ? F.XN + (size_t)m * D : F.XNM + (size_t)(m - MT) * D; };
    for (int m = gw; m < MT + MEMR; m += 2 * NGW) {
        const int m2 = m + NGW; const bool two = m2 < MT + MEMR;
        const GAS f32x4* xa = (const GAS f32x4*)row_src(m) + F.lane; const GAS f32x4* xb = (const GAS f32x4*)row_src(two ? m2 : m) + F.lane;
        f32x4 va[4], vb[4]; float sa = 0.f, sb = 0.f;
#pragma unroll
        for (int j = 0; j < 4; ++j) { va[j] = xa[64 * j]; vb[j] = xb[64 * j]; }
#pragma unroll
        for (int j = 0; j < 4; ++j) { sa += (va[j].x * va[j].x + va[j].y * va[j].y) + (va[j].z * va[j].z + va[j].w * va[j].w); sb += (vb[j].x * vb[j].x + vb[j].y * vb[j].y) + (vb[j].z * vb[j].z + vb[j].w * vb[j].w); }
        const float ra = 1.f / sqrtf(wave_sum(sa) * (1.f / D) + EPS), rb = 1.f / sqrtf(wave_sum(sb) * (1.f / D) + EPS);
        const GAS f32x4* ga = (const GAS f32x4*)(m < MT ? F.ln1_g : F.mem_norm_g) + F.lane; const GAS f32x4* gb = (const GAS f32x4*)((two ? m2 : m) < MT ? F.ln1_g : F.mem_norm_g) + F.lane;
        GAS unsigned long long* oa = (GAS unsigned long long*)row_dst(m) + F.lane; GAS unsigned long long* ob = (GAS unsigned long long*)row_dst(two ? m2 : m) + F.lane;
#pragma unroll
        for (int j = 0; j < 4; ++j) { const f32x4 g1 = ga[64 * j]; oa[64 * j] = (unsigned long long)pk2(va[j].x * ra * g1.x, va[j].y * ra * g1.y) | ((unsigned long long)pk2(va[j].z * ra * g1.z, va[j].w * ra * g1.w) << 32); }
        if (two) {
#pragma unroll
            for (int j = 0; j < 4; ++j) { const f32x4 g2 = gb[64 * j]; ob[64 * j] = (unsigned long long)pk2(vb[j].x * rb * g2.x, vb[j].y * rb * g2.y) | ((unsigned long long)pk2(vb[j].z * rb * g2.z, vb[j].w * rb * g2.w) << 32); } }
    }
}
__device__ __forceinline__ void p0_late(Frame& F, int gw, int NGW) {
    LAS float* scr = (LAS float*)(F.lds + F.wave * 16384);
    constexpr int I_OUT = (D / 64) * (D / 32), I_DN = (DFF / 64) * (D / 32);
    for (int it = gw; it < I_OUT + I_DN; it += NGW) {
        int r = it;
        if (r < I_OUT) { if (r >= 4 * (D / 32)) p0_transpose_item(F.w_out, D, D, F.WOUT, 0, scr, r, F.lane); continue; } r -= I_OUT;
        p0_transpose_item(F.w_down, DFF, D, F.WDN, 0, scr, r, F.lane);
    }
    for (int it = gw; it < 2048; it += NGW) { const int g = it >> 9, c2 = (it >> 4) & 31, n = (it & 15) * 64 + F.lane;
        const float* p0 = F.pool_w + (size_t)g * 4096 + (2 * c2) * 64; const float* p1 = p0 + 64; float o0 = 0.f, o1 = 0.f;
#pragma unroll
        for (int dd = 0; dd < 64; ++dd) { const float sw = F.pool_scale[64 * g + dd] * F.w_out[(size_t)(64 * g + dd) * D + n]; o0 += p0[dd] * sw; o1 += p1[dd] * sw; }
        *(GAS unsigned*)(F.WOUT + (size_t)n * D + 64 * g + 2 * c2) = pk2(o0, o1); }
}
__device__ __forceinline__ void pool_phase(Frame& F) {
    const int total = (MT / 8) * 64;
    for (int i = blockIdx.x * 512 + F.tid; i < total; i += F.G * 512) {
        const int r0 = (i >> 6) * 8, c = (i & 63) * 4, g = c >> 6; const bool smp = r0 >= TP; const int rr = smp ? r0 - TP : r0; const int b = smp ? rr >> 3 : rr >> 11, t0 = smp ? 0 : rr & 2047;
        const float* ub = F.U + (size_t)(r0 - t0) * 256 + c;
        f32x4 x[23];
#pragma unroll
        for (int k = 0; k < 23; ++k) { const int tau = t0 - 15 + k;
            if (tau >= 0) x[k] = *(const GAS f32x4*)(ub + (size_t)tau * 256); else if (smp) x[k] = *(const GAS f32x4*)(F.state_pool + ((size_t)b * 15 + 15 + tau) * 256 + c); else x[k] = (f32x4){0.f, 0.f, 0.f, 0.f}; }
        f32x4 s2[23], s4[23], s8[23], s16[8];
#pragma unroll
        for (int k = 1; k < 23; ++k) s2[k] = x[k] + x[k - 1];
#pragma unroll
        for (int k = 3; k < 23; ++k) s4[k] = s2[k] + s2[k - 2];
#pragma unroll
        for (int k = 7; k < 23; ++k) s8[k] = s4[k] + s4[k - 4];
#pragma unroll
        for (int k = 0; k < 8; ++k) s16[k] = s8[15 + k] + s8[7 + k];
        const float wf = (float)(2 << g);
#pragma unroll
        for (int k = 0; k < 8; ++k) { const int t = t0 + k;
            const f32x4 s = g == 0 ? s2[15 + k] : g == 1 ? s4[15 + k] : g == 2 ? s8[15 + k] : s16[k];
            const float cnt = smp ? wf : fminf(wf, (float)(t + 1));
            const f32x4 dd = s * (1.f / cnt) - x[15 + k];
            *(GAS u32x2v*)(F.MIX + (size_t)(r0 + k) * D + c) = (u32x2v){pk2(dd[0], dd[1]), pk2(dd[2], dd[3])}; }
        if (smp || t0 == 2040) { float* np = (smp ? F.o_pool_s : F.o_pool_p) + (size_t)b * 15 * 256 + c;
#pragma unroll
            for (int k = 0; k < 15; ++k) *(GAS f32x4*)(np + k * 256) = x[8 + k]; }
    }
}
__device__ __forceinline__ void hgrn_naive_phase(Frame& F) {
    LAS float* qs = (LAS float*)F.lds; LAS float* fs = qs + 128; LAS float* ks = fs + 128; LAS float* part = ks + 128; LAS float* red = part + 512;
    const int tid = F.tid, dv = tid & 127, qd = tid >> 7;
    for (int u = blockIdx.x; u < 32 + 512; u += F.G) {
        const bool smp = u >= 32; const int bh = smp ? u - 32 : u, b = bh >> 2, h = bh & 3, L = smp ? 8 : 2048, row0 = smp ? TP + b * 8 : b * 2048;
        float S[32];
#pragma unroll
        for (int j = 0; j < 32; ++j) S[j] = smp ? F.state_hgrn[(((size_t)b * 4 + h) * 128 + qd * 32 + j) * 128 + dv] : 0.f;
        for (int t = 0; t < L; ++t) {
            const size_t ro = (size_t)(row0 + t) * 512 + h * 128;
            if (tid < 128) { qs[tid] = bf2f(F.Q[ro + tid]); fs[tid] = __expf(F.LOGF[ro + tid]); ks[tid] = bf2f(F.KK[ro + tid]); }
            const float v = bf2f(F.V[ro + dv]);
            __syncthreads();
            float op = 0.f;
#pragma unroll
            for (int j = 0; j < 32; ++j) { const int dk = qd * 32 + j; S[j] = fs[dk] * S[j] + ks[dk] * v; op += qs[dk] * S[j]; }
            part[qd * 128 + dv] = op;
            __syncthreads();
            const float o = (part[dv] + part[128 + dv]) + (part[256 + dv] + part[384 + dv]);
            const float ss = wave_sum(o * o);
            if (F.lane == 0) red[F.wave] = ss;
            __syncthreads();
            if (qd == 0) { const float tot = red[0] + red[1];
                F.MIX[(size_t)(row0 + t) * D + 256 + h * 128 + dv] = (bf16)f2bf(o * (1.f / sqrtf(tot * (1.f / 128.f) + EPS)) * F.onorm_g[h * 128 + dv] * bf2f(F.GS[ro + dv])); }
        }
        float* so = (smp ? F.o_hgrn_s : F.o_hgrn_p) + ((size_t)b * 4 + h) * 128 * 128;
#pragma unroll
        for (int j = 0; j < 32; ++j) so[(size_t)(qd * 32 + j) * 128 + dv] = S[j];
        __syncthreads();
    }
}
__device__ __forceinline__ void xattn_naive_phase(Frame& F) {
    const int half = F.tid >> 8, t2 = F.tid & 255, wv = t2 >> 6;
    LAS float* q = (LAS float*)F.lds + half * 1024; LAS float* p = q + 64; LAS float* red = p + 256; LAS float* po = red + 8;
    for (int it = blockIdx.x; it < MT * 2; it += F.G) {
        const int item = it * 2 + half, r = item >> 2, h = item & 3; const bool smp = r >= TP; const int b = smp ? (r - TP) >> 3 : r >> 11;
        if (t2 < 64) q[t2] = bf2f(F.QX[(size_t)r * 256 + h * 64 + t2]);
        __syncthreads();
        float s = 0.f;
        if (smp) { const float* kr = F.cache_k + ((size_t)b * NMEM + t2) * 256 + h * 64; for (int d = 0; d < 64; ++d) s += q[d] * kr[d]; }
        else { const bf16* kr = F.KVB + ((size_t)b * NMEM + t2) * 512 + h * 64; for (int d = 0; d < 64; ++d) s += q[d] * bf2f(kr[d]); }
        float m = wave_max(s);
        if (F.lane == 0) red[wv] = m;
        __syncthreads();
        m = fmaxf(fmaxf(red[0], red[1]), fmaxf(red[2], red[3]));
        const float e = exp2f(s - m);
        p[t2] = e;
        float sum = wave_sum(e);
        __syncthreads();
        if (F.lane == 0) red[wv] = sum;
        __syncthreads();
        sum = (red[0] + red[1]) + (red[2] + red[3]);
        const int d = t2 & 63, pt = t2 >> 6; float o = 0.f;
        if (smp) { for (int mm = pt * 64; mm < pt * 64 + 64; ++mm) o += p[mm] * F.cache_v[((size_t)b * NMEM + mm) * 256 + h * 64 + d]; }
        else { for (int mm = pt * 64; mm < pt * 64 + 64; ++mm) o += p[mm] * bf2f(F.KVB[((size_t)b * NMEM + mm) * 512 + 256 + h * 64 + d]); }
        po[pt * 64 + d] = o;
        __syncthreads();
        if (t2 < 64) F.MIX[(size_t)r * D + 768 + h * 64 + t2] = (bf16)f2bf(((po[t2] + po[64 + t2]) + (po[128 + t2] + po[192 + t2])) / sum);
        __syncthreads();
    }
}
__device__ __forceinline__ void norm2_phase(Frame& F) {
    const int gw = blockIdx.x * NWAVES + F.wave, NGW = F.G * NWAVES;
    for (int m = gw; m < MT; m += NGW) rms_row_to_bf16(F.lane, F.y + (size_t)m * D, F.ln2_g, F.XN + (size_t)m * D);
}
__device__ __forceinline__ void final_norm_phase(Frame& F) {
    const int gw = blockIdx.x * NWAVES + F.wave, NGW = F.G * NWAVES;
    for (int m = gw; m < MT; m += NGW) {
        GAS f32x4* xr = (GAS f32x4*)(F.y + (size_t)m * D) + F.lane; const GAS f32x4* gr = (const GAS f32x4*)F.lnf_g + F.lane;
        f32x4 v[4]; float s = 0.f;
#pragma unroll
        for (int j = 0; j < 4; ++j) { v[j] = xr[64 * j]; s += (v[j].x * v[j].x + v[j].y * v[j].y) + (v[j].z * v[j].z + v[j].w * v[j].w); }
        const float rstd = 1.f / sqrtf(wave_sum(s) * (1.f / D) + EPS);
#pragma unroll
        for (int j = 0; j < 4; ++j) xr[64 * j] = v[j] * rstd * gr[64 * j];
    }
}
__device__ __forceinline__ float gelu_tanh(float x) { const float u2 = 1.5957691216057308f * (x + 0.044715f * x * x * x); return x * frcp_(1.f + __expf(-u2)); }
__device__ __forceinline__ void conv_fixup_phase(Frame& F) {
    const int total = 56 * 2 * (DFF / 4);
    for (int i = blockIdx.x * 512 + F.tid; i < total; i += F.G * 512) {
        const int j = (i % (DFF / 4)) * 4, k = (i / (DFF / 4)) & 1, q = i / (DFF / 2), pm = (q / 7) * 8 + 1 + (q % 7);
        const f32x4 a0 = *(const GAS f32x4*)(F.EA + ((size_t)pm * 4 + k) * DFF + j);
        const f32x4 a1 = k == 0 ? *(const GAS f32x4*)(F.EA + ((size_t)(pm - 1) * 4 + 3) * DFF + j) : *(const GAS f32x4*)(F.EA + ((size_t)pm * 4 + 0) * DFF + j);
        const f32x4 a2 = k == 0 ? *(const GAS f32x4*)(F.EA + ((size_t)(pm - 1) * 4 + 2) * DFF + j) : *(const GAS f32x4*)(F.EA + ((size_t)(pm - 1) * 4 + 3) * DFF + j);
        const f32x4 bv = *(const GAS f32x4*)(F.EB + ((size_t)pm * 2 + k) * DFF + j);
        const f32x4 cb = *(const GAS f32x4*)(F.conv_b + j), w0 = *(const GAS f32x4*)(F.conv_w + j), w1 = *(const GAS f32x4*)(F.conv_w + DFF + j), w2 = *(const GAS f32x4*)(F.conv_w + 2 * DFF + j);
        float h[4];
#pragma unroll
        for (int e = 0; e < 4; ++e) h[e] = gelu_tanh(cb[e] + w0[e] * a2[e] + w1[e] * a1[e] + w2[e] * a0[e]) * bv[e];
        *(GAS u32x2v*)(F.PB + (size_t)(pm * 256 + k) * DFF + j) = (u32x2v){pk2(h[0], h[1]), pk2(h[2], h[3])};
    }
}
__device__ __forceinline__ void conv_phase(Frame& F) {
    const int total = MT * (DFF / 8);
    for (int i = blockIdx.x * 512 + F.tid; i < total; i += F.G * 512) {
        const int r = i / (DFF / 8), j0 = (i % (DFF / 8)) * 8; const bool smp = r >= TP; const int rr = smp ? r - TP : r; const int b = smp ? rr >> 3 : rr >> 11, t = smp ? rr & 7 : rr & 2047, L = smp ? 8 : 2048;
        const v4u a0p = *(const GAS v4u*)(F.PA + (size_t)r * DFF + j0); const v4u bp = *(const GAS v4u*)(F.PB + (size_t)r * DFF + j0);
        float a0[8], a1[8], a2[8], bb[8];
#pragma unroll
        for (int e = 0; e < 4; ++e) { a0[2 * e] = __builtin_bit_cast(float, a0p[e] << 16); a0[2 * e + 1] = __builtin_bit_cast(float, a0p[e] & 0xffff0000u); bb[2 * e] = __builtin_bit_cast(float, bp[e] << 16); bb[2 * e + 1] = __builtin_bit_cast(float, bp[e] & 0xffff0000u); }
        if (t >= 1) { const v4u p = *(const GAS v4u*)(F.PA + (size_t)(r - 1) * DFF + j0);
#pragma unroll
            for (int e = 0; e < 4; ++e) { a1[2 * e] = __builtin_bit_cast(float, p[e] << 16); a1[2 * e + 1] = __builtin_bit_cast(float, p[e] & 0xffff0000u); } }
        else {
#pragma unroll
            for (int e = 0; e < 8; ++e) a1[e] = smp ? F.state_conv[((size_t)b * 2 + 1) * DFF + j0 + e] : 0.f; }
        if (t >= 2) { const v4u p = *(const GAS v4u*)(F.PA + (size_t)(r - 2) * DFF + j0);
#pragma unroll
            for (int e = 0; e < 4; ++e) { a2[2 * e] = __builtin_bit_cast(float, p[e] << 16); a2[2 * e + 1] = __builtin_bit_cast(float, p[e] & 0xffff0000u); } }
        else {
#pragma unroll
            for (int e = 0; e < 8; ++e) a2[e] = smp ? F.state_conv[((size_t)b * 2 + t) * DFF + j0 + e] : 0.f; }
        float h[8];
#pragma unroll
        for (int e = 0; e < 8; ++e) { const int j = j0 + e; const float c = F.conv_b[j] + F.conv_w[j] * a2[e] + F.conv_w[DFF + j] * a1[e] + F.conv_w[2 * DFF + j] * a0[e]; h[e] = gelu_tanh(c) * bb[e]; }
        v4u o; o.x = pk2(h[0], h[1]); o.y = pk2(h[2], h[3]); o.z = pk2(h[4], h[5]); o.w = pk2(h[6], h[7]);
        *(GAS v4u*)(F.PB + (size_t)r * DFF + j0) = o;
        if (t == L - 1) { float* nc = (smp ? F.o_conv_s : F.o_conv_p) + (size_t)b * 2 * DFF + j0;
#pragma unroll
            for (int e = 0; e < 8; ++e) { nc[e] = a1[e]; nc[DFF + e] = a0[e]; } }
    }
}
__device__ __forceinline__ int sw512(int row, int ch) { return row * 512 + ((ch ^ (row & 15)) << 4); }
__device__ __forceinline__ int sw256(int row, int ch) { return row * 256 + ((ch ^ (row & 15)) << 4); }
__device__ __forceinline__ int sw128(int row, int ch) { return row * 128 + ((ch ^ ((row >> 1) & 7)) << 4); }
__device__ __forceinline__ bf16x8 ldfrag(const LAS unsigned char* p) { return *(const LAS bf16x8*)p; }
__device__ __forceinline__ f32x4 mma16(bf16x8 a, bf16x8 b, f32x4 c) { return __builtin_amdgcn_mfma_f32_16x16x32_bf16(a, b, c, 0, 0, 0); }
constexpr int HG_NU = 8 * 4 * 8;
constexpr float A_CLAMP = -80.f;

__device__ __forceinline__ int sw512b(int row, int ch) { return row * 512 + ((ch ^ ((row ^ (row >> 3)) & 15)) << 4); }
__device__ __forceinline__ void hgrn_passA(Frame& F, f32x4* HU, float* HD) {
    LAS unsigned char* KT = F.lds;
    LAS unsigned char* VT = F.lds + 65536;
    LAS float* segtot = (LAS float*)F.lds;
    const int tid = F.tid, c8 = tid & 15, tq = tid >> 4, w = F.wave, lane = F.lane, l15 = lane & 15, lq = lane >> 4;
    for (int u = blockIdx.x; u < HG_NU; u += F.G) {
        const int sc = u & 7, bh = u >> 3, b = bh >> 2, h = bh & 3;
        const size_t rbase = (size_t)(b * 2048 + sc * 256 + tq * 8) * 512 + h * 128 + 8 * c8;
        f32x4 lf[8][2]; v4u kq[8], vq[8];
#pragma unroll
        for (int i = 0; i < 8; ++i) { lf[i][0] = *(const GAS f32x4*)(F.LOGF + rbase + (size_t)i * 512); lf[i][1] = *(const GAS f32x4*)(F.LOGF + rbase + (size_t)i * 512 + 4);
            kq[i] = *(const GAS v4u*)(F.KK + rbase + (size_t)i * 512); }
#pragma unroll
        for (int i = 1; i < 8; ++i) { lf[i][0] += lf[i - 1][0]; lf[i][1] += lf[i - 1][1]; }
        *(LAS f32x4*)(segtot + tq * 128 + 8 * c8) = lf[7][0]; *(LAS f32x4*)(segtot + tq * 128 + 8 * c8 + 4) = lf[7][1];
        __syncthreads();
        f32x4 off[2] = {(f32x4){0.f, 0.f, 0.f, 0.f}, (f32x4){0.f, 0.f, 0.f, 0.f}}, aend[2] = {(f32x4){0.f, 0.f, 0.f, 0.f}, (f32x4){0.f, 0.f, 0.f, 0.f}};
#pragma unroll 8
        for (int s2 = 0; s2 < 32; ++s2) { const f32x4 t0 = *(const LAS f32x4*)(segtot + s2 * 128 + 8 * c8), t1 = *(const LAS f32x4*)(segtot + s2 * 128 + 8 * c8 + 4);
            aend[0] += t0; aend[1] += t1; if (s2 < tq) { off[0] += t0; off[1] += t1; } }
        __syncthreads();
        if (tq == 0) { f32x4 d0, d1;
#pragma unroll
            for (int e = 0; e < 4; ++e) { d0[e] = __expf(aend[0][e]); d1[e] = __expf(aend[1][e]); }
            *(GAS f32x4*)(HD + (size_t)u * 128 + 8 * c8) = d0; *(GAS f32x4*)(HD + (size_t)u * 128 + 8 * c8 + 4) = d1; }
#pragma unroll
        for (int jh = 0; jh < 2; ++jh) {
            unsigned ke[4][4];
#pragma unroll
            for (int i = 0; i < 8; ++i)
#pragma unroll
                for (int jj = 0; jj < 4; ++jj) { const int j = 4 * jh + jj; const float kk = __builtin_bit_cast(float, (j & 1) ? (kq[i][j >> 1] & 0xffff0000u) : (kq[i][j >> 1] << 16));
                    const float ev = kk * __expf(aend[jh][jj] - (off[jh][jj] + lf[i][jh][jj])); const unsigned bits = f2bf(ev);
                    if (i & 1) ke[jj][i >> 1] |= bits << 16; else ke[jj][i >> 1] = bits; }
#pragma unroll
            for (int jj = 0; jj < 4; ++jj) *(LAS v4u*)(KT + sw512b(8 * c8 + 4 * jh + jj, tq)) = (v4u){ke[jj][0], ke[jj][1], ke[jj][2], ke[jj][3]};
            __builtin_amdgcn_sched_barrier(0);
            if (jh == 0) {
#pragma unroll
                for (int i = 0; i < 8; ++i) vq[i] = *(const GAS v4u*)(F.V + rbase + (size_t)i * 512);
            }
        }
#pragma unroll
        for (int j = 0; j < 8; ++j) {
            unsigned vv[4];
#pragma unroll
            for (int p = 0; p < 4; ++p) { const unsigned lo = (j & 1) ? (vq[2 * p][j >> 1] >> 16) : (vq[2 * p][j >> 1] & 0xffffu), hi = (j & 1) ? (vq[2 * p + 1][j >> 1] & 0xffff0000u) : (vq[2 * p + 1][j >> 1] << 16); vv[p] = lo | hi; }
            *(LAS v4u*)(VT + sw512b(8 * c8 + j, tq)) = (v4u){vv[0], vv[1], vv[2], vv[3]}; }
        __syncthreads();
        f32x4 acc[8];
#pragma unroll
        for (int n = 0; n < 8; ++n) acc[n] = (f32x4){0.f, 0.f, 0.f, 0.f};
#pragma unroll
        for (int ks = 0; ks < 8; ++ks) {
            const bf16x8 af = ldfrag(KT + sw512b(16 * w + l15, 4 * ks + lq));
#pragma unroll
            for (int n = 0; n < 8; ++n) acc[n] = mma16(af, ldfrag(VT + sw512b(16 * n + l15, 4 * ks + lq)), acc[n]);
        }
#pragma unroll
        for (int n = 0; n < 8; ++n) HU[(((size_t)u * 8 + w) * 8 + n) * 64 + lane] = acc[n];
        __syncthreads();
    }
}

#define PC_LOAD_LF(LF, ckk) do { const size_t rb_ = (size_t)(b * 2048 + sc * 256 + (ckk) * 64 + seg * 16) * 512 + h * 128 + c; \
    _Pragma("unroll") for (int i = 0; i < 16; ++i) LF[i] = F.LOGF[rb_ + (size_t)i * 512]; } while (0)
#define PC_LOAD_QKV(QQ, KQ, VQ, ckk) do { const size_t rb_ = (size_t)(b * 2048 + sc * 256 + (ckk) * 64 + seg * 16) * 512 + h * 128 + c; \
    _Pragma("unroll") for (int i = 0; i < 16; ++i) { QQ[i] = F.Q[rb_ + (size_t)i * 512]; KQ[i] = F.KK[rb_ + (size_t)i * 512]; VQ[i] = F.V[rb_ + (size_t)i * 512]; } } while (0)
#define PC_CHUNK(ck, LF, QQ, KQ, VQ, NLF, NQQ, NKQ, NVQ) do { \
    const int trow0 = b * 2048 + sc * 256 + (ck) * 64; \
    _Pragma("unroll") for (int n = 0; n < 8; ++n) { const int dv = 16 * n + l15; *(LAS u32x2v*)(ST + sw256(dv, 2 * w + (lq >> 1)) + 8 * (lq & 1)) = (u32x2v){pk2(S[n][0], S[n][1]), pk2(S[n][2], S[n][3])}; } \
    float a[16]; { float run = 0.f; _Pragma("unroll") for (int i = 0; i < 16; ++i) { run += LF[i]; a[i] = run; } } \
    segtot[seg * 128 + c] = a[15]; \
    __syncthreads(); \
    float off = 0.f, aend = 0.f; \
    _Pragma("unroll") for (int s2 = 0; s2 < 4; ++s2) { const float v_ = segtot[s2 * 128 + c]; aend += v_; if (s2 < seg) off += v_; } \
    if (seg == 0) AE[c] = aend; \
    unsigned ke[8], vv[8]; \
    _Pragma("unroll") for (int i = 0; i < 16; ++i) { \
        const float At = fmaxf(off + a[i], A_CLAMP); const float q = bf2f(QQ[i]), k = bf2f(KQ[i]); \
        const float eA = __expf(At), eN = __expf(-At), eE = __expf(aend - (off + a[i])); const int t = seg * 16 + i; \
        *(LAS bf16*)(QA + sw256(t, c >> 3) + 2 * (c & 7)) = (bf16)f2bf(q * eA); *(LAS bf16*)(KA + sw256(t, c >> 3) + 2 * (c & 7)) = (bf16)f2bf(k * eN); \
        const unsigned kev = f2bf(k * eE), vvv = (unsigned)VQ[i]; \
        if (i & 1) { ke[i >> 1] |= kev << 16; vv[i >> 1] |= vvv << 16; } else { ke[i >> 1] = kev; vv[i >> 1] = vvv; } } \
    *(LAS v4u*)(KET + sw128(c, 2 * seg)) = (v4u){ke[0], ke[1], ke[2], ke[3]}; *(LAS v4u*)(KET + sw128(c, 2 * seg + 1)) = (v4u){ke[4], ke[5], ke[6], ke[7]}; \
    *(LAS v4u*)(VT + sw128(c, 2 * seg)) = (v4u){vv[0], vv[1], vv[2], vv[3]}; *(LAS v4u*)(VT + sw128(c, 2 * seg + 1)) = (v4u){vv[4], vv[5], vv[6], vv[7]}; \
    __syncthreads(); \
    _Pragma("unroll") for (int j = 0; j < 2; ++j) { const int sb = 2 * wh + j; f32x4 p = (f32x4){0.f, 0.f, 0.f, 0.f}; \
        if (sb <= tb) { _Pragma("unroll") for (int ks = 0; ks < 4; ++ks) p = mma16(ldfrag(QA + sw256(16 * tb + l15, 4 * ks + lq)), ldfrag(KA + sw256(16 * sb + l15, 4 * ks + lq)), p); } \
        _Pragma("unroll") for (int i = 0; i < 4; ++i) { const int t = 16 * tb + 4 * lq + i, s = 16 * sb + l15; const float pv = (s <= t) ? p[i] : 0.f; \
            *(LAS bf16*)(PS + sw128(t, s >> 3) + 2 * (s & 7)) = (bf16)f2bf(pv); } } \
    __syncthreads(); \
    bf16 gq[4][4]; \
    _Pragma("unroll") for (int i = 0; i < 4; ++i) _Pragma("unroll") for (int n = 0; n < 4; ++n) gq[i][n] = F.GS[(size_t)(trow0 + 16 * tb + 4 * lq + i) * 512 + h * 128 + 16 * (4 * wh + n) + l15]; \
    f32x4 o[4]; \
    _Pragma("unroll") for (int n = 0; n < 4; ++n) o[n] = (f32x4){0.f, 0.f, 0.f, 0.f}; \
    _Pragma("unroll") for (int ks = 0; ks < 2; ++ks) { const bf16x8 af = ldfrag(PS + sw128(16 * tb + l15, 4 * ks + lq)); \
        _Pragma("unroll") for (int n = 0; n < 4; ++n) o[n] = mma16(af, ldfrag(VT + sw128(16 * (4 * wh + n) + l15, 4 * ks + lq)), o[n]); } \
    _Pragma("unroll") for (int ks = 0; ks < 4; ++ks) { const bf16x8 af = ldfrag(QA + sw256(16 * tb + l15, 4 * ks + lq)); \
        _Pragma("unroll") for (int n = 0; n < 4; ++n) o[n] = mma16(af, ldfrag(ST + sw256(16 * (4 * wh + n) + l15, 4 * ks + lq)), o[n]); } \
    if ((ck) < 3) { const f32x4 d4 = *(const LAS f32x4*)(AE + 16 * w + 4 * lq); f32x4 dc; \
        _Pragma("unroll") for (int i = 0; i < 4; ++i) dc[i] = __expf(d4[i]); \
        _Pragma("unroll") for (int n = 0; n < 8; ++n) S[n] = S[n] * dc; \
        _Pragma("unroll") for (int ks = 0; ks < 2; ++ks) { const bf16x8 af = ldfrag(KET + sw128(16 * w + l15, 4 * ks + lq)); \
            _Pragma("unroll") for (int n = 0; n < 8; ++n) S[n] = mma16(af, ldfrag(VT + sw128(16 * n + l15, 4 * ks + lq)), S[n]); } } \
    if ((ck) < 3) { PC_LOAD_LF(NLF, (ck) + 1); PC_LOAD_QKV(NQQ, NKQ, NVQ, (ck) + 1); } \
    f32x4 ss = (f32x4){0.f, 0.f, 0.f, 0.f}; \
    _Pragma("unroll") for (int n = 0; n < 4; ++n) ss += o[n] * o[n]; \
    _Pragma("unroll") for (int i = 0; i < 4; ++i) { float v_ = ss[i]; v_ += __shfl_xor(v_, 1); v_ += __shfl_xor(v_, 2); v_ += __shfl_xor(v_, 4); v_ += __shfl_xor(v_, 8); ss[i] = v_; } \
    if (l15 == 0) { _Pragma("unroll") for (int i = 0; i < 4; ++i) RS[(16 * tb + 4 * lq + i) * 2 + wh] = ss[i]; } \
    __syncthreads(); \
    _Pragma("unroll") for (int i = 0; i < 4; ++i) { const int t = 16 * tb + 4 * lq + i; const float tot = RS[t * 2] + RS[t * 2 + 1]; const float rs = 1.f / sqrtf(tot * (1.f / 128.f) + EPS); \
        const size_t r = (size_t)(trow0 + t); \
        _Pragma("unroll") for (int n = 0; n < 4; ++n) { const int dv = 16 * (4 * wh + n) + l15; \
            F.MIX[r * D + 256 + h * 128 + dv] = (bf16)f2bf(o[n][i] * rs * og[n] * bf2f(gq[i][n])); } } \
  } while (0)
__device__ __forceinline__ void hgrn_passC(Frame& F, const f32x4* HU, const float* HD) {
    LAS unsigned char* QA = F.lds;
    LAS unsigned char* KA = F.lds + 16384;
    LAS unsigned char* KET = F.lds + 32768;
    LAS unsigned char* VT = F.lds + 49152;
    LAS unsigned char* PS = F.lds + 65536;
    LAS unsigned char* ST = F.lds + 73728;
    LAS float* AE = (LAS float*)(F.lds + 106496);
    LAS float* segtot = AE + 128;
    LAS float* RS = segtot + 512;
    const int tid = F.tid, c = tid & 127, seg = tid >> 7, w = F.wave, lane = F.lane, l15 = lane & 15, lq = lane >> 4;
    const int tb = w >> 1, wh = w & 1;
    for (int u = blockIdx.x; u < HG_NU; u += F.G) {
        const int sc = u & 7, bh = u >> 3, b = bh >> 2, h = bh & 3;
        float lfA[16], lfB[16]; bf16 qA_[16], kA_[16], vA_[16], qB_[16], kB_[16], vB_[16];
        PC_LOAD_LF(lfA, 0); PC_LOAD_QKV(qA_, kA_, vA_, 0);
        float og[4];
#pragma unroll
        for (int n = 0; n < 4; ++n) og[n] = F.onorm_g[h * 128 + 16 * (4 * wh + n) + l15];
        f32x4 S[8];
#pragma unroll
        for (int n = 0; n < 8; ++n) S[n] = (f32x4){0.f, 0.f, 0.f, 0.f};
        for (int p = 0; p < sc; ++p) { const int up = (bh << 3) + p; const f32x4 d4 = *(const f32x4*)(HD + (size_t)up * 128 + 16 * w + 4 * lq);
#pragma unroll
            for (int n = 0; n < 8; ++n) S[n] = S[n] * d4 + HU[(((size_t)up * 8 + w) * 8 + n) * 64 + lane]; }
        if (sc == 7) { const f32x4 d4 = *(const f32x4*)(HD + (size_t)u * 128 + 16 * w + 4 * lq); float* so = F.o_hgrn_p + (size_t)bh * 128 * 128;
#pragma unroll
            for (int n = 0; n < 8; ++n) { const f32x4 fin = S[n] * d4 + HU[(((size_t)u * 8 + w) * 8 + n) * 64 + lane];
#pragma unroll
                for (int i = 0; i < 4; ++i) so[(size_t)(16 * w + 4 * lq + i) * 128 + 16 * n + l15] = fin[i]; } }
        PC_CHUNK(0, lfA, qA_, kA_, vA_, lfB, qB_, kB_, vB_);
        PC_CHUNK(1, lfB, qB_, kB_, vB_, lfA, qA_, kA_, vA_);
        PC_CHUNK(2, lfA, qA_, kA_, vA_, lfB, qB_, kB_, vB_);
        PC_CHUNK(3, lfB, qB_, kB_, vB_, lfA, qA_, kA_, vA_);
        __syncthreads();
    }
}
#undef PC_LOAD_LF
#undef PC_LOAD_QKV
#undef PC_CHUNK

__device__ __forceinline__ void hgrn_sample(Frame& F) {
    LAS float* qs = (LAS float*)F.lds; LAS float* fs = qs + 1024; LAS float* ks = fs + 1024;
    LAS float* part = ks + 1024;
    LAS float* red = part + 4096;
    const int tid = F.tid, dv = tid & 127, qd = tid >> 7;
    for (int u = blockIdx.x; u < 512; u += F.G) {
        const int b = u >> 2, h = u & 3, row0 = TP + b * 8;
        float S[32];
#pragma unroll
        for (int j = 0; j < 32; ++j) S[j] = F.state_hgrn[(((size_t)b * 4 + h) * 128 + qd * 32 + j) * 128 + dv];
#pragma unroll
        for (int i = 0; i < 2; ++i) { const int idx = tid + 512 * i, t = idx >> 7, cc = idx & 127; const size_t ro = (size_t)(row0 + t) * 512 + h * 128 + cc;
            qs[idx] = bf2f(F.Q[ro]); fs[idx] = __expf(F.LOGF[ro]); ks[idx] = bf2f(F.KK[ro]); }
        float v[8];
#pragma unroll
        for (int t = 0; t < 8; ++t) v[t] = bf2f(F.V[(size_t)(row0 + t) * 512 + h * 128 + dv]);
        __syncthreads();
#pragma unroll
        for (int t = 0; t < 8; ++t) { float op = 0.f;
#pragma unroll
            for (int j4 = 0; j4 < 8; ++j4) { const f32x4 f4 = *(const LAS f32x4*)(fs + t * 128 + qd * 32 + 4 * j4), k4 = *(const LAS f32x4*)(ks + t * 128 + qd * 32 + 4 * j4), q4 = *(const LAS f32x4*)(qs + t * 128 + qd * 32 + 4 * j4);
#pragma unroll
                for (int e = 0; e < 4; ++e) { float s = f4[e] * S[4 * j4 + e] + k4[e] * v[t]; S[4 * j4 + e] = s; op += q4[e] * s; } }
            part[(qd * 8 + t) * 128 + dv] = op; }
        float* so = F.o_hgrn_s + ((size_t)b * 4 + h) * 128 * 128;
#pragma unroll
        for (int j = 0; j < 32; ++j) so[(size_t)(qd * 32 + j) * 128 + dv] = S[j];
        __syncthreads();
        float o2[2];
#pragma unroll
        for (int i = 0; i < 2; ++i) { const int idx = tid + 512 * i, t = idx >> 7, d2 = idx & 127;
            const float o = (part[(0 * 8 + t) * 128 + d2] + part[(1 * 8 + t) * 128 + d2]) + (part[(2 * 8 + t) * 128 + d2] + part[(3 * 8 + t) * 128 + d2]);
            o2[i] = o; const float ssq = wave_sum(o * o); if (F.lane == 0) red[i * 8 + F.wave] = ssq; }
        __syncthreads();
#pragma unroll
        for (int i = 0; i < 2; ++i) { const int idx = tid + 512 * i, t = idx >> 7, d2 = idx & 127; const float tot = red[i * 8 + (F.wave & ~1)] + red[i * 8 + (F.wave | 1)];
            const size_t r = (size_t)(row0 + t);
            F.MIX[r * D + 256 + h * 128 + d2] = (bf16)f2bf(o2[i] * (1.f / sqrtf(tot * (1.f / 128.f) + EPS)) * F.onorm_g[h * 128 + d2] * bf2f(F.GS[r * 512 + h * 128 + d2])); }
        __syncthreads();
    }
}
__device__ __forceinline__ bf16x8 frag_from(unsigned a, unsigned b, unsigned c, unsigned d) { return __builtin_bit_cast(bf16x8, (v4u){a, b, c, d}); }
__device__ __forceinline__ void xattn_prompt(Frame& F) {
    LAS unsigned char* KS = F.lds;
    LAS unsigned char* VT = F.lds + 32768;
    const int tid = F.tid, w = F.wave, lane = F.lane, l15 = lane & 15, lq = lane >> 4;
    for (int u = blockIdx.x; u < 256; u += F.G) {
        const int qb = u & 7, bh = u >> 3, b = bh >> 2, h = bh & 3;
        { const int kv = tid >> 1, half = tid & 1; const bf16* src = F.KVB + (size_t)(b * 256 + kv) * 512 + h * 64 + half * 32;
#pragma unroll
          for (int j = 0; j < 4; ++j) { const int cidx = 4 * half + j; *(LAS v4u*)(KS + ((((kv >> 4) * 2 + (cidx >> 2)) * 64 + 16 * (cidx & 3) + (kv & 15)) << 4)) = *(const GAS v4u*)(src + 8 * j); } }
        { const int d = tid & 63, kvg = tid >> 6; const bf16* src = F.KVB + (size_t)(b * 256 + 32 * kvg) * 512 + 256 + h * 64 + d;
          unsigned x[32];
#pragma unroll
          for (int i = 0; i < 32; ++i) x[i] = (unsigned)src[(size_t)i * 512];
#pragma unroll
          for (int q4 = 0; q4 < 4; ++q4) *(LAS v4u*)(VT + ((((d >> 4) * 8 + kvg) * 64 + 16 * q4 + (d & 15)) << 4)) =
              (v4u){x[4 * q4] | (x[4 * q4 + 1] << 16), x[4 * q4 + 2] | (x[4 * q4 + 3] << 16), x[16 + 4 * q4] | (x[16 + 4 * q4 + 1] << 16), x[16 + 4 * q4 + 2] | (x[16 + 4 * q4 + 3] << 16)}; }
        __syncthreads();
        const LAS unsigned char* kl = KS + lane * 16; const LAS unsigned char* vl = VT + lane * 16;
#pragma unroll 1
        for (int blk = 0; blk < 2; ++blk) {
            const int q0 = b * 2048 + qb * 256 + 32 * w + 16 * blk;
            bf16x8 qf[2];
#pragma unroll
            for (int ks = 0; ks < 2; ++ks) qf[ks] = *(const GAS bf16x8*)(F.QX + (size_t)(q0 + l15) * 256 + h * 64 + 32 * ks + 8 * lq);
            f32x4 s[16];
#pragma unroll
            for (int kt = 0; kt < 16; ++kt) { s[kt] = mma16(ldfrag(kl + (kt * 2 + 0) * 1024), qf[0], (f32x4){0.f, 0.f, 0.f, 0.f}); s[kt] = mma16(ldfrag(kl + (kt * 2 + 1) * 1024), qf[1], s[kt]);
                if ((kt & 3) == 3) __builtin_amdgcn_sched_barrier(0); }
            float m = s[0][0];
#pragma unroll
            for (int kt = 0; kt < 16; ++kt)
#pragma unroll
                for (int i = 0; i < 4; ++i) m = fmaxf(m, s[kt][i]);
            m = fmaxf(m, __shfl_xor(m, 16)); m = fmaxf(m, __shfl_xor(m, 32));
            float l = 0.f;
#pragma unroll
            for (int kt = 0; kt < 16; ++kt)
#pragma unroll
                for (int i = 0; i < 4; ++i) { const float p = exp2f(s[kt][i] - m); s[kt][i] = p; l += p; }
            l += __shfl_xor(l, 16); l += __shfl_xor(l, 32);
            const float inv = 1.f / l;
            f32x4 o[4];
#pragma unroll
            for (int dt = 0; dt < 4; ++dt) o[dt] = (f32x4){0.f, 0.f, 0.f, 0.f};
#pragma unroll
            for (int ks = 0; ks < 8; ++ks) {
                const f32x4 p0 = s[2 * ks] * inv, p1 = s[2 * ks + 1] * inv;
                const bf16x8 bfr = frag_from(pk2(p0[0], p0[1]), pk2(p0[2], p0[3]), pk2(p1[0], p1[1]), pk2(p1[2], p1[3]));
#pragma unroll
                for (int dt = 0; dt < 4; ++dt) o[dt] = mma16(ldfrag(vl + (dt * 8 + ks) * 1024), bfr, o[dt]);
                __builtin_amdgcn_sched_barrier(0);
            }
#pragma unroll
            for (int dt = 0; dt < 4; ++dt) *(GAS u32x2v*)(F.MIX + (size_t)(q0 + l15) * D + 768 + h * 64 + 16 * dt + 4 * lq) = (u32x2v){pk2(o[dt][0], o[dt][1]), pk2(o[dt][2], o[dt][3])};
        }
        __syncthreads();
    }
}
__device__ __forceinline__ void xattn_sample(Frame& F) {
    LAS float* MX = (LAS float*)F.lds; LAS float* LS = MX + 128; LAS float* OP = LS + 128;
    const int tid = F.tid, w = F.wave, lane = F.lane, l15 = lane & 15, lq = lane >> 4;
    for (int u = blockIdx.x; u < 512; u += F.G) {
        const int b = u >> 2, h = u & 3, row0 = TP + 8 * b;
        bf16x8 qf[2];
#pragma unroll
        for (int ks = 0; ks < 2; ++ks) qf[ks] = *(const GAS bf16x8*)(F.QX + (size_t)(row0 + (l15 & 7)) * 256 + h * 64 + 32 * ks + 8 * lq);
        f32x4 s[2];
#pragma unroll
        for (int t2 = 0; t2 < 2; ++t2) { s[t2] = (f32x4){0.f, 0.f, 0.f, 0.f};
#pragma unroll
            for (int ks = 0; ks < 2; ++ks) { const float* kp = F.cache_k + (((size_t)b * 256 + 32 * w + 16 * t2 + l15) * 4 + h) * 64 + 32 * ks + 8 * lq;
                const f32x4 x0 = *(const GAS f32x4*)kp, x1 = *(const GAS f32x4*)(kp + 4);
                s[t2] = mma16(frag_from(pk2(x0[0], x0[1]), pk2(x0[2], x0[3]), pk2(x1[0], x1[1]), pk2(x1[2], x1[3])), qf[ks], s[t2]); } }
        float vv[4][8];
#pragma unroll
        for (int dt = 0; dt < 4; ++dt)
#pragma unroll
            for (int j = 0; j < 8; ++j) vv[dt][j] = F.cache_v[(((size_t)b * 256 + 32 * w + 16 * (j >> 2) + 4 * lq + (j & 3)) * 4 + h) * 64 + 16 * dt + l15];
        float m = fmaxf(fmaxf(fmaxf(s[0][0], s[0][1]), fmaxf(s[0][2], s[0][3])), fmaxf(fmaxf(s[1][0], s[1][1]), fmaxf(s[1][2], s[1][3])));
        m = fmaxf(m, __shfl_xor(m, 16)); m = fmaxf(m, __shfl_xor(m, 32));
        if (lq == 0) MX[w * 16 + l15] = m;
        __syncthreads();
        m = MX[l15];
#pragma unroll
        for (int w2 = 1; w2 < 8; ++w2) m = fmaxf(m, MX[w2 * 16 + l15]);
        float l = 0.f;
#pragma unroll
        for (int t2 = 0; t2 < 2; ++t2)
#pragma unroll
            for (int i = 0; i < 4; ++i) { const float p = exp2f(s[t2][i] - m); s[t2][i] = p; l += p; }
        l += __shfl_xor(l, 16); l += __shfl_xor(l, 32);
        if (lq == 0) LS[w * 16 + l15] = l;
        const bf16x8 bfr = frag_from(pk2(s[0][0], s[0][1]), pk2(s[0][2], s[0][3]), pk2(s[1][0], s[1][1]), pk2(s[1][2], s[1][3]));
#pragma unroll
        for (int dt = 0; dt < 4; ++dt) {
            const f32x4 o = mma16(frag_from(pk2(vv[dt][0], vv[dt][1]), pk2(vv[dt][2], vv[dt][3]), pk2(vv[dt][4], vv[dt][5]), pk2(vv[dt][6], vv[dt][7])), bfr, (f32x4){0.f, 0.f, 0.f, 0.f});
#pragma unroll
            for (int i = 0; i < 4; ++i) OP[(w * 64 + 16 * dt + 4 * lq + i) * 16 + l15] = o[i];
        }
        __syncthreads();
        { const int q = tid >> 6, d = tid & 63; float o = 0.f, ll = 0.f;
#pragma unroll
          for (int w2 = 0; w2 < 8; ++w2) { o += OP[(w2 * 64 + d) * 16 + q]; ll += LS[w2 * 16 + q]; }
          F.MIX[(size_t)(row0 + q) * D + 768 + h * 64 + d] = (bf16)f2bf(o / ll); }
        __syncthreads();
    }
}
template <class Epi> __device__ __forceinline__ void small_piece(const bf16* A, const bf16* Bt, int K, int w, int lane, const Epi& epi) {
    const int rb = w >> 1, cb = w & 1, l15 = lane & 15, lq = lane >> 4;
    const bf16* ap = A + (size_t)(16 * rb + l15) * K + 8 * lq;
    const bf16* bp0 = Bt + (size_t)(32 * cb + l15) * K + 8 * lq; const bf16* bp1 = bp0 + (size_t)16 * K;
    f32x4 acc0 = (f32x4){0.f, 0.f, 0.f, 0.f}, acc1 = (f32x4){0.f, 0.f, 0.f, 0.f};
    const int ng = K / 256;
    bf16x8 xa[8], wa0[8], wa1[8], xb[8], wb0[8], wb1[8];
#define SP_LOAD(X, W0, W1, gi) do { const int o_ = 256 * (gi); _Pragma("unroll") for (int j = 0; j < 8; ++j) { X[j] = *(const GAS bf16x8*)(ap + o_ + 32 * j); W0[j] = *(const GAS bf16x8*)(bp0 + o_ + 32 * j); W1[j] = *(const GAS bf16x8*)(bp1 + o_ + 32 * j); } } while (0)
#define SP_MMA(X, W0, W1) do { _Pragma("unroll") for (int j = 0; j < 8; ++j) { acc0 = mma16(W0[j], X[j], acc0); acc1 = mma16(W1[j], X[j], acc1); } } while (0)
    SP_LOAD(xa, wa0, wa1, 0);
    int g = 0;
#pragma unroll 1
    for (; g + 1 < ng; g += 2) {
        SP_LOAD(xb, wb0, wb1, g + 1);
        SP_MMA(xa, wa0, wa1);
        SP_LOAD(xa, wa0, wa1, (g + 2 < ng ? g + 2 : ng - 1));
        SP_MMA(xb, wb0, wb1);
    }
    if (g < ng) SP_MMA(xa, wa0, wa1);
#undef SP_LOAD
#undef SP_MMA
    epi(acc0, acc1, 16 * rb + l15, 32 * cb + 4 * lq, cb, lq);
}
__device__ __forceinline__ void out_sample_piece(Frame& F) {
    const int p = blockIdx.x; if (p >= 256) return; const int pr = p >> 4, pc = p & 15;
    auto epi = [&](const f32x4& a0, const f32x4& a1, int r, int c, int cb, int lq) {
        const int rs = 64 * pr + r, col = 64 * pc + c; const float* xr = F.x_sample + (size_t)rs * D + col; bf16* xo = F.XN + (size_t)(TP + rs) * D + col;
        const f32x4 v0 = a0 + *(const GAS f32x4*)xr, v1 = a1 + *(const GAS f32x4*)(xr + 16);
        *(GAS u32x2v*)xo = (u32x2v){pk2(v0[0], v0[1]), pk2(v0[2], v0[3])}; *(GAS u32x2v*)(xo + 16) = (u32x2v){pk2(v1[0], v1[1]), pk2(v1[2], v1[3])};
        float ss = ((v0[0] * v0[0] + v0[1] * v0[1]) + (v0[2] * v0[2] + v0[3] * v0[3])) + ((v1[0] * v1[0] + v1[1] * v1[1]) + (v1[2] * v1[2] + v1[3] * v1[3]));
        ss += __shfl_xor(ss, 16); ss += __shfl_xor(ss, 32);
        if (lq == 0) F.ROWSS_S[(size_t)rs * 32 + pc * 2 + cb] = ss; };
    small_piece(F.MIX + (size_t)(TP + 64 * pr) * D, F.WOUT + (size_t)(64 * pc) * D, D, F.wave, F.lane, epi);
}
__device__ __forceinline__ void down_sample_piece(Frame& F) {
    const int p = blockIdx.x; if (p >= 256) return; const int pr = p >> 4, pc = p & 15;
    auto epi = [&](const f32x4& a0, const f32x4& a1, int r, int c, int cb, int lq) {
        float* yo = F.y + (size_t)(TP + 64 * pr + r) * D + 64 * pc + c; const bf16* xi = F.XN + (size_t)(TP + 64 * pr + r) * D + 64 * pc + c;
        const u32x2v b0 = *(const GAS u32x2v*)xi, b1 = *(const GAS u32x2v*)(xi + 16);
        const f32x4 r0 = (f32x4){__builtin_bit_cast(float, b0.x << 16), __builtin_bit_cast(float, b0.x & 0xffff0000u), __builtin_bit_cast(float, b0.y << 16), __builtin_bit_cast(float, b0.y & 0xffff0000u)};
        const f32x4 r1 = (f32x4){__builtin_bit_cast(float, b1.x << 16), __builtin_bit_cast(float, b1.x & 0xffff0000u), __builtin_bit_cast(float, b1.y << 16), __builtin_bit_cast(float, b1.y & 0xffff0000u)};
        const f32x4 v0 = a0 + r0, v1 = a1 + r1;
        *(GAS f32x4*)yo = v0; *(GAS f32x4*)(yo + 16) = v1; };
    small_piece(F.PB + (size_t)(TP + 64 * pr) * DFF, F.WDN + (size_t)(64 * pc) * DFF, DFF, F.wave, F.lane, epi);
}
__global__ void __launch_bounds__(NWAVES * 64, 2) mk_fwd(Args args) {
    extern __shared__ __attribute__((aligned(16))) unsigned char lds[];
    Frame F;
    F.lds = (LAS unsigned char*)lds;
    F.tid = threadIdx.x; F.lane = F.tid & 63; F.wave = __builtin_amdgcn_readfirstlane(F.tid >> 6); F.G = gridDim.x;
    volatile LAS unsigned* MISC = (volatile LAS unsigned*)(F.lds + MISC_OFF);
    unsigned char* ws = args.ws;
    gu32* ctl = (gu32*)(ws + WS_CTL);
    F.x_prompt = args.in[0]; F.x_sample = args.in[1]; F.mem_prompt = args.in[2]; F.state_pool = args.in[3]; F.state_hgrn = args.in[4]; F.state_conv = args.in[5];
    F.cache_k = args.in[6]; F.cache_v = args.in[7]; F.ln1_g = args.in[8]; F.w_in = args.in[9]; F.pool_w = args.in[10]; F.pool_scale = args.in[11]; F.lb_logits = args.in[12];
    F.onorm_g = args.in[13]; F.mem_norm_g = args.in[14]; F.w_mem_kv = args.in[15]; F.w_out = args.in[16]; F.ln2_g = args.in[17]; F.w_up = args.in[18]; F.conv_w = args.in[19];
    F.conv_b = args.in[20]; F.w_down = args.in[21]; F.lnf_g = args.in[22];
    float* out = args.out;
    F.y = out; F.o_pool_p = out + (size_t)MT * D; F.o_hgrn_p = F.o_pool_p + 8 * 15 * 256; F.o_conv_p = F.o_hgrn_p + 8 * 4 * 128 * 128; F.o_mk = F.o_conv_p + 8 * 2 * DFF;
    F.o_mv = F.o_mk + MEMR * 256; F.o_pool_s = F.o_mv + MEMR * 256; F.o_hgrn_s = F.o_pool_s + 128 * 15 * 256; F.o_conv_s = F.o_hgrn_s + (size_t)128 * 4 * 128 * 128;
    F.WIN = (bf16*)(ws + WS_WIN); F.WKV = (bf16*)(ws + WS_WKV); F.WOUT = (bf16*)(ws + WS_WOUT); F.WUP = (bf16*)(ws + WS_WUP); F.WDN = (bf16*)(ws + WS_WDN);
    F.XN = (bf16*)(ws + WS_XN); F.XNM = (bf16*)(ws + WS_XNM); F.KVB = (bf16*)(ws + WS_KVB); F.MIX = (bf16*)(ws + WS_MIX);
    F.U = (float*)(ws + WS_U); F.Q = (bf16*)(ws + WS_Q); F.LOGF = (float*)(ws + WS_LOGF); F.KK = (bf16*)(ws + WS_KK); F.V = (bf16*)(ws + WS_V); F.GS = (bf16*)(ws + WS_G); F.QX = (bf16*)(ws + WS_QX);
    F.PA = (bf16*)(ws + WS_PA); F.PB = (bf16*)(ws + WS_PB); F.EA = (float*)(ws + WS_EA); F.EB = (float*)(ws + WS_EB); F.ROWSS = (float*)(ws + WS_ROWSS); F.ROWSS_S = (float*)(ws + WS_ROWSS_S);
    for (int u = F.tid; u < (LDS_BYTES - LDSCTL_OFF) / 4; u += NWAVES * 64) ((LAS unsigned*)(F.lds + LDSCTL_OFF))[u] = 0u;
    __syncthreads();
    const int lo = args.ph_lo, hi = args.ph_hi;
    XcdBarrier bar; bar.bar = (unsigned*)(ctl + CW_BAR); bar.x = 0; bar.st = nullptr;
    if (hi - lo > 1) bar = xcd_barrier_post((unsigned*)(ctl + CW_BAR), MISC + 8);
#define IN(k) (lo <= (k) && (k) < hi)
#if defined(PROBE_A)
    volatile LAS unsigned long long* TSW = (volatile LAS unsigned long long*)(F.lds + LDSCTL_OFF + 512);
    if (blockIdx.x == 0 && F.tid == 0) TSW[0] = __builtin_amdgcn_s_memrealtime();
#define SEAM(k) do { if (IN(k) && IN((k) + 1)) xcd_barrier(bar); if (blockIdx.x == 0 && F.tid == 0) TSW[(k) + 1] = __builtin_amdgcn_s_memrealtime(); } while (0)
#else
#define SEAM(k) do { if (IN(k) && IN((k) + 1)) xcd_barrier(bar); } while (0)
#endif

    if (IN(0)) { p0_prologue(F); p0_late(F, (int)blockIdx.x * NWAVES + F.wave, F.G * NWAVES); } SEAM(0);
    if (IN(1)) {
        { pg8::Gemm g{F.XN, F.WIN, MT, DIN, D}; pg8::StaticOrder S; S.init(MT, DIN, F.G, (int)blockIdx.x);
          pg8::EpiIn E{F.U, F.Q, F.LOGF, F.KK, F.V, F.GS, F.QX, F.lb_logits};
          pg8::gemm_phase<pg8::EpiIn, pg8::StaticOrder, true, true>(F.lds, g, S, E); }
        { pg8::Gemm g{F.XNM, F.WKV, MEMR, 512, D}; pg8::StaticOrder S; S.init(MEMR, 512, F.G, (int)((blockIdx.x + F.G - 168 % F.G) % F.G));
          pg8::EpiKV E{F.o_mk, F.o_mv, F.KVB};
          pg8::gemm_phase<pg8::EpiKV, pg8::StaticOrder, true, true>(F.lds, g, S, E); }
    } SEAM(1);
#if defined(PROBE_A)
#define SUBSTAMP(k) do { if (blockIdx.x == 0 && F.tid == 0) TSW[k] = __builtin_amdgcn_s_memrealtime(); } while (0)
#else
#define SUBSTAMP(k) do { } while (0)
#endif
    if (IN(2)) { pool_phase(F); SUBSTAMP(26); hgrn_passA(F, (f32x4*)(ws + WS_HU), (float*)(ws + WS_HD)); SUBSTAMP(27); hgrn_sample(F); SUBSTAMP(28); xattn_prompt(F); SUBSTAMP(29); xattn_sample(F); SUBSTAMP(30); } SEAM(2);
    if (IN(3)) { hgrn_passC(F, (const f32x4*)(ws + WS_HU), (const float*)(ws + WS_HD)); } SEAM(3);
    if (IN(4)) {
        pg8::Gemm g{F.MIX, F.WOUT, TP, D, D}; pg8::StaticOrder S; S.init(TP, D, F.G, (int)blockIdx.x);
        pg8::EpiOut2 E{F.x_prompt, F.x_sample, TP, F.y, F.XN, F.ROWSS};
        pg8::gemm_phase<pg8::EpiOut2, pg8::StaticOrder, true, true>(F.lds, g, S, E);
#if defined(PROBE_A)
        if (blockIdx.x == 0 && F.tid == 0) TSW[20] = __builtin_amdgcn_s_memrealtime();
        if (F.tid == 0) atomicMax((unsigned long long*)(ws + WS_CTL + 32768 + 128), (unsigned long long)__builtin_amdgcn_s_memrealtime());
#endif
        out_sample_piece(F);
#if defined(PROBE_A)
        if (F.tid == 0) atomicMax((unsigned long long*)(ws + WS_CTL + 32768 + 192), (unsigned long long)__builtin_amdgcn_s_memrealtime());
#endif
    } SEAM(4);
    if (IN(5)) {
        pg8::Gemm g{F.XN, F.WUP, MT, 2 * DFF, D}; pg8::StaticOrder S; S.init(MT, 2 * DFF, F.G, (int)blockIdx.x);
        pg8::EpiUpConv E{F.ROWSS, F.ROWSS_S, F.conv_w, F.conv_b, F.state_conv, F.PB, F.EA, F.EB, F.o_conv_p, F.o_conv_s, (LAS float*)(F.lds + RING_BYTES + 4096)};
        pg8::gemm_phase<pg8::EpiUpConv, pg8::StaticOrder, true, true>(F.lds, g, S, E);
    } SEAM(5);
    if (IN(6)) { conv_fixup_phase(F); } SEAM(6);
    if (IN(7)) {
        pg8::Gemm g{F.PB, F.WDN, TP, D, DFF}; pg8::StaticOrder S; S.init(TP, D, F.G, (int)blockIdx.x);
        pg8::EpiResB E{F.XN, F.y};
        pg8::gemm_phase<pg8::EpiResB, pg8::StaticOrder, true, true>(F.lds, g, S, E);
#if defined(PROBE_A)
        if (blockIdx.x == 0 && F.tid == 0) TSW[21] = __builtin_amdgcn_s_memrealtime();
        if (F.tid == 0) atomicMax((unsigned long long*)(ws + WS_CTL + 32768), (unsigned long long)__builtin_amdgcn_s_memrealtime());
#endif
        down_sample_piece(F);
#if defined(PROBE_A)
        if (F.tid == 0) atomicMax((unsigned long long*)(ws + WS_CTL + 32768 + 64), (unsigned long long)__builtin_amdgcn_s_memrealtime());
#endif
    } SEAM(7);
    if (IN(8)) { final_norm_phase(F); }
#if defined(PROBE_A)
    __syncthreads();
    if (blockIdx.x == 0 && F.tid == 0) { TSW[NPHASE] = __builtin_amdgcn_s_memrealtime();
        TSW[22] = __hip_atomic_load((unsigned long long*)(ws + WS_CTL + 32768), __ATOMIC_RELAXED, __HIP_MEMORY_SCOPE_AGENT); TSW[23] = __hip_atomic_load((unsigned long long*)(ws + WS_CTL + 32768 + 64), __ATOMIC_RELAXED, __HIP_MEMORY_SCOPE_AGENT); TSW[24] = __hip_atomic_load((unsigned long long*)(ws + WS_CTL + 32768 + 128), __ATOMIC_RELAXED, __HIP_MEMORY_SCOPE_AGENT); TSW[25] = __hip_atomic_load((unsigned long long*)(ws + WS_CTL + 32768 + 192), __ATOMIC_RELAXED, __HIP_MEMORY_SCOPE_AGENT);
        const unsigned long long wait = (TSW[PROBE_B] - TSW[PROBE_A]) * 512ull, t0 = __builtin_amdgcn_s_memrealtime();
        while (__builtin_amdgcn_s_memrealtime() - t0 < wait) __builtin_amdgcn_s_sleep(32); }
#endif
#undef IN
#undef SEAM
}

extern "C" void kernel_launch(void* const* d_in, const int* in_sizes, int n_in, void* d_out, int out_size, void* d_ws, size_t ws_size, hipStream_t stream) {
    static int grid = 0;
    if (grid == 0) {
        if (n_in != 23 || ws_size < WS_END) { fprintf(stderr, "kernel_launch: unexpected n_in %d / ws_size %zu\n", n_in, ws_size); grid = -1; return; }
        int dev = 0, cus = 0, per_cu = 0;
        if (hipGetDevice(&dev) != hipSuccess || hipDeviceGetAttribute(&cus, hipDeviceAttributeMultiprocessorCount, dev) != hipSuccess) { grid = -1; return; }
        if (hipFuncSetAttribute((const void*)mk_fwd, hipFuncAttributeMaxDynamicSharedMemorySize, LDS_BYTES) != hipSuccess) { fprintf(stderr, "kernel_launch: hipFuncSetAttribute failed\n"); grid = -1; return; }
        if (hipOccupancyMaxActiveBlocksPerMultiprocessor(&per_cu, (const void*)mk_fwd, NWAVES * 64, LDS_BYTES) != hipSuccess || per_cu < 1) { fprintf(stderr, "kernel_launch: occupancy query says %d blocks/CU\n", per_cu); }
        (void)hipGetLastError();
        grid = cus;
    }
    if (grid < 0) return;
    (void)hipMemsetAsync((char*)d_ws + WS_CTL, 0, CTL_ZERO_BYTES, stream);
    Args a{};
    for (int i = 0; i < 23; ++i) a.in[i] = (const float*)d_in[i];
    a.out = (float*)d_out; a.ws = (unsigned char*)d_ws;
#if MK_PER_PHASE
    for (int p = 0; p < NPHASE; ++p) { a.ph_lo = p; a.ph_hi = p + 1; hipLaunchKernelGGL(mk_fwd, dim3(grid), dim3(NWAVES * 64), LDS_BYTES, stream, a); }
#else
    a.ph_lo = 0; a.ph_hi = NPHASE;
    hipLaunchKernelGGL(mk_fwd, dim3(grid), dim3(NWAVES * 64), LDS_BYTES, stream, a);
#endif
}
```

```cpp
#include <hip/hip_runtime.h>
#include <cstdio>
#include <cstdint>
namespace pg8 {
#define PG8_LAS __attribute__((address_space(3)))
typedef unsigned short bf16_t;
typedef short bf16x8 __attribute__((ext_vector_type(8)));
typedef float f32x4 __attribute__((ext_vector_type(4)));
typedef unsigned u32x4 __attribute__((ext_vector_type(4)));
constexpr int BM = 256, BK = 64, HALF = 128, HTB = HALF * BK * 2  , STAGE_BYTES = 8 * HTB, NXCD = 8, WGM = 8;

__host__ __device__ __forceinline__ int lds_byte(int r, int c) { const int st = (r >> 4) * 2 + (c >> 5), rr = r & 15, cc = c & 31, ob = rr * 64 + cc * 2; return st * 1024 + (ob ^ (((ob >> 9) & 1) << 5)); }
__host__ __device__ __forceinline__ void stage_rc(int b, int& R, int& C) { const int st = b / 1024, sb = b % 1024, swz = sb ^ (((sb >> 9) & 1) << 5); R = (st >> 1) * 16 + swz / 64; C = (st & 1) * 32 + (swz % 64) / 2; }
__host__ __device__ __forceinline__ int perm32(int rho) { const int n = rho >> 4, i = rho & 15; return 8 * (i >> 2) + 4 * n + (i & 3); }

struct Unit { int pm, pn; };
struct Gemm { const bf16_t* A; const bf16_t* Bt; int M, N, K; };

struct StaticOrder {
    int nM, nN, nwg, G, c;
    __host__ __device__ void init(int M, int N, int G_, int c_) { nM = M / BM; nN = N / BM; nwg = nM * nN; G = G_; c = c_; }
    __host__ __device__ bool next(int i, Unit& u) const {
        const long L = (long)i * G + c; if (L >= nwg) return false;
        int wgid = (int)L; { const int q = nwg / NXCD, r = nwg % NXCD, xcd = wgid % NXCD, off = wgid / NXCD; wgid = (xcd < r ? xcd * (q + 1) : r * (q + 1) + (xcd - r) * q) + off; }
        const int nig = WGM * nN, gid = wgid / nig, fm = gid * WGM, gsz = (nM - fm) < WGM ? (nM - fm) : WGM;
        u.pm = fm + ((wgid % nig) % gsz); u.pn = (wgid % nig) / gsz; return true;
    }
    __device__ __forceinline__ void a_ready(const Unit&) const {}
    __device__ __forceinline__ void done(const Unit&) const {}
};
__device__ __forceinline__ unsigned cvt_pk_bf16(float lo, float hi) { unsigned r; asm volatile("v_cvt_pk_bf16_f32 %0, %1, %2" : "=v"(r) : "v"(lo), "v"(hi)); return r; }
typedef float f32x2 __attribute__((ext_vector_type(2)));
typedef unsigned u32x2 __attribute__((ext_vector_type(2)));
__device__ __forceinline__ float frcp(float x) { return __builtin_amdgcn_rcpf(x); }
__device__ __forceinline__ float fsilu(float x) { return x * frcp(1.f + __expf(-x)); }
__device__ __forceinline__ u32x4 pack8(const f32x4& v0, const f32x4& v1) { u32x4 w; w.x = cvt_pk_bf16(v0[0], v0[1]); w.y = cvt_pk_bf16(v0[2], v0[3]); w.z = cvt_pk_bf16(v1[0], v1[1]); w.w = cvt_pk_bf16(v1[2], v1[3]); return w; }
constexpr float QX_SCALE = 0.125f * 1.4426950408889634f;
struct EpiIn {
    static constexpr bool PERM = true, AFTER_DRAIN = false;
    float* U; bf16_t* Q; float* LOGF; bf16_t* KK; bf16_t* V; bf16_t* G; bf16_t* QX; const float* lbl;
    __device__ __forceinline__ void operator()(const f32x4 (&acc)[2][2][4][2], const Unit& u, int wr, int wc, int fr, int fq) const {
        const int row0 = u.pm * BM + wr * 64 + fr, pn = u.pn, cl = wc * 32 + 8 * fq;
        if (pn == 0) {
#pragma unroll
            for (int ai = 0; ai < 2; ++ai)
#pragma unroll
                for (int m = 0; m < 4; ++m) { float* rowp = U + (size_t)(row0 + ai * HALF + m * 16) * 256 + cl;
#pragma unroll
                    for (int bj = 0; bj < 2; ++bj) { *(f32x4*)(rowp + bj * HALF) = acc[ai][bj][m][0]; *(f32x4*)(rowp + bj * HALF + 4) = acc[ai][bj][m][1]; } }
        } else if (pn == 3 || pn == 4) {
            const int c0 = (pn - 3) * 256 + cl;
            f32x4 oml[2][2];
#pragma unroll
            for (int bj = 0; bj < 2; ++bj)
#pragma unroll
                for (int n = 0; n < 2; ++n) { const f32x4 l0 = *(const f32x4*)(lbl + c0 + bj * HALF + 4 * n), l1 = *(const f32x4*)(lbl + 512 + c0 + bj * HALF + 4 * n);
#pragma unroll
                    for (int e = 0; e < 4; ++e) oml[bj][n][e] = frcp(1.f + __expf(l0[e] - l1[e])); }
#pragma unroll
            for (int ai = 0; ai < 2; ++ai)
#pragma unroll
                for (int m = 0; m < 4; ++m) { const size_t ro = (size_t)(row0 + ai * HALF + m * 16) * 512 + c0;
#pragma unroll
                    for (int bj = 0; bj < 2; ++bj) { f32x4 kk[2], lf[2];
#pragma unroll
                        for (int n = 0; n < 2; ++n)
#pragma unroll
                            for (int e = 0; e < 4; ++e) { const float x = acc[ai][bj][m][n][e]; const float k = oml[bj][n][e] * frcp(1.f + __expf(x)); kk[n][e] = k; lf[n][e] = __logf(1.f - k); }
                        *(f32x4*)(LOGF + ro + bj * HALF) = lf[0]; *(f32x4*)(LOGF + ro + bj * HALF + 4) = lf[1];
                        *(u32x4*)(KK + ro + bj * HALF) = pack8(kk[0], kk[1]); } }
        } else {
            bf16_t* base; int ldc, cb, mode;
            if (pn <= 2) { base = Q; ldc = 512; cb = (pn - 1) * 256; mode = 1; }
            else if (pn <= 6) { base = V; ldc = 512; cb = (pn - 5) * 256; mode = 0; }
            else if (pn <= 8) { base = G; ldc = 512; cb = (pn - 7) * 256; mode = 1; }
            else { base = QX; ldc = 256; cb = 0; mode = 2; }
#pragma unroll
            for (int ai = 0; ai < 2; ++ai)
#pragma unroll
                for (int m = 0; m < 4; ++m) { bf16_t* rowp = base + (size_t)(row0 + ai * HALF + m * 16) * ldc + cb + cl;
#pragma unroll
                    for (int bj = 0; bj < 2; ++bj) { f32x4 v0 = acc[ai][bj][m][0], v1 = acc[ai][bj][m][1];
                        if (mode == 1) {
#pragma unroll
                            for (int e = 0; e < 4; ++e) { v0[e] = fsilu(v0[e]); v1[e] = fsilu(v1[e]); } }
                        else if (mode == 2) { v0 = v0 * QX_SCALE; v1 = v1 * QX_SCALE; }
                        *(u32x4*)(rowp + bj * HALF) = pack8(v0, v1); } }
        }
    }
};
struct EpiKV {
    static constexpr bool PERM = true, AFTER_DRAIN = false;
    float* MK; float* MV; bf16_t* KVB;
    __device__ __forceinline__ void operator()(const f32x4 (&acc)[2][2][4][2], const Unit& u, int wr, int wc, int fr, int fq) const {
        const int row0 = u.pm * BM + wr * 64 + fr, cl = wc * 32 + 8 * fq; float* of = u.pn ? MV : MK;
#pragma unroll
        for (int ai = 0; ai < 2; ++ai)
#pragma unroll
            for (int m = 0; m < 4; ++m) { const size_t r = (size_t)(row0 + ai * HALF + m * 16);
#pragma unroll
                for (int bj = 0; bj < 2; ++bj) { *(f32x4*)(of + r * 256 + cl + bj * HALF) = acc[ai][bj][m][0]; *(f32x4*)(of + r * 256 + cl + bj * HALF + 4) = acc[ai][bj][m][1];
                    *(u32x4*)(KVB + r * 512 + u.pn * 256 + cl + bj * HALF) = pack8(acc[ai][bj][m][0], acc[ai][bj][m][1]); } }
    }
};
struct EpiRes {
    static constexpr bool PERM = true, AFTER_DRAIN = false;
    const float* r0; const float* r1; int split; float* out;
    __device__ __forceinline__ void operator()(const f32x4 (&acc)[2][2][4][2], const Unit& u, int wr, int wc, int fr, int fq) const {
        const int row0 = u.pm * BM + wr * 64 + fr, cl = u.pn * BM + wc * 32 + 8 * fq;
#pragma unroll
        for (int ai = 0; ai < 2; ++ai)
#pragma unroll
            for (int m = 0; m < 4; ++m) { const int r = row0 + ai * HALF + m * 16; const float* rp = (r < split ? r0 + (size_t)r * 1024 : r1 + (size_t)(r - split) * 1024) + cl; float* op = out + (size_t)r * 1024 + cl;
#pragma unroll
                for (int bj = 0; bj < 2; ++bj)
#pragma unroll
                    for (int n = 0; n < 2; ++n) { const f32x4 x = *(const f32x4*)(rp + bj * HALF + 4 * n); *(f32x4*)(op + bj * HALF + 4 * n) = acc[ai][bj][m][n] + x; } }
    }
};
struct EpiPlanes {
    static constexpr bool PERM = true, AFTER_DRAIN = false;
    bf16_t* P0; bf16_t* P1; int tiles_per_plane, ldc;
    __device__ __forceinline__ void operator()(const f32x4 (&acc)[2][2][4][2], const Unit& u, int wr, int wc, int fr, int fq) const {
        const int row0 = u.pm * BM + wr * 64 + fr; const bool second = u.pn >= tiles_per_plane; bf16_t* base = second ? P1 : P0; const int cl = (second ? u.pn - tiles_per_plane : u.pn) * BM + wc * 32 + 8 * fq;
#pragma unroll
        for (int ai = 0; ai < 2; ++ai)
#pragma unroll
            for (int m = 0; m < 4; ++m) { bf16_t* rowp = base + (size_t)(row0 + ai * HALF + m * 16) * ldc + cl;
#pragma unroll
                for (int bj = 0; bj < 2; ++bj) *(u32x4*)(rowp + bj * HALF) = pack8(acc[ai][bj][m][0], acc[ai][bj][m][1]); }
    }
};
struct EpiOut2 {
    static constexpr bool PERM = true, AFTER_DRAIN = false;
    const float* r0; const float* r1; int split; float* out; bf16_t* XB; float* ROWSS;
    __device__ __forceinline__ void operator()(const f32x4 (&acc)[2][2][4][2], const Unit& u, int wr, int wc, int fr, int fq) const {
        const int row0 = u.pm * BM + wr * 64 + fr, cl = u.pn * BM + wc * 32 + 8 * fq;
#pragma unroll
        for (int ai = 0; ai < 2; ++ai)
#pragma unroll
            for (int m = 0; m < 4; ++m) { const int r = row0 + ai * HALF + m * 16; const float* rp = (r < split ? r0 + (size_t)r * 1024 : r1 + (size_t)(r - split) * 1024) + cl;
                float ss = 0.f;
#pragma unroll
                for (int bj = 0; bj < 2; ++bj) { f32x4 v[2];
#pragma unroll
                    for (int n = 0; n < 2; ++n) { v[n] = acc[ai][bj][m][n] + *(const f32x4*)(rp + bj * HALF + 4 * n);
                        ss += (v[n][0] * v[n][0] + v[n][1] * v[n][1]) + (v[n][2] * v[n][2] + v[n][3] * v[n][3]); }
                    *(u32x4*)(XB + (size_t)r * 1024 + cl + bj * HALF) = pack8(v[0], v[1]); }
                ss += __shfl_xor(ss, 16); ss += __shfl_xor(ss, 32);
                if (fq == 0) ROWSS[(size_t)r * 16 + u.pn * 4 + wc] = ss; }
    }
};
struct EpiUpConv {
    static constexpr bool PERM = true, AFTER_DRAIN = false;
    const float* ROWSS; const float* ROWSS_S; const float* conv_w; const float* conv_b; const float* state_conv; bf16_t* HID; float* EA; float* EB; float* o_conv_p; float* o_conv_s; PG8_LAS float* xch;
    static constexpr int FF = 2816;
    __device__ __forceinline__ static float gelu_t(float x) { const float u2 = 1.5957691216057308f * (x + 0.044715f * x * x * x); return x * frcp(1.f + __expf(-u2)); }
    __device__ __forceinline__ void operator()(const f32x4 (&acc)[2][2][4][2], const Unit& u, int wr, int wc, int fr, int fq) const {
        const int lane = fq * 16 + fr, row0 = u.pm * BM + wr * 64 + fr, j0 = u.pn * 128 + wc * 32 + 8 * fq;
        const bool smp = u.pm >= 64;
        float rstd[2][4];
#pragma unroll
        for (int ai = 0; ai < 2; ++ai)
#pragma unroll
            for (int m = 0; m < 4; ++m) { const int r = row0 + ai * HALF + m * 16; float s;
                if (!smp) { const f32x4 p = *(const f32x4*)(ROWSS + (size_t)r * 16 + 4 * fq); s = (p[0] + p[1]) + (p[2] + p[3]); }
                else { const f32x4 p = *(const f32x4*)(ROWSS_S + (size_t)(r - 16384) * 32 + 8 * fq), q = *(const f32x4*)(ROWSS_S + (size_t)(r - 16384) * 32 + 8 * fq + 4); s = ((p[0] + p[1]) + (p[2] + p[3])) + ((q[0] + q[1]) + (q[2] + q[3])); }
                s += __shfl_xor(s, 16); s += __shfl_xor(s, 32); rstd[ai][m] = 1.0f / sqrtf(s * (1.f / 1024.f) + 1e-6f); }
        if (!smp) {
            if (fr >= 14) {
#pragma unroll
                for (int ai = 0; ai < 2; ++ai)
#pragma unroll
                    for (int n = 0; n < 2; ++n) *(PG8_LAS f32x4*)(xch + ((((ai * 2 + wr) * 4 + wc) * 4 + fq) * 2 + (fr - 14)) * 8 + 4 * n) = acc[ai][0][3][n] * rstd[ai][3]; }
            asm volatile("s_waitcnt lgkmcnt(0)" ::: "memory"); __builtin_amdgcn_s_barrier(); asm volatile("" ::: "memory");
        }
        const int src1 = (lane & 48) | ((fr + 15) & 15), src2 = (lane & 48) | ((fr + 14) & 15);
#pragma unroll
        for (int n = 0; n < 2; ++n) {
            const f32x4 cb = *(const f32x4*)(conv_b + j0 + 4 * n), w0 = *(const f32x4*)(conv_w + j0 + 4 * n), w1 = *(const f32x4*)(conv_w + FF + j0 + 4 * n), w2 = *(const f32x4*)(conv_w + 2 * FF + j0 + 4 * n);
#pragma unroll
            for (int ai = 0; ai < 2; ++ai) {
                f32x4 pa = (f32x4){0.f, 0.f, 0.f, 0.f};
                if (!smp && fr >= 14 && (wr == 1 || ai == 1)) { const int sai = wr == 1 ? ai : 0, swr = wr == 1 ? 0 : 1;
                    pa = *(const PG8_LAS f32x4*)(xch + ((((sai * 2 + swr) * 4 + wc) * 4 + fq) * 2 + (fr - 14)) * 8 + 4 * n); }
#pragma unroll
                for (int m = 0; m < 4; ++m) {
                    const int r = row0 + ai * HALF + m * 16; const float rs = rstd[ai][m];
                    const f32x4 a = acc[ai][0][m][n] * rs, b = acc[ai][1][m][n] * rs; f32x4 p1, p2;
                    if (!smp) {
#pragma unroll
                        for (int e2 = 0; e2 < 4; ++e2) { const float s1 = fr == 15 ? pa[e2] : a[e2], s2 = fr >= 14 ? pa[e2] : a[e2]; p1[e2] = __shfl(s1, src1); p2[e2] = __shfl(s2, src2); }
                        if (ai == 0 && wr == 0 && m == 0 && fr < 2) { *(f32x4*)(EA + ((size_t)u.pm * 4 + fr) * FF + j0 + 4 * n) = a; *(f32x4*)(EB + ((size_t)u.pm * 2 + fr) * FF + j0 + 4 * n) = b; }
                        if (ai == 1 && wr == 1 && m == 3 && fr >= 14) { *(f32x4*)(EA + ((size_t)u.pm * 4 + 2 + (fr - 14)) * FF + j0 + 4 * n) = a;
                            if ((u.pm & 7) == 7) *(f32x4*)(o_conv_p + ((size_t)(u.pm >> 3) * 2 + (fr - 14)) * FF + j0 + 4 * n) = a; }
                    } else {
                        const int t = fr & 7, bb = (r - 16384) >> 3;
#pragma unroll
                        for (int e2 = 0; e2 < 4; ++e2) { p1[e2] = __shfl(a[e2], src1); p2[e2] = __shfl(a[e2], src2); }
                        if (t < 2) { const f32x4 h1 = *(const f32x4*)(state_conv + ((size_t)bb * 2 + 1) * FF + j0 + 4 * n);
                            if (t == 0) { p1 = h1; p2 = *(const f32x4*)(state_conv + ((size_t)bb * 2) * FF + j0 + 4 * n); } else p2 = h1; }
                        if (t >= 6) *(f32x4*)(o_conv_s + ((size_t)bb * 2 + (t - 6)) * FF + j0 + 4 * n) = a;
                    }
                    f32x4 hv;
#pragma unroll
                    for (int e2 = 0; e2 < 4; ++e2) { const float c = cb[e2] + w0[e2] * p2[e2] + w1[e2] * p1[e2] + w2[e2] * a[e2]; hv[e2] = gelu_t(c) * b[e2]; }
                    *(u32x2*)(HID + (size_t)r * FF + j0 + 4 * n) = (u32x2){cvt_pk_bf16(hv[0], hv[1]), cvt_pk_bf16(hv[2], hv[3])};
                    pa = a;
                }
            }
        }
    }
};
struct EpiResB {
    static constexpr bool PERM = true, AFTER_DRAIN = false;
    const bf16_t* XB; float* out;
    __device__ __forceinline__ void operator()(const f32x4 (&acc)[2][2][4][2], const Unit& u, int wr, int wc, int fr, int fq) const {
        const int row0 = u.pm * BM + wr * 64 + fr, cl = u.pn * BM + wc * 32 + 8 * fq;
#pragma unroll
        for (int ai = 0; ai < 2; ++ai)
#pragma unroll
            for (int m = 0; m < 4; ++m) { const int r = row0 + ai * HALF + m * 16; float* op = out + (size_t)r * 1024 + cl;
#pragma unroll
                for (int bj = 0; bj < 2; ++bj) { const u32x4 xb = *(const u32x4*)(XB + (size_t)r * 1024 + cl + bj * HALF);
                    f32x4 x0, x1;
                    x0[0] = __builtin_bit_cast(float, xb[0] << 16); x0[1] = __builtin_bit_cast(float, xb[0] & 0xffff0000u); x0[2] = __builtin_bit_cast(float, xb[1] << 16); x0[3] = __builtin_bit_cast(float, xb[1] & 0xffff0000u);
                    x1[0] = __builtin_bit_cast(float, xb[2] << 16); x1[1] = __builtin_bit_cast(float, xb[2] & 0xffff0000u); x1[2] = __builtin_bit_cast(float, xb[3] << 16); x1[3] = __builtin_bit_cast(float, xb[3] & 0xffff0000u);
                    *(f32x4*)(op + bj * HALF) = acc[ai][bj][m][0] + x0; *(f32x4*)(op + bj * HALF + 4) = acc[ai][bj][m][1] + x1; } }
    }
};
template <class Epi, class Sched, bool ALIGN_EPI = false, bool SP2 = false>
__device__ __forceinline__ void gemm_phase(PG8_LAS unsigned char* lds, const Gemm g, const Sched& S, const Epi& E) {
    const int tid = threadIdx.x, wid = __builtin_amdgcn_readfirstlane(tid >> 6), lane = tid & 63, wr = wid >> 2, wc = wid & 3, fr = lane & 15, fq = lane >> 4;
    const int K = g.K, nt = K / BK;
    unsigned voffA[2], voffB[2];
#pragma unroll
    for (int i = 0; i < 2; ++i) { int R, C; stage_rc(tid * 16 + i * 8192, R, C); const int Rb = Epi::PERM ? ((R & ~31) + perm32(R & 31)) : R;
        voffA[i] = (unsigned)(R * K + C) * 2u; voffB[i] = (unsigned)(Rb * K + C) * 2u; }
    const size_t kstep = (size_t)(BK * 2);
    const size_t hstep = (size_t)HALF * K * 2;
    const size_t tstep = 2 * hstep;
    const unsigned ldsw = (unsigned)wid * 1024u;
    const int aoff = lds_byte(wr * 64 + fr, fq * 8), boff = lds_byte(wc * 32 + fr, fq * 8);
#define PG8_SA(b, h) (((b) * 2 + (h)) * HTB)
#define PG8_SB(b, h) ((4 + (b) * 2 + (h)) * HTB)
#define PG8_STAGE(bufoff, gbase, voff) do { _Pragma("unroll") for (int _i = 0; _i < 2; ++_i) \
        __builtin_amdgcn_global_load_lds((const unsigned*)((const char*)(gbase) + (voff)[_i]), (PG8_LAS unsigned*)(lds + (bufoff) + ldsw + _i * 8192), 16, 0, 0); } while (0)
#define PG8_LDA(dst, b, h) do { _Pragma("unroll") for (int m = 0; m < 4; ++m) _Pragma("unroll") for (int k = 0; k < 2; ++k) dst[m][k] = *(const PG8_LAS bf16x8*)(lds + PG8_SA(b, h) + aoff + m * 2048 + k * 1024); } while (0)
#define PG8_LDB(dst, b, h) do { _Pragma("unroll") for (int n = 0; n < 2; ++n) _Pragma("unroll") for (int k = 0; k < 2; ++k) dst[n][k] = *(const PG8_LAS bf16x8*)(lds + PG8_SB(b, h) + boff + n * 2048 + k * 1024); } while (0)
#define PG8_MMA(ai, bj, At, Bt) do { __builtin_amdgcn_s_setprio(1); _Pragma("unroll") for (int m = 0; m < 4; ++m) _Pragma("unroll") for (int n = 0; n < 2; ++n) _Pragma("unroll") for (int k = 0; k < 2; ++k) \
        acc[ai][bj][m][n] = __builtin_amdgcn_mfma_f32_16x16x32_bf16(Bt[n][k], At[m][k], acc[ai][bj][m][n], 0, 0, 0); __builtin_amdgcn_s_setprio(0); } while (0)
#define PG8_WAIT_V(n) asm volatile("s_waitcnt vmcnt(" #n ")" ::: "memory")
#define PG8_WAIT_L(n) asm volatile("s_waitcnt lgkmcnt(" #n ")" ::: "memory")
#define PG8_BAR __builtin_amdgcn_s_barrier()
#define PG8_SCHED __builtin_amdgcn_sched_barrier(0)
    Unit cur, nxt; int ui = 0;
    if (!S.next(0, cur)) return;
    f32x4 acc[2][2][4][2];
#pragma unroll
    for (int a = 0; a < 2; ++a)
#pragma unroll
        for (int b = 0; b < 2; ++b)
#pragma unroll
            for (int m = 0; m < 4; ++m)
#pragma unroll
                for (int n = 0; n < 2; ++n) acc[a][b][m][n] = (f32x4){0.f, 0.f, 0.f, 0.f};
    bf16x8 At[4][2], B0[2][2], B1[2][2];
    const char* cA = (const char*)g.A + (size_t)cur.pm * tstep; const char* cB = (const char*)g.Bt + (size_t)cur.pn * tstep;
    S.a_ready(cur);
    if constexpr (SP2) {
        PG8_STAGE(PG8_SB(0, 0), cB, voffB); PG8_STAGE(PG8_SB(0, 1), cB + hstep, voffB); PG8_STAGE(PG8_SA(0, 0), cA, voffA); PG8_STAGE(PG8_SA(0, 1), cA + hstep, voffA);
        if (wr == 1) PG8_BAR;
        PG8_WAIT_V(2); PG8_BAR;
        PG8_STAGE(PG8_SB(1, 0), cB + kstep, voffB); PG8_STAGE(PG8_SA(1, 0), cA + kstep, voffA); PG8_STAGE(PG8_SB(1, 1), cB + hstep + kstep, voffB);
        PG8_WAIT_V(6); PG8_BAR;
    } else {
        PG8_STAGE(PG8_SB(0, 0), cB, voffB); PG8_STAGE(PG8_SA(0, 0), cA, voffA); PG8_STAGE(PG8_SB(0, 1), cB + hstep, voffB); PG8_STAGE(PG8_SA(0, 1), cA + hstep, voffA);
        if (wr == 1) PG8_BAR;
        PG8_WAIT_V(4); PG8_BAR;
        PG8_STAGE(PG8_SB(1, 0), cB + kstep, voffB); PG8_STAGE(PG8_SA(1, 0), cA + kstep, voffA); PG8_STAGE(PG8_SB(1, 1), cB + hstep + kstep, voffB);
        PG8_WAIT_V(6); PG8_BAR;
    }
    for (;;) {
        const bool has_next = S.next(ui + 1, nxt);
        const char* nA = has_next ? (const char*)g.A + (size_t)nxt.pm * tstep : cA; const char* nB = has_next ? (const char*)g.Bt + (size_t)nxt.pn * tstep : cB;
        for (int t = 0; t < nt; t += 2) {
            const bool last = (t == nt - 2);
            const char* a1 = cA + (size_t)(t + 1) * kstep;
            const char* a2 = last ? nA : cA + (size_t)(t + 2) * kstep; const char* b2 = last ? nB : cB + (size_t)(t + 2) * kstep;
            const char* a3 = a2 + kstep; const char* b3 = b2 + kstep;
            if (last && has_next) S.a_ready(nxt);
            if constexpr (SP2) {
            PG8_LDB(B0, 0, 0); PG8_LDB(B1, 0, 1); PG8_SCHED; PG8_LDA(At, 0, 0); PG8_STAGE(PG8_SA(1, 1), a1 + hstep, voffA);
            PG8_WAIT_V(8); PG8_WAIT_L(0); PG8_BAR; PG8_MMA(0, 0, At, B0); PG8_MMA(0, 1, At, B1); PG8_BAR; PG8_SCHED;
            PG8_LDA(At, 0, 1); PG8_STAGE(PG8_SB(0, 0), b2, voffB); PG8_STAGE(PG8_SB(0, 1), b2 + hstep, voffB); PG8_STAGE(PG8_SA(0, 0), a2, voffA);
            PG8_WAIT_V(8); PG8_WAIT_L(0); PG8_BAR; PG8_MMA(1, 0, At, B0); PG8_MMA(1, 1, At, B1); PG8_BAR; PG8_SCHED;
            PG8_LDB(B0, 1, 0); PG8_LDB(B1, 1, 1); PG8_SCHED; PG8_LDA(At, 1, 0); PG8_STAGE(PG8_SA(0, 1), a2 + hstep, voffA);
            PG8_WAIT_V(8); PG8_WAIT_L(0); PG8_BAR; PG8_MMA(0, 0, At, B0); PG8_MMA(0, 1, At, B1); PG8_BAR; PG8_SCHED;
            PG8_LDA(At, 1, 1); PG8_STAGE(PG8_SB(1, 0), b3, voffB); PG8_STAGE(PG8_SB(1, 1), b3 + hstep, voffB); PG8_STAGE(PG8_SA(1, 0), a3, voffA);
            PG8_WAIT_V(8); PG8_WAIT_L(0); PG8_BAR; PG8_MMA(1, 0, At, B0); PG8_MMA(1, 1, At, B1); PG8_BAR; PG8_SCHED;
            } else {
            PG8_LDB(B0, 0, 0); PG8_SCHED; PG8_LDA(At, 0, 0); PG8_STAGE(PG8_SA(1, 1), a1 + hstep, voffA);
            PG8_WAIT_L(8); PG8_BAR; PG8_WAIT_L(0); PG8_MMA(0, 0, At, B0); PG8_BAR; PG8_SCHED;
            PG8_LDB(B1, 0, 1); PG8_STAGE(PG8_SB(0, 0), b2, voffB);
            PG8_BAR; PG8_WAIT_L(0); PG8_MMA(0, 1, At, B1); PG8_BAR;
            PG8_LDA(At, 0, 1); PG8_STAGE(PG8_SA(0, 0), a2, voffA);
            PG8_BAR; PG8_WAIT_L(0); PG8_MMA(1, 0, At, B0); PG8_BAR; PG8_SCHED;
            PG8_STAGE(PG8_SB(0, 1), b2 + hstep, voffB);
            PG8_WAIT_V(6); PG8_BAR; PG8_MMA(1, 1, At, B1); PG8_BAR;
            PG8_LDB(B0, 1, 0); PG8_SCHED; PG8_LDA(At, 1, 0); PG8_STAGE(PG8_SA(0, 1), a2 + hstep, voffA);
            PG8_WAIT_L(8); PG8_BAR; PG8_WAIT_L(0); PG8_MMA(0, 0, At, B0); PG8_BAR; PG8_SCHED;
            PG8_LDB(B1, 1, 1); PG8_STAGE(PG8_SB(1, 0), b3, voffB);
            PG8_BAR; PG8_WAIT_L(0); PG8_MMA(0, 1, At, B1); PG8_BAR;
            PG8_LDA(At, 1, 1); PG8_STAGE(PG8_SA(1, 0), a3, voffA);
            PG8_BAR; PG8_WAIT_L(0); PG8_MMA(1, 0, At, B0); PG8_BAR; PG8_SCHED;
            PG8_STAGE(PG8_SB(1, 1), b3 + hstep, voffB);
            PG8_WAIT_V(6); PG8_BAR; PG8_MMA(1, 1, At, B1); PG8_BAR;
            }
        }
        if constexpr (ALIGN_EPI) { if (wr == 0) PG8_BAR; }
        if constexpr (!Epi::AFTER_DRAIN) { E(acc, cur, wr, wc, fr, fq); S.done(cur); }
        if (!has_next) break;
#pragma unroll
        for (int a = 0; a < 2; ++a)
#pragma unroll
            for (int b = 0; b < 2; ++b)
#pragma unroll
                for (int m = 0; m < 4; ++m)
#pragma unroll
                    for (int n = 0; n < 2; ++n) acc[a][b][m][n] = (f32x4){0.f, 0.f, 0.f, 0.f};
        cur = nxt; cA = nA; cB = nB; ++ui;
        if constexpr (ALIGN_EPI) { if (wr == 1) PG8_BAR; }
    }
    PG8_WAIT_V(0);
    if constexpr (!ALIGN_EPI) { if (wr == 0) PG8_BAR; }
    PG8_BAR;
    if constexpr (Epi::AFTER_DRAIN) { E.fused(acc, cur, wr, wc, fr, fq, lds, wid, lane); S.done(cur); }
#undef PG8_SA
#undef PG8_SB
#undef PG8_STAGE
#undef PG8_LDA
#undef PG8_LDB
#undef PG8_MMA
#undef PG8_WAIT_V
#undef PG8_WAIT_L
#undef PG8_BAR
#undef PG8_SCHED
}
}
#define GAS __attribute__((address_space(1)))
#define LAS __attribute__((address_space(3)))
typedef unsigned short bf16;
typedef unsigned v4u __attribute__((ext_vector_type(4)));
typedef float f32x4 __attribute__((ext_vector_type(4)));
typedef short bf16x8 __attribute__((ext_vector_type(8)));
typedef GAS unsigned gu32;
typedef GAS unsigned long long gu64;
#define RLX_AGENT __ATOMIC_RELAXED, __HIP_MEMORY_SCOPE_AGENT
#define LDS_WAIT() asm volatile("s_waitcnt lgkmcnt(0)" ::: "memory")
#define VM_WAIT() asm volatile("s_waitcnt vmcnt(0)" ::: "memory")
__device__ __forceinline__ unsigned long long rt() { return __builtin_amdgcn_s_memrealtime(); }
__device__ __forceinline__ unsigned f2bf(float f) { unsigned u = __builtin_bit_cast(unsigned, f); return (u + 0x7fffu + ((u >> 16) & 1u)) >> 16; }
__device__ __forceinline__ unsigned pk2(float lo, float hi) { return f2bf(lo) | (f2bf(hi) << 16); }

#define XB_TMO      128
#define XB_XCNT(j)  (256  + 64 * (j))
#define XB_XSUB(j)  (1280 + 64 * (j))
#define XB_XGEN(j)  (2304 + 64 * (j))
#define XB_TOP      3328
#define XB_TOPGEN   3392
#define XCD_BAR_WORDS 3456
#define XB_SPIN_CAP (1u << 18)

__device__ __forceinline__ unsigned xb_ld(unsigned* p)              { return __hip_atomic_load(p, __ATOMIC_RELAXED, __HIP_MEMORY_SCOPE_AGENT); }
__device__ __forceinline__ unsigned xb_add(unsigned* p, unsigned v) { return __hip_atomic_fetch_add(p, v, __ATOMIC_RELAXED, __HIP_MEMORY_SCOPE_AGENT); }
__device__ __forceinline__ unsigned xb_xcc_id() { return (unsigned)__builtin_amdgcn_s_getreg((3 << 11) | 20) & 0xFu; }
#define XB_SPIN(cond, bar) do { unsigned _sp = 0; while (cond) { __builtin_amdgcn_s_sleep(1); \
    if ((++_sp & 255u) == 0u) { if (xb_ld(&(bar)[XB_TMO])) break; if (_sp > XB_SPIN_CAP) { atomicAdd(&(bar)[XB_TMO], 1u); break; } } } } while (0)

struct XcdBarrier {
    unsigned* bar; unsigned x;
    volatile LAS unsigned* st;
};

__device__ __forceinline__ XcdBarrier xcd_barrier_post(unsigned* bar, volatile LAS unsigned* st) {
    XcdBarrier b; b.bar = bar; b.x = xb_xcc_id(); b.st = st;
    if (threadIdx.x == 0) (void)xb_add(&bar[XB_XCNT(b.x)], 1u);
    return b;
}
__device__ __forceinline__ void xcd_barrier_complete(unsigned* bar, unsigned x, unsigned& nloc, unsigned& nx) {
    const unsigned G = gridDim.x * gridDim.y * gridDim.z;
    unsigned sum, cnt, mine, sp = 0u;
    for (;;) {
        sum = 0u; cnt = 0u; mine = 0u;
#pragma unroll
        for (unsigned j = 0; j < 16; ++j) { const unsigned c = xb_ld(&bar[XB_XCNT(j)]); sum += c; cnt += (c > 0u) ? 1u : 0u; mine = (j == x) ? c : mine; }
        if (sum == G) break;
        __builtin_amdgcn_s_sleep(1);
        if ((++sp & 255u) == 0u) { if (xb_ld(&bar[XB_TMO])) break; if (sp > XB_SPIN_CAP) { atomicAdd(&bar[XB_TMO], 1u); break; } }
    }
    nloc = mine > 0u ? mine : 1u; nx = cnt > 0u ? cnt : 1u;
}

__device__ __forceinline__ void xcd_barrier(const XcdBarrier& b) {
    asm volatile("s_waitcnt vmcnt(0)" ::: "memory");
    __syncthreads();
    if (threadIdx.x == 0) {
        unsigned* bar = b.bar;
        __builtin_amdgcn_s_waitcnt(0);
        unsigned nloc = b.st[0], nx = b.st[1];
        if (nloc == 0u) { xcd_barrier_complete(bar, b.x, nloc, nx); b.st[0] = nloc; b.st[1] = nx; }
        const unsigned old = xb_add(&bar[XB_XSUB(b.x)], 1u);
        const unsigned gen = old / nloc;
        if (old + 1u == (gen + 1u) * nloc) {
            __builtin_amdgcn_fence(__ATOMIC_RELEASE, "agent");
            asm volatile("s_waitcnt vmcnt(0)" ::: "memory");
            const unsigned og = xb_add(&bar[XB_TOP], 1u);
            const unsigned tg = og / nx;
            if (og + 1u == (tg + 1u) * nx) xb_add(&bar[XB_TOPGEN], 1u);
            else XB_SPIN(xb_ld(&bar[XB_TOPGEN]) == tg, bar);
            __builtin_amdgcn_fence(__ATOMIC_ACQUIRE, "agent");
            xb_add(&bar[XB_XGEN(b.x)], 1u);
            asm volatile("s_waitcnt vmcnt(0)" ::: "memory");
        } else {
            XB_SPIN(xb_ld(&bar[XB_XGEN(b.x)]) == gen, bar);
            __builtin_amdgcn_fence(__ATOMIC_ACQUIRE, "agent");
            asm volatile("s_waitcnt vmcnt(0)" ::: "memory");
        }
    }
    __syncthreads();
}
__device__ __forceinline__ float wave_sum(float v) {
#pragma unroll
    for (int o = 1; o < 64; o <<= 1) v += __shfl_xor(v, o);
    return v;
}
__device__ __forceinline__ void p0_transpose_item(const float* W, int K, int N, bf16* WT, int row_off, LAS float* scr, int item, int lane) {
    const int nblk = N / 32, kb = item / nblk, nb = item % nblk, k0 = 64 * kb, n0 = 32 * nb;
    { const int kk = lane >> 3, n4 = (lane & 7) * 4; f32x4 v[8];
#pragma unroll
      for (int i = 0; i < 8; ++i) v[i] = *(const GAS f32x4*)(W + (size_t)(k0 + kk + 8 * i) * N + n0 + n4);
#pragma unroll
      for (int i = 0; i < 8; ++i) { LAS float* d = scr + (kk + 8 * i) * 33 + n4; d[0] = v[i][0]; d[1] = v[i][1]; d[2] = v[i][2]; d[3] = v[i][3]; } }
    LDS_WAIT(); asm volatile("" ::: "memory");
    const int c = lane & 7;
#pragma unroll
    for (int j = 0; j < 4; ++j) { const int n = (lane >> 3) + 8 * j; const LAS float* s = scr + (8 * c) * 33 + n;
        v4u o; o.x = pk2(s[0 * 33], s[1 * 33]); o.y = pk2(s[2 * 33], s[3 * 33]); o.z = pk2(s[4 * 33], s[5 * 33]); o.w = pk2(s[6 * 33], s[7 * 33]);
        *(GAS v4u*)(WT + (size_t)(row_off + n0 + n) * K + k0 + 8 * c) = o; }
    LDS_WAIT(); asm volatile("" ::: "memory");
}
constexpr int NWAVES = 8;
constexpr int D = 1024, TP = 16384, TS = 1024, MT = TP + TS, MEMR = 2048, DIN = 2560, DFF = 2816, NMEM = 256;
constexpr float EPS = 1e-6f;
#ifndef MK_PER_PHASE
#define MK_PER_PHASE 0
#endif
constexpr int NPHASE = 9;
constexpr size_t MiB = 1u << 20;
constexpr size_t WS_CTL = 0, CTL_ZERO_BYTES = 64 * 1024;
constexpr size_t WS_WIN = 1 * MiB, WS_WKV = 6 * MiB, WS_WOUT = 7 * MiB, WS_WUP = 9 * MiB, WS_WDN = 20 * MiB;
constexpr size_t WS_XN = 26 * MiB;
constexpr size_t WS_XNM = 60 * MiB;
constexpr size_t WS_KVB = 64 * MiB;
constexpr size_t WS_HU = 66 * MiB, WS_HD = 82 * MiB;
constexpr size_t WS_MIX = 83 * MiB;
constexpr size_t WS_U = 117 * MiB, WS_Q = 134 * MiB, WS_LOGF = 151 * MiB, WS_KK = 185 * MiB, WS_V = 202 * MiB, WS_G = 219 * MiB, WS_QX = 236 * MiB;
constexpr size_t WS_EA = 64 * MiB, WS_EB = 68 * MiB, WS_ROWSS = 70 * MiB, WS_ROWSS_S = 72 * MiB;
constexpr size_t WS_PA = 64 * MiB, WS_PB = 158 * MiB;
constexpr size_t WS_END = 256 * MiB;
static_assert(WS_QX + (size_t)MT * 256 * 2 <= WS_END && WS_PB + (size_t)MT * DFF * 2 <= WS_END && WS_PA + (size_t)MT * DFF * 2 <= WS_PB, "d_ws map");
constexpr int CW_BAR = 4096;
constexpr int RING_BYTES = 131072, LDSCTL_OFF = RING_BYTES, MISC_OFF = LDSCTL_OFF + 320, LDS_BYTES = 147456;

struct Args { const float* in[23]; float* out; unsigned char* ws; int ph_lo, ph_hi; };
struct Frame {
    LAS unsigned char* lds; int tid, lane, wave, G;
    const float *x_prompt, *x_sample, *mem_prompt, *state_pool, *state_hgrn, *state_conv, *cache_k, *cache_v, *ln1_g, *w_in, *pool_w, *pool_scale, *lb_logits, *onorm_g, *mem_norm_g, *w_mem_kv, *w_out, *ln2_g, *w_up, *conv_w, *conv_b, *w_down, *lnf_g;
    float *y, *o_pool_p, *o_hgrn_p, *o_conv_p, *o_mk, *o_mv, *o_pool_s, *o_hgrn_s, *o_conv_s;
    bf16 *WIN, *WKV, *WOUT, *WUP, *WDN, *XN, *XNM, *KVB, *MIX, *Q, *KK, *V, *GS, *QX, *PA, *PB;
    float *U, *LOGF, *EA, *EB, *ROWSS, *ROWSS_S;
};
typedef unsigned u32x2v __attribute__((ext_vector_type(2)));
__device__ __forceinline__ float bf2f(bf16 h) { return __builtin_bit_cast(float, (unsigned)h << 16); }
__device__ __forceinline__ float frcp_(float x) { return __builtin_amdgcn_rcpf(x); }
__device__ __forceinline__ float wave_max(float v) {
#pragma unroll
    for (int o = 1; o < 64; o <<= 1) v = fmaxf(v, __shfl_xor(v, o));
    return v;
}
__device__ __forceinline__ void rms_row_to_bf16(int lane, const float* xrow, const float* g, bf16* orow) {
    const GAS f32x4* xr = (const GAS f32x4*)xrow + lane; const GAS f32x4* gr = (const GAS f32x4*)g + lane;
    f32x4 v[4]; float s = 0.f;
#pragma unroll
    for (int j = 0; j < 4; ++j) { v[j] = xr[64 * j]; s += (v[j].x * v[j].x + v[j].y * v[j].y) + (v[j].z * v[j].z + v[j].w * v[j].w); }
    const float rstd = 1.f / sqrtf(wave_sum(s) * (1.f / D) + EPS);
    GAS unsigned long long* o8 = (GAS unsigned long long*)orow + lane;
#pragma unroll
    for (int j = 0; j < 4; ++j) { const f32x4 gg = gr[64 * j]; o8[64 * j] = (unsigned long long)pk2(v[j].x * rstd * gg.x, v[j].y * rstd * gg.y) | ((unsigned long long)pk2(v[j].z * rstd * gg.z, v[j].w * rstd * gg.w) << 32); }
}
__device__ __forceinline__ void p0_transpose_item2(const float* W, int K, int N, bf16* WT, int dst_row0, const float* gain, LAS float* scr, int kb, int nb, int lane) {
    const int k0 = 64 * kb, n0 = 32 * nb;
    { const int kk = lane >> 3, n4 = (lane & 7) * 4; f32x4 v[8];
#pragma unroll
      for (int i = 0; i < 8; ++i) v[i] = *(const GAS f32x4*)(W + (size_t)(k0 + kk + 8 * i) * N + n0 + n4);
#pragma unroll
      for (int i = 0; i < 8; ++i) { LAS float* d = scr + (kk + 8 * i) * 33 + n4; d[0] = v[i][0]; d[1] = v[i][1]; d[2] = v[i][2]; d[3] = v[i][3]; } }
    LDS_WAIT(); asm volatile("" ::: "memory");
    const int c = lane & 7; float gg[8];
#pragma unroll
    for (int e = 0; e < 8; ++e) gg[e] = gain[k0 + 8 * c + e];
#pragma unroll
    for (int j = 0; j < 4; ++j) { const int n = (lane >> 3) + 8 * j; const LAS float* s = scr + (8 * c) * 33 + n;
        v4u o; o.x = pk2(s[0 * 33] * gg[0], s[1 * 33] * gg[1]); o.y = pk2(s[2 * 33] * gg[2], s[3 * 33] * gg[3]); o.z = pk2(s[4 * 33] * gg[4], s[5 * 33] * gg[5]); o.w = pk2(s[6 * 33] * gg[6], s[7 * 33] * gg[7]);
        *(GAS v4u*)(WT + (size_t)(dst_row0 + n) * K + k0 + 8 * c) = o; }
    LDS_WAIT(); asm volatile("" ::: "memory");
}
__device__ __forceinline__ void p0_prologue(Frame& F) {
    LAS float* scr = (LAS float*)(F.lds + F.wave * 16384);
    const int gw = blockIdx.x * NWAVES + F.wave, NGW = F.G * NWAVES;
    constexpr int I_IN = (D / 64) * (DIN / 32), I_KV = (D / 64) * (512 / 32), I_UP = (D / 64) * (2 * DFF / 32);
    for (int it = gw; it < I_IN + I_KV + I_UP; it += NGW) {
        if (it < I_IN) p0_transpose_item(F.w_in, D, DIN, F.WIN, 0, scr, it, F.lane);
        else if (it < I_IN + I_KV) p0_transpose_item(F.w_mem_kv, D, 512, F.WKV, 0, scr, it - I_IN, F.lane);
        else { const int r = it - I_IN - I_KV, nblk = 2 * DFF / 32, kb = r / nblk, nb = r % nblk, n0 = 32 * nb, j = n0 < DFF ? n0 : n0 - DFF;
            p0_transpose_item2(F.w_up, D, 2 * DFF, F.WUP, (j >> 7) * 256 + (j & 127) + (n0 < DFF ? 0 : 128), F.ln2_g, scr, kb, nb, F.lane); }
    }
    auto row_src = [&](int m) -> const float* { return m < TP ? F.x_prompt + (size_t)m * D : m < MT ? F.x_sample + (size_t)(m - TP) * D : F.mem_prompt + (size_t)(m - MT) * D; };
    auto row_dst = [&](int m) -> bf16* { return m < MT ? F.XN + (size_t)m * D : F.XNM + (size_t)(m - MT) * D; };
    for (int m = gw; m < MT + MEMR; m += 2 * NGW) {
        const int m2 = m + NGW; const bool two = m2 < MT + MEMR;
        const GAS f32x4* xa = (const GAS f32x4*)row_src(m) + F.lane; const GAS f32x4* xb = (const GAS f32x4*)row_src(two ? m2 : m) + F.lane;
        f32x4 va[4], vb[4]; float sa = 0.f, sb = 0.f;
#pragma unroll
        for (int j = 0; j < 4; ++j) { va[j] = xa[64 * j]; vb[j] = xb[64 * j]; }
#pragma unroll
        for (int j = 0; j < 4; ++j) { sa += (va[j].x * va[j].x + va[j].y * va[j].y) + (va[j].z * va[j].z + va[j].w * va[j].w); sb += (vb[j].x * vb[j].x + vb[j].y * vb[j].y) + (vb[j].z * vb[j].z + vb[j].w * vb[j].w); }
        const float ra = 1.f / sqrtf(wave_sum(sa) * (1.f / D) + EPS), rb = 1.f / sqrtf(wave_sum(sb) * (1.f / D) + EPS);
        const GAS f32x4* ga = (const GAS f32x4*)(m < MT ? F.ln1_g : F.mem_norm_g) + F.lane; const GAS f32x4* gb = (const GAS f32x4*)((two ? m2 : m) < MT ? F.ln1_g : F.mem_norm_g) + F.lane;
        GAS unsigned long long* oa = (GAS unsigned long long*)row_dst(m) + F.lane; GAS unsigned long long* ob = (GAS unsigned long long*)row_dst(two ? m2 : m) + F.lane;
#pragma unroll
        for (int j = 0; j < 4; ++j) { const f32x4 g1 = ga[64 * j]; oa[64 * j] = (unsigned long long)pk2(va[j].x * ra * g1.x, va[j].y * ra * g1.y) | ((unsigned long long)pk2(va[j].z * ra * g1.z, va[j].w * ra * g1.w) << 32); }
        if (two) {
#pragma unroll
            for (int j = 0; j < 4; ++j) { const f32x4 g2 = gb[64 * j]; ob[64 * j] = (unsigned long long)pk2(vb[j].x * rb * g2.x, vb[j].y * rb * g2.y) | ((unsigned long long)pk2(vb[j].z * rb * g2.z, vb[j].w * rb * g2.w) << 32); } }
    }
}
__device__ __forceinline__ void p0_late(Frame& F, int gw, int NGW) {
    LAS float* scr = (LAS float*)(F.lds + F.wave * 16384);
    constexpr int I_OUT = (D / 64) * (D / 32), I_DN = (DFF / 64) * (D / 32);
    for (int it = gw; it < I_OUT + I_DN; it += NGW) {
        int r = it;
        if (r < I_OUT) { if (r >= 4 * (D / 32)) p0_transpose_item(F.w_out, D, D, F.WOUT, 0, scr, r, F.lane); continue; } r -= I_OUT;
        p0_transpose_item(F.w_down, DFF, D, F.WDN, 0, scr, r, F.lane);
    }
    for (int it = gw; it < 2048; it += NGW) { const int g = it >> 9, c2 = (it >> 4) & 31, n = (it & 15) * 64 + F.lane;
        const float* p0 = F.pool_w + (size_t)g * 4096 + (2 * c2) * 64; const float* p1 = p0 + 64; float o0 = 0.f, o1 = 0.f;
#pragma unroll
        for (int dd = 0; dd < 64; ++dd) { const float sw = F.pool_scale[64 * g + dd] * F.w_out[(size_t)(64 * g + dd) * D + n]; o0 += p0[dd] * sw; o1 += p1[dd] * sw; }
        *(GAS unsigned*)(F.WOUT + (size_t)n * D + 64 * g + 2 * c2) = pk2(o0, o1); }
}
__device__ __forceinline__ void pool_phase(Frame& F) {
    const int total = (MT / 8) * 64;
    for (int i = blockIdx.x * 512 + F.tid; i < total; i += F.G * 512) {
        const int r0 = (i >> 6) * 8, c = (i & 63) * 4, g = c >> 6; const bool smp = r0 >= TP; const int rr = smp ? r0 - TP : r0; const int b = smp ? rr >> 3 : rr >> 11, t0 = smp ? 0 : rr & 2047;
        const float* ub = F.U + (size_t)(r0 - t0) * 256 + c;
        f32x4 x[23];
#pragma unroll
        for (int k = 0; k < 23; ++k) { const int tau = t0 - 15 + k;
            if (tau >= 0) x[k] = *(const GAS f32x4*)(ub + (size_t)tau * 256); else if (smp) x[k] = *(const GAS f32x4*)(F.state_pool + ((size_t)b * 15 + 15 + tau) * 256 + c); else x[k] = (f32x4){0.f, 0.f, 0.f, 0.f}; }
        f32x4 s2[23], s4[23], s8[23], s16[8];
#pragma unroll
        for (int k = 1; k < 23; ++k) s2[k] = x[k] + x[k - 1];
#pragma unroll
        for (int k = 3; k < 23; ++k) s4[k] = s2[k] + s2[k - 2];
#pragma unroll
        for (int k = 7; k < 23; ++k) s8[k] = s4[k] + s4[k - 4];
#pragma unroll
        for (int k = 0; k < 8; ++k) s16[k] = s8[15 + k] + s8[7 + k];
        const float wf = (float)(2 << g);
#pragma unroll
        for (int k = 0; k < 8; ++k) { const int t = t0 + k;
            const f32x4 s = g == 0 ? s2[15 + k] : g == 1 ? s4[15 + k] : g == 2 ? s8[15 + k] : s16[k];
            const float cnt = smp ? wf : fminf(wf, (float)(t + 1));
            const f32x4 dd = s * (1.f / cnt) - x[15 + k];
            *(GAS u32x2v*)(F.MIX + (size_t)(r0 + k) * D + c) = (u32x2v){pk2(dd[0], dd[1]), pk2(dd[2], dd[3])}; }
        if (smp || t0 == 2040) { float* np = (smp ? F.o_pool_s : F.o_pool_p) + (size_t)b * 15 * 256 + c;
#pragma unroll
            for (int k = 0; k < 15; ++k) *(GAS f32x4*)(np + k * 256) = x[8 + k]; }
    }
}
__device__ __forceinline__ void hgrn_naive_phase(Frame& F) {
    LAS float* qs = (LAS float*)F.lds; LAS float* fs = qs + 128; LAS float* ks = fs + 128; LAS float* part = ks + 128; LAS float* red = part + 512;
    const int tid = F.tid, dv = tid & 127, qd = tid >> 7;
    for (int u = blockIdx.x; u < 32 + 512; u += F.G) {
        const bool smp = u >= 32; const int bh = smp ? u - 32 : u, b = bh >> 2, h = bh & 3, L = smp ? 8 : 2048, row0 = smp ? TP + b * 8 : b * 2048;
        float S[32];
#pragma unroll
        for (int j = 0; j < 32; ++j) S[j] = smp ? F.state_hgrn[(((size_t)b * 4 + h) * 128 + qd * 32 + j) * 128 + dv] : 0.f;
        for (int t = 0; t < L; ++t) {
            const size_t ro = (size_t)(row0 + t) * 512 + h * 128;
            if (tid < 128) { qs[tid] = bf2f(F.Q[ro + tid]); fs[tid] = __expf(F.LOGF[ro + tid]); ks[tid] = bf2f(F.KK[ro + tid]); }
            const float v = bf2f(F.V[ro + dv]);
            __syncthreads();
            float op = 0.f;
#pragma unroll
            for (int j = 0; j < 32; ++j) { const int dk = qd * 32 + j; S[j] = fs[dk] * S[j] + ks[dk] * v; op += qs[dk] * S[j]; }
            part[qd * 128 + dv] = op;
            __syncthreads();
            const float o = (part[dv] + part[128 + dv]) + (part[256 + dv] + part[384 + dv]);
            const float ss = wave_sum(o * o);
            if (F.lane == 0) red[F.wave] = ss;
            __syncthreads();
            if (qd == 0) { const float tot = red[0] + red[1];
                F.MIX[(size_t)(row0 + t) * D + 256 + h * 128 + dv] = (bf16)f2bf(o * (1.f / sqrtf(tot * (1.f / 128.f) + EPS)) * F.onorm_g[h * 128 + dv] * bf2f(F.GS[ro + dv])); }
        }
        float* so = (smp ? F.o_hgrn_s : F.o_hgrn_p) + ((size_t)b * 4 + h) * 128 * 128;
#pragma unroll
        for (int j = 0; j < 32; ++j) so[(size_t)(qd * 32 + j) * 128 + dv] = S[j];
        __syncthreads();
    }
}
__device__ __forceinline__ void xattn_naive_phase(Frame& F) {
    const int half = F.tid >> 8, t2 = F.tid & 255, wv = t2 >> 6;
    LAS float* q = (LAS float*)F.lds + half * 1024; LAS float* p = q + 64; LAS float* red = p + 256; LAS float* po = red + 8;
    for (int it = blockIdx.x; it < MT * 2; it += F.G) {
        const int item = it * 2 + half, r = item >> 2, h = item & 3; const bool smp = r >= TP; const int b = smp ? (r - TP) >> 3 : r >> 11;
        if (t2 < 64) q[t2] = bf2f(F.QX[(size_t)r * 256 + h * 64 + t2]);
        __syncthreads();
        float s = 0.f;
        if (smp) { const float* kr = F.cache_k + ((size_t)b * NMEM + t2) * 256 + h * 64; for (int d = 0; d < 64; ++d) s += q[d] * kr[d]; }
        else { const bf16* kr = F.KVB + ((size_t)b * NMEM + t2) * 512 + h * 64; for (int d = 0; d < 64; ++d) s += q[d] * bf2f(kr[d]); }
        float m = wave_max(s);
        if (F.lane == 0) red[wv] = m;
        __syncthreads();
        m = fmaxf(fmaxf(red[0], red[1]), fmaxf(red[2], red[3]));
        const float e = exp2f(s - m);
        p[t2] = e;
        float sum = wave_sum(e);
        __syncthreads();
        if (F.lane == 0) red[wv] = sum;
        __syncthreads();
        sum = (red[0] + red[1]) + (red[2] + red[3]);
        const int d = t2 & 63, pt = t2 >> 6; float o = 0.f;
        if (smp) { for (int mm = pt * 64; mm < pt * 64 + 64; ++mm) o += p[mm] * F.cache_v[((size_t)b * NMEM + mm) * 256 + h * 64 + d]; }
        else { for (int mm = pt * 64; mm < pt * 64 + 64; ++mm) o += p[mm] * bf2f(F.KVB[((size_t)b * NMEM + mm) * 512 + 256 + h * 64 + d]); }
        po[pt * 64 + d] = o;
        __syncthreads();
        if (t2 < 64) F.MIX[(size_t)r * D + 768 + h * 64 + t2] = (bf16)f2bf(((po[t2] + po[64 + t2]) + (po[128 + t2] + po[192 + t2])) / sum);
        __syncthreads();
    }
}
__device__ __forceinline__ void norm2_phase(Frame& F) {
    const int gw = blockIdx.x * NWAVES + F.wave, NGW = F.G * NWAVES;
    for (int m = gw; m < MT; m += NGW) rms_row_to_bf16(F.lane, F.y + (size_t)m * D, F.ln2_g, F.XN + (size_t)m * D);
}
__device__ __forceinline__ void final_norm_phase(Frame& F) {
    const int gw = blockIdx.x * NWAVES + F.wave, NGW = F.G * NWAVES;
    for (int m = gw; m < MT; m += NGW) {
        GAS f32x4* xr = (GAS f32x4*)(F.y + (size_t)m * D) + F.lane; const GAS f32x4* gr = (const GAS f32x4*)F.lnf_g + F.lane;
        f32x4 v[4]; float s = 0.f;
#pragma unroll
        for (int j = 0; j < 4; ++j) { v[j] = xr[64 * j]; s += (v[j].x * v[j].x + v[j].y * v[j].y) + (v[j].z * v[j].z + v[j].w * v[j].w); }
        const float rstd = 1.f / sqrtf(wave_sum(s) * (1.f / D) + EPS);
#pragma unroll
        for (int j = 0; j < 4; ++j) xr[64 * j] = v[j] * rstd * gr[64 * j];
    }
}
__device__ __forceinline__ float gelu_tanh(float x) { const float u2 = 1.5957691216057308f * (x + 0.044715f * x * x * x); return x * frcp_(1.f + __expf(-u2)); }
__device__ __forceinline__ void conv_fixup_phase(Frame& F) {
    const int total = 56 * 2 * (DFF / 4);
    for (int i = blockIdx.x * 512 + F.tid; i < total; i += F.G * 512) {
        const int j = (i % (DFF / 4)) * 4, k = (i / (DFF / 4)) & 1, q = i / (DFF / 2), pm = (q / 7) * 8 + 1 + (q % 7);
        const f32x4 a0 = *(const GAS f32x4*)(F.EA + ((size_t)pm * 4 + k) * DFF + j);
        const f32x4 a1 = k == 0 ? *(const GAS f32x4*)(F.EA + ((size_t)(pm - 1) * 4 + 3) * DFF + j) : *(const GAS f32x4*)(F.EA + ((size_t)pm * 4 + 0) * DFF + j);
        const f32x4 a2 = k == 0 ? *(const GAS f32x4*)(F.EA + ((size_t)(pm - 1) * 4 + 2) * DFF + j) : *(const GAS f32x4*)(F.EA + ((size_t)(pm - 1) * 4 + 3) * DFF + j);
        const f32x4 bv = *(const GAS f32x4*)(F.EB + ((size_t)pm * 2 + k) * DFF + j);
        const f32x4 cb = *(const GAS f32x4*)(F.conv_b + j), w0 = *(const GAS f32x4*)(F.conv_w + j), w1 = *(const GAS f32x4*)(F.conv_w + DFF + j), w2 = *(const GAS f32x4*)(F.conv_w + 2 * DFF + j);
        float h[4];
#pragma unroll
        for (int e = 0; e < 4; ++e) h[e] = gelu_tanh(cb[e] + w0[e] * a2[e] + w1[e] * a1[e] + w2[e] * a0[e]) * bv[e];
        *(GAS u32x2v*)(F.PB + (size_t)(pm * 256 + k) * DFF + j) = (u32x2v){pk2(h[0], h[1]), pk2(h[2], h[3])};
    }
}
__device__ __forceinline__ void conv_phase(Frame& F) {
    const int total = MT * (DFF / 8);
    for (int i = blockIdx.x * 512 + F.tid; i < total; i += F.G * 512) {
        const int r = i / (DFF / 8), j0 = (i % (DFF / 8)) * 8; const bool smp = r >= TP; const int rr = smp ? r - TP : r; const int b = smp ? rr >> 3 : rr >> 11, t = smp ? rr & 7 : rr & 2047, L = smp ? 8 : 2048;
        const v4u a0p = *(const GAS v4u*)(F.PA + (size_t)r * DFF + j0); const v4u bp = *(const GAS v4u*)(F.PB + (size_t)r * DFF + j0);
        float a0[8], a1[8], a2[8], bb[8];
#pragma unroll
        for (int e = 0; e < 4; ++e) { a0[2 * e] = __builtin_bit_cast(float, a0p[e] << 16); a0[2 * e + 1] = __builtin_bit_cast(float, a0p[e] & 0xffff0000u); bb[2 * e] = __builtin_bit_cast(float, bp[e] << 16); bb[2 * e + 1] = __builtin_bit_cast(float, bp[e] & 0xffff0000u); }
        if (t >= 1) { const v4u p = *(const GAS v4u*)(F.PA + (size_t)(r - 1) * DFF + j0);
#pragma unroll
            for (int e = 0; e < 4; ++e) { a1[2 * e] = __builtin_bit_cast(float, p[e] << 16); a1[2 * e + 1] = __builtin_bit_cast(float, p[e] & 0xffff0000u); } }
        else {
#pragma unroll
            for (int e = 0; e < 8; ++e) a1[e] = smp ? F.state_conv[((size_t)b * 2 + 1) * DFF + j0 + e] : 0.f; }
        if (t >= 2) { const v4u p = *(const GAS v4u*)(F.PA + (size_t)(r - 2) * DFF + j0);
#pragma unroll
            for (int e = 0; e < 4; ++e) { a2[2 * e] = __builtin_bit_cast(float, p[e] << 16); a2[2 * e + 1] = __builtin_bit_cast(float, p[e] & 0xffff0000u); } }
        else {
#pragma unroll
            for (int e = 0; e < 8; ++e) a2[e] = smp ? F.state_conv[((size_t)b * 2 + t) * DFF + j0 + e] : 0.f; }
        float h[8];
#pragma unroll
        for (int e = 0; e < 8; ++e) { const int j = j0 + e; const float c = F.conv_b[j] + F.conv_w[j] * a2[e] + F.conv_w[DFF + j] * a1[e] + F.conv_w[2 * DFF + j] * a0[e]; h[e] = gelu_tanh(c) * bb[e]; }
        v4u o; o.x = pk2(h[0], h[1]); o.y = pk2(h[2], h[3]); o.z = pk2(h[4], h[5]); o.w = pk2(h[6], h[7]);
        *(GAS v4u*)(F.PB + (size_t)r * DFF + j0) = o;
        if (t == L - 1) { float* nc = (smp ? F.o_conv_s : F.o_conv_p) + (size_t)b * 2 * DFF + j0;
#pragma unroll
            for (int e = 0; e < 8; ++e) { nc[e] = a1[e]; nc[DFF + e] = a0[e]; } }
    }
}
__device__ __forceinline__ int sw512(int row, int ch) { return row * 512 + ((ch ^ (row & 15)) << 4); }
__device__ __forceinline__ int sw256(int row, int ch) { return row * 256 + ((ch ^ (row & 15)) << 4); }
__device__ __forceinline__ int sw128(int row, int ch) { return row * 128 + ((ch ^ ((row >> 1) & 7)) << 4); }
__device__ __forceinline__ bf16x8 ldfrag(const LAS unsigned char* p) { return *(const LAS bf16x8*)p; }
__device__ __forceinline__ f32x4 mma16(bf16x8 a, bf16x8 b, f32x4 c) { return __builtin_amdgcn_mfma_f32_16x16x32_bf16(a, b, c, 0, 0, 0); }
constexpr int HG_NU = 8 * 4 * 8;
constexpr float A_CLAMP = -80.f;

__device__ __forceinline__ int sw512b(int row, int ch) { return row * 512 + ((ch ^ ((row ^ (row >> 3)) & 15)) << 4); }
__device__ __forceinline__ void hgrn_passA(Frame& F, f32x4* HU, float* HD) {
    LAS unsigned char* KT = F.lds;
    LAS unsigned char* VT = F.lds + 65536;
    LAS float* segtot = (LAS float*)F.lds;
    const int tid = F.tid, c8 = tid & 15, tq = tid >> 4, w = F.wave, lane = F.lane, l15 = lane & 15, lq = lane >> 4;
    for (int u = blockIdx.x; u < HG_NU; u += F.G) {
        const int sc = u & 7, bh = u >> 3, b = bh >> 2, h = bh & 3;
        const size_t rbase = (size_t)(b * 2048 + sc * 256 + tq * 8) * 512 + h * 128 + 8 * c8;
        f32x4 lf[8][2]; v4u kq[8], vq[8];
#pragma unroll
        for (int i = 0; i < 8; ++i) { lf[i][0] = *(const GAS f32x4*)(F.LOGF + rbase + (size_t)i * 512); lf[i][1] = *(const GAS f32x4*)(F.LOGF + rbase + (size_t)i * 512 + 4);
            kq[i] = *(const GAS v4u*)(F.KK + rbase + (size_t)i * 512); }
#pragma unroll
        for (int i = 1; i < 8; ++i) { lf[i][0] += lf[i - 1][0]; lf[i][1] += lf[i - 1][1]; }
        *(LAS f32x4*)(segtot + tq * 128 + 8 * c8) = lf[7][0]; *(LAS f32x4*)(segtot + tq * 128 + 8 * c8 + 4) = lf[7][1];
        __syncthreads();
        f32x4 off[2] = {(f32x4){0.f, 0.f, 0.f, 0.f}, (f32x4){0.f, 0.f, 0.f, 0.f}}, aend[2] = {(f32x4){0.f, 0.f, 0.f, 0.f}, (f32x4){0.f, 0.f, 0.f, 0.f}};
#pragma unroll 8
        for (int s2 = 0; s2 < 32; ++s2) { const f32x4 t0 = *(const LAS f32x4*)(segtot + s2 * 128 + 8 * c8), t1 = *(const LAS f32x4*)(segtot + s2 * 128 + 8 * c8 + 4);
            aend[0] += t0; aend[1] += t1; if (s2 < tq) { off[0] += t0; off[1] += t1; } }
        __syncthreads();
        if (tq == 0) { f32x4 d0, d1;
#pragma unroll
            for (int e = 0; e < 4; ++e) { d0[e] = __expf(aend[0][e]); d1[e] = __expf(aend[1][e]); }
            *(GAS f32x4*)(HD + (size_t)u * 128 + 8 * c8) = d0; *(GAS f32x4*)(HD + (size_t)u * 128 + 8 * c8 + 4) = d1; }
#pragma unroll
        for (int jh = 0; jh < 2; ++jh) {
            unsigned ke[4][4];
#pragma unroll
            for (int i = 0; i < 8; ++i)
#pragma unroll
                for (int jj = 0; jj < 4; ++jj) { const int j = 4 * jh + jj; const float kk = __builtin_bit_cast(float, (j & 1) ? (kq[i][j >> 1] & 0xffff0000u) : (kq[i][j >> 1] << 16));
                    const float ev = kk * __expf(aend[jh][jj] - (off[jh][jj] + lf[i][jh][jj])); const unsigned bits = f2bf(ev);
                    if (i & 1) ke[jj][i >> 1] |= bits << 16; else ke[jj][i >> 1] = bits; }
#pragma unroll
            for (int jj = 0; jj < 4; ++jj) *(LAS v4u*)(KT + sw512b(8 * c8 + 4 * jh + jj, tq)) = (v4u){ke[jj][0], ke[jj][1], ke[jj][2], ke[jj][3]};
            __builtin_amdgcn_sched_barrier(0);
            if (jh == 0) {
#pragma unroll
                for (int i = 0; i < 8; ++i) vq[i] = *(const GAS v4u*)(F.V + rbase + (size_t)i * 512);
            }
        }
#pragma unroll
        for (int j = 0; j < 8; ++j) {
            unsigned vv[4];
#pragma unroll
            for (int p = 0; p < 4; ++p) { const unsigned lo = (j & 1) ? (vq[2 * p][j >> 1] >> 16) : (vq[2 * p][j >> 1] & 0xffffu), hi = (j & 1) ? (vq[2 * p + 1][j >> 1] & 0xffff0000u) : (vq[2 * p + 1][j >> 1] << 16); vv[p] = lo | hi; }
            *(LAS v4u*)(VT + sw512b(8 * c8 + j, tq)) = (v4u){vv[0], vv[1], vv[2], vv[3]}; }
        __syncthreads();
        f32x4 acc[8];
#pragma unroll
        for (int n = 0; n < 8; ++n) acc[n] = (f32x4){0.f, 0.f, 0.f, 0.f};
#pragma unroll
        for (int ks = 0; ks < 8; ++ks) {
            const bf16x8 af = ldfrag(KT + sw512b(16 * w + l15, 4 * ks + lq));
#pragma unroll
            for (int n = 0; n < 8; ++n) acc[n] = mma16(af, ldfrag(VT + sw512b(16 * n + l15, 4 * ks + lq)), acc[n]);
        }
#pragma unroll
        for (int n = 0; n < 8; ++n) HU[(((size_t)u * 8 + w) * 8 + n) * 64 + lane] = acc[n];
        __syncthreads();
    }
}

#define PC_LOAD_LF(LF, ckk) do { const size_t rb_ = (size_t)(b * 2048 + sc * 256 + (ckk) * 64 + seg * 16) * 512 + h * 128 + c; \
    _Pragma("unroll") for (int i = 0; i < 16; ++i) LF[i] = F.LOGF[rb_ + (size_t)i * 512]; } while (0)
#define PC_LOAD_QKV(QQ, KQ, VQ, ckk) do { const size_t rb_ = (size_t)(b * 2048 + sc * 256 + (ckk) * 64 + seg * 16) * 512 + h * 128 + c; \
    _Pragma("unroll") for (int i = 0; i < 16; ++i) { QQ[i] = F.Q[rb_ + (size_t)i * 512]; KQ[i] = F.KK[rb_ + (size_t)i * 512]; VQ[i] = F.V[rb_ + (size_t)i * 512]; } } while (0)
#define PC_CHUNK(ck, LF, QQ, KQ, VQ, NLF, NQQ, NKQ, NVQ) do { \
    const int trow0 = b * 2048 + sc * 256 + (ck) * 64; \
    _Pragma("unroll") for (int n = 0; n < 8; ++n) { const int dv = 16 * n + l15; *(LAS u32x2v*)(ST + sw256(dv, 2 * w + (lq >> 1)) + 8 * (lq & 1)) = (u32x2v){pk2(S[n][0], S[n][1]), pk2(S[n][2], S[n][3])}; } \
    float a[16]; { float run = 0.f; _Pragma("unroll") for (int i = 0; i < 16; ++i) { run += LF[i]; a[i] = run; } } \
    segtot[seg * 128 + c] = a[15]; \
    __syncthreads(); \
    float off = 0.f, aend = 0.f; \
    _Pragma("unroll") for (int s2 = 0; s2 < 4; ++s2) { const float v_ = segtot[s2 * 128 + c]; aend += v_; if (s2 < seg) off += v_; } \
    if (seg == 0) AE[c] = aend; \
    unsigned ke[8], vv[8]; \
    _Pragma("unroll") for (int i = 0; i < 16; ++i) { \
        const float At = fmaxf(off + a[i], A_CLAMP); const float q = bf2f(QQ[i]), k = bf2f(KQ[i]); \
        const float eA = __expf(At), eN = __expf(-At), eE = __expf(aend - (off + a[i])); const int t = seg * 16 + i; \
        *(LAS bf16*)(QA + sw256(t, c >> 3) + 2 * (c & 7)) = (bf16)f2bf(q * eA); *(LAS bf16*)(KA + sw256(t, c >> 3) + 2 * (c & 7)) = (bf16)f2bf(k * eN); \
        const unsigned kev = f2bf(k * eE), vvv = (unsigned)VQ[i]; \
        if (i & 1) { ke[i >> 1] |= kev << 16; vv[i >> 1] |= vvv << 16; } else { ke[i >> 1] = kev; vv[i >> 1] = vvv; } } \
    *(LAS v4u*)(KET + sw128(c, 2 * seg)) = (v4u){ke[0], ke[1], ke[2], ke[3]}; *(LAS v4u*)(KET + sw128(c, 2 * seg + 1)) = (v4u){ke[4], ke[5], ke[6], ke[7]}; \
    *(LAS v4u*)(VT + sw128(c, 2 * seg)) = (v4u){vv[0], vv[1], vv[2], vv[3]}; *(LAS v4u*)(VT + sw128(c, 2 * seg + 1)) = (v4u){vv[4], vv[5], vv[6], vv[7]}; \
    __syncthreads(); \
    _Pragma("unroll") for (int j = 0; j < 2; ++j) { const int sb = 2 * wh + j; f32x4 p = (f32x4){0.f, 0.f, 0.f, 0.f}; \
        if (sb <= tb) { _Pragma("unroll") for (int ks = 0; ks < 4; ++ks) p = mma16(ldfrag(QA + sw256(16 * tb + l15, 4 * ks + lq)), ldfrag(KA + sw256(16 * sb + l15, 4 * ks + lq)), p); } \
        _Pragma("unroll") for (int i = 0; i < 4; ++i) { const int t = 16 * tb + 4 * lq + i, s = 16 * sb + l15; const float pv = (s <= t) ? p[i] : 0.f; \
            *(LAS bf16*)(PS + sw128(t, s >> 3) + 2 * (s & 7)) = (bf16)f2bf(pv); } } \
    __syncthreads(); \
    bf16 gq[4][4]; \
    _Pragma("unroll") for (int i = 0; i < 4; ++i) _Pragma("unroll") for (int n = 0; n < 4; ++n) gq[i][n] = F.GS[(size_t)(trow0 + 16 * tb + 4 * lq + i) * 512 + h * 128 + 16 * (4 * wh + n) + l15]; \
    f32x4 o[4]; \
    _Pragma("unroll") for (int n = 0; n < 4; ++n) o[n] = (f32x4){0.f, 0.f, 0.f, 0.f}; \
    _Pragma("unroll") for (int ks = 0; ks < 2; ++ks) { const bf16x8 af = ldfrag(PS + sw128(16 * tb + l15, 4 * ks + lq)); \
        _Pragma("unroll") for (int n = 0; n < 4; ++n) o[n] = mma16(af, ldfrag(VT + sw128(16 * (4 * wh + n) + l15, 4 * ks + lq)), o[n]); } \
    _Pragma("unroll") for (int ks = 0; ks < 4; ++ks) { const bf16x8 af = ldfrag(QA + sw256(16 * tb + l15, 4 * ks + lq)); \
        _Pragma("unroll") for (int n = 0; n < 4; ++n) o[n] = mma16(af, ldfrag(ST + sw256(16 * (4 * wh + n) + l15, 4 * ks + lq)), o[n]); } \
    if ((ck) < 3) { const f32x4 d4 = *(const LAS f32x4*)(AE + 16 * w + 4 * lq); f32x4 dc; \
        _Pragma("unroll") for (int i = 0; i < 4; ++i) dc[i] = __expf(d4[i]); \
        _Pragma("unroll") for (int n = 0; n < 8; ++n) S[n] = S[n] * dc; \
        _Pragma("unroll") for (int ks = 0; ks < 2; ++ks) { const bf16x8 af = ldfrag(KET + sw128(16 * w + l15, 4 * ks + lq)); \
            _Pragma("unroll") for (int n = 0; n < 8; ++n) S[n] = mma16(af, ldfrag(VT + sw128(16 * n + l15, 4 * ks + lq)), S[n]); } } \
    if ((ck) < 3) { PC_LOAD_LF(NLF, (ck) + 1); PC_LOAD_QKV(NQQ, NKQ, NVQ, (ck) + 1); } \
    f32x4 ss = (f32x4){0.f, 0.f, 0.f, 0.f}; \
    _Pragma("unroll") for (int n = 0; n < 4; ++n) ss += o[n] * o[n]; \
    _Pragma("unroll") for (int i = 0; i < 4; ++i) { float v_ = ss[i]; v_ += __shfl_xor(v_, 1); v_ += __shfl_xor(v_, 2); v_ += __shfl_xor(v_, 4); v_ += __shfl_xor(v_, 8); ss[i] = v_; } \
    if (l15 == 0) { _Pragma("unroll") for (int i = 0; i < 4; ++i) RS[(16 * tb + 4 * lq + i) * 2 + wh] = ss[i]; } \
    __syncthreads(); \
    _Pragma("unroll") for (int i = 0; i < 4; ++i) { const int t = 16 * tb + 4 * lq + i; const float tot = RS[t * 2] + RS[t * 2 + 1]; const float rs = 1.f / sqrtf(tot * (1.f / 128.f) + EPS); \
        const size_t r = (size_t)(trow0 + t); \
        _Pragma("unroll") for (int n = 0; n < 4; ++n) { const int dv = 16 * (4 * wh + n) + l15; \
            F.MIX[r * D + 256 + h * 128 + dv] = (bf16)f2bf(o[n][i] * rs * og[n] * bf2f(gq[i][n])); } } \
  } while (0)
__device__ __forceinline__ void hgrn_passC(Frame& F, const f32x4* HU, const float* HD) {
    LAS unsigned char* QA = F.lds;
    LAS unsigned char* KA = F.lds + 16384;
    LAS unsigned char* KET = F.lds + 32768;
    LAS unsigned char* VT = F.lds + 49152;
    LAS unsigned char* PS = F.lds + 65536;
    LAS unsigned char* ST = F.lds + 73728;
    LAS float* AE = (LAS float*)(F.lds + 106496);
    LAS float* segtot = AE + 128;
    LAS float* RS = segtot + 512;
    const int tid = F.tid, c = tid & 127, seg = tid >> 7, w = F.wave, lane = F.lane, l15 = lane & 15, lq = lane >> 4;
    const int tb = w >> 1, wh = w & 1;
    for (int u = blockIdx.x; u < HG_NU; u += F.G) {
        const int sc = u & 7, bh = u >> 3, b = bh >> 2, h = bh & 3;
        float lfA[16], lfB[16]; bf16 qA_[16], kA_[16], vA_[16], qB_[16], kB_[16], vB_[16];
        PC_LOAD_LF(lfA, 0); PC_LOAD_QKV(qA_, kA_, vA_, 0);
        float og[4];
#pragma unroll
        for (int n = 0; n < 4; ++n) og[n] = F.onorm_g[h * 128 + 16 * (4 * wh + n) + l15];
        f32x4 S[8];
#pragma unroll
        for (int n = 0; n < 8; ++n) S[n] = (f32x4){0.f, 0.f, 0.f, 0.f};
        for (int p = 0; p < sc; ++p) { const int up = (bh << 3) + p; const f32x4 d4 = *(const f32x4*)(HD + (size_t)up * 128 + 16 * w + 4 * lq);
#pragma unroll
            for (int n = 0; n < 8; ++n) S[n] = S[n] * d4 + HU[(((size_t)up * 8 + w) * 8 + n) * 64 + lane]; }
        if (sc == 7) { const f32x4 d4 = *(const f32x4*)(HD + (size_t)u * 128 + 16 * w + 4 * lq); float* so = F.o_hgrn_p + (size_t)bh * 128 * 128;
#pragma unroll
            for (int n = 0; n < 8; ++n) { const f32x4 fin = S[n] * d4 + HU[(((size_t)u * 8 + w) * 8 + n) * 64 + lane];
#pragma unroll
                for (int i = 0; i < 4; ++i) so[(size_t)(16 * w + 4 * lq + i) * 128 + 16 * n + l15] = fin[i]; } }
        PC_CHUNK(0, lfA, qA_, kA_, vA_, lfB, qB_, kB_, vB_);
        PC_CHUNK(1, lfB, qB_, kB_, vB_, lfA, qA_, kA_, vA_);
        PC_CHUNK(2, lfA, qA_, kA_, vA_, lfB, qB_, kB_, vB_);
        PC_CHUNK(3, lfB, qB_, kB_, vB_, lfA, qA_, kA_, vA_);
        __syncthreads();
    }
}
#undef PC_LOAD_LF
#undef PC_LOAD_QKV
#undef PC_CHUNK

__device__ __forceinline__ void hgrn_sample(Frame& F) {
    LAS float* qs = (LAS float*)F.lds; LAS float* fs = qs + 1024; LAS float* ks = fs + 1024;
    LAS float* part = ks + 1024;
    LAS float* red = part + 4096;
    const int tid = F.tid, dv = tid & 127, qd = tid >> 7;
    for (int u = blockIdx.x; u < 512; u += F.G) {
        const int b = u >> 2, h = u & 3, row0 = TP + b * 8;
        float S[32];
#pragma unroll
        for (int j = 0; j < 32; ++j) S[j] = F.state_hgrn[(((size_t)b * 4 + h) * 128 + qd * 32 + j) * 128 + dv];
#pragma unroll
        for (int i = 0; i < 2; ++i) { const int idx = tid + 512 * i, t = idx >> 7, cc = idx & 127; const size_t ro = (size_t)(row0 + t) * 512 + h * 128 + cc;
            qs[idx] = bf2f(F.Q[ro]); fs[idx] = __expf(F.LOGF[ro]); ks[idx] = bf2f(F.KK[ro]); }
        float v[8];
#pragma unroll
        for (int t = 0; t < 8; ++t) v[t] = bf2f(F.V[(size_t)(row0 + t) * 512 + h * 128 + dv]);
        __syncthreads();
#pragma unroll
        for (int t = 0; t < 8; ++t) { float op = 0.f;
#pragma unroll
            for (int j4 = 0; j4 < 8; ++j4) { const f32x4 f4 = *(const LAS f32x4*)(fs + t * 128 + qd * 32 + 4 * j4), k4 = *(const LAS f32x4*)(ks + t * 128 + qd * 32 + 4 * j4), q4 = *(const LAS f32x4*)(qs + t * 128 + qd * 32 + 4 * j4);
#pragma unroll
                for (int e = 0; e < 4; ++e) { float s = f4[e] * S[4 * j4 + e] + k4[e] * v[t]; S[4 * j4 + e] = s; op += q4[e] * s; } }
            part[(qd * 8 + t) * 128 + dv] = op; }
        float* so = F.o_hgrn_s + ((size_t)b * 4 + h) * 128 * 128;
#pragma unroll
        for (int j = 0; j < 32; ++j) so[(size_t)(qd * 32 + j) * 128 + dv] = S[j];
        __syncthreads();
        float o2[2];
#pragma unroll
        for (int i = 0; i < 2; ++i) { const int idx = tid + 512 * i, t = idx >> 7, d2 = idx & 127;
            const float o = (part[(0 * 8 + t) * 128 + d2] + part[(1 * 8 + t) * 128 + d2]) + (part[(2 * 8 + t) * 128 + d2] + part[(3 * 8 + t) * 128 + d2]);
            o2[i] = o; const float ssq = wave_sum(o * o); if (F.lane == 0) red[i * 8 + F.wave] = ssq; }
        __syncthreads();
#pragma unroll
        for (int i = 0; i < 2; ++i) { const int idx = tid + 512 * i, t = idx >> 7, d2 = idx & 127; const float tot = red[i * 8 + (F.wave & ~1)] + red[i * 8 + (F.wave | 1)];
            const size_t r = (size_t)(row0 + t);
            F.MIX[r * D + 256 + h * 128 + d2] = (bf16)f2bf(o2[i] * (1.f / sqrtf(tot * (1.f / 128.f) + EPS)) * F.onorm_g[h * 128 + d2] * bf2f(F.GS[r * 512 + h * 128 + d2])); }
        __syncthreads();
    }
}
__device__ __forceinline__ bf16x8 frag_from(unsigned a, unsigned b, unsigned c, unsigned d) { return __builtin_bit_cast(bf16x8, (v4u){a, b, c, d}); }
__device__ __forceinline__ void xattn_prompt(Frame& F) {
    LAS unsigned char* KS = F.lds;
    LAS unsigned char* VT = F.lds + 32768;
    const int tid = F.tid, w = F.wave, lane = F.lane, l15 = lane & 15, lq = lane >> 4;
    for (int u = blockIdx.x; u < 256; u += F.G) {
        const int qb = u & 7, bh = u >> 3, b = bh >> 2, h = bh & 3;
        { const int kv = tid >> 1, half = tid & 1; const bf16* src = F.KVB + (size_t)(b * 256 + kv) * 512 + h * 64 + half * 32;
#pragma unroll
          for (int j = 0; j < 4; ++j) { const int cidx = 4 * half + j; *(LAS v4u*)(KS + ((((kv >> 4) * 2 + (cidx >> 2)) * 64 + 16 * (cidx & 3) + (kv & 15)) << 4)) = *(const GAS v4u*)(src + 8 * j); } }
        { const int d = tid & 63, kvg = tid >> 6; const bf16* src = F.KVB + (size_t)(b * 256 + 32 * kvg) * 512 + 256 + h * 64 + d;
          unsigned x[32];
#pragma unroll
          for (int i = 0; i < 32; ++i) x[i] = (unsigned)src[(size_t)i * 512];
#pragma unroll
          for (int q4 = 0; q4 < 4; ++q4) *(LAS v4u*)(VT + ((((d >> 4) * 8 + kvg) * 64 + 16 * q4 + (d & 15)) << 4)) =
              (v4u){x[4 * q4] | (x[4 * q4 + 1] << 16), x[4 * q4 + 2] | (x[4 * q4 + 3] << 16), x[16 + 4 * q4] | (x[16 + 4 * q4 + 1] << 16), x[16 + 4 * q4 + 2] | (x[16 + 4 * q4 + 3] << 16)}; }
        __syncthreads();
        const LAS unsigned char* kl = KS + lane * 16; const LAS unsigned char* vl = VT + lane * 16;
#pragma unroll 1
        for (int blk = 0; blk < 2; ++blk) {
            const int q0 = b * 2048 + qb * 256 + 32 * w + 16 * blk;
            bf16x8 qf[2];
#pragma unroll
            for (int ks = 0; ks < 2; ++ks) qf[ks] = *(const GAS bf16x8*)(F.QX + (size_t)(q0 + l15) * 256 + h * 64 + 32 * ks + 8 * lq);
            f32x4 s[16];
#pragma unroll
            for (int kt = 0; kt < 16; ++kt) { s[kt] = mma16(ldfrag(kl + (kt * 2 + 0) * 1024), qf[0], (f32x4){0.f, 0.f, 0.f, 0.f}); s[kt] = mma16(ldfrag(kl + (kt * 2 + 1) * 1024), qf[1], s[kt]);
                if ((kt & 3) == 3) __builtin_amdgcn_sched_barrier(0); }
            float m = s[0][0];
#pragma unroll
            for (int kt = 0; kt < 16; ++kt)
#pragma unroll
                for (int i = 0; i < 4; ++i) m = fmaxf(m, s[kt][i]);
            m = fmaxf(m, __shfl_xor(m, 16)); m = fmaxf(m, __shfl_xor(m, 32));
            float l = 0.f;
#pragma unroll
            for (int kt = 0; kt < 16; ++kt)
#pragma unroll
                for (int i = 0; i < 4; ++i) { const float p = exp2f(s[kt][i] - m); s[kt][i] = p; l += p; }
            l += __shfl_xor(l, 16); l += __shfl_xor(l, 32);
            const float inv = 1.f / l;
            f32x4 o[4];
#pragma unroll
            for (int dt = 0; dt < 4; ++dt) o[dt] = (f32x4){0.f, 0.f, 0.f, 0.f};
#pragma unroll
            for (int ks = 0; ks < 8; ++ks) {
                const f32x4 p0 = s[2 * ks] * inv, p1 = s[2 * ks + 1] * inv;
                const bf16x8 bfr = frag_from(pk2(p0[0], p0[1]), pk2(p0[2], p0[3]), pk2(p1[0], p1[1]), pk2(p1[2], p1[3]));
#pragma unroll
                for (int dt = 0; dt < 4; ++dt) o[dt] = mma16(ldfrag(vl + (dt * 8 + ks) * 1024), bfr, o[dt]);
                __builtin_amdgcn_sched_barrier(0);
            }
#pragma unroll
            for (int dt = 0; dt < 4; ++dt) *(GAS u32x2v*)(F.MIX + (size_t)(q0 + l15) * D + 768 + h * 64 + 16 * dt + 4 * lq) = (u32x2v){pk2(o[dt][0], o[dt][1]), pk2(o[dt][2], o[dt][3])};
        }
        __syncthreads();
    }
}
__device__ __forceinline__ void xattn_sample(Frame& F) {
    LAS float* MX = (LAS float*)F.lds; LAS float* LS = MX + 128; LAS float* OP = LS + 128;
    const int tid = F.tid, w = F.wave, lane = F.lane, l15 = lane & 15, lq = lane >> 4;
    for (int u = blockIdx.x; u < 512; u += F.G) {
        const int b = u >> 2, h = u & 3, row0 = TP + 8 * b;
        bf16x8 qf[2];
#pragma unroll
        for (int ks = 0; ks < 2; ++ks) qf[ks] = *(const GAS bf16x8*)(F.QX + (size_t)(row0 + (l15 & 7)) * 256 + h * 64 + 32 * ks + 8 * lq);
        f32x4 s[2];
#pragma unroll
        for (int t2 = 0; t2 < 2; ++t2) { s[t2] = (f32x4){0.f, 0.f, 0.f, 0.f};
#pragma unroll
            for (int ks = 0; ks < 2; ++ks) { const float* kp = F.cache_k + (((size_t)b * 256 + 32 * w + 16 * t2 + l15) * 4 + h) * 64 + 32 * ks + 8 * lq;
                const f32x4 x0 = *(const GAS f32x4*)kp, x1 = *(const GAS f32x4*)(kp + 4);
                s[t2] = mma16(frag_from(pk2(x0[0], x0[1]), pk2(x0[2], x0[3]), pk2(x1[0], x1[1]), pk2(x1[2], x1[3])), qf[ks], s[t2]); } }
        float vv[4][8];
#pragma unroll
        for (int dt = 0; dt < 4; ++dt)
#pragma unroll
            for (int j = 0; j < 8; ++j) vv[dt][j] = F.cache_v[(((size_t)b * 256 + 32 * w + 16 * (j >> 2) + 4 * lq + (j & 3)) * 4 + h) * 64 + 16 * dt + l15];
        float m = fmaxf(fmaxf(fmaxf(s[0][0], s[0][1]), fmaxf(s[0][2], s[0][3])), fmaxf(fmaxf(s[1][0], s[1][1]), fmaxf(s[1][2], s[1][3])));
        m = fmaxf(m, __shfl_xor(m, 16)); m = fmaxf(m, __shfl_xor(m, 32));
        if (lq == 0) MX[w * 16 + l15] = m;
        __syncthreads();
        m = MX[l15];
#pragma unroll
        for (int w2 = 1; w2 < 8; ++w2) m = fmaxf(m, MX[w2 * 16 + l15]);
        float l = 0.f;
#pragma unroll
        for (int t2 = 0; t2 < 2; ++t2)
#pragma unroll
            for (int i = 0; i < 4; ++i) { const float p = exp2f(s[t2][i] - m); s[t2][i] = p; l += p; }
        l += __shfl_xor(l, 16); l += __shfl_xor(l, 32);
        if (lq == 0) LS[w * 16 + l15] = l;
        const bf16x8 bfr = frag_from(pk2(s[0][0], s[0][1]), pk2(s[0][2], s[0][3]), pk2(s[1][0], s[1][1]), pk2(s[1][2], s[1][3]));
#pragma unroll
        for (int dt = 0; dt < 4; ++dt) {
            const f32x4 o = mma16(frag_from(pk2(vv[dt][0], vv[dt][1]), pk2(vv[dt][2], vv[dt][3]), pk2(vv[dt][4], vv[dt][5]), pk2(vv[dt][6], vv[dt][7])), bfr, (f32x4){0.f, 0.f, 0.f, 0.f});
#pragma unroll
            for (int i = 0; i < 4; ++i) OP[(w * 64 + 16 * dt + 4 * lq + i) * 16 + l15] = o[i];
        }
        __syncthreads();
        { const int q = tid >> 6, d = tid & 63; float o = 0.f, ll = 0.f;
#pragma unroll
          for (int w2 = 0; w2 < 8; ++w2) { o += OP[(w2 * 64 + d) * 16 + q]; ll += LS[w2 * 16 + q]; }
          F.MIX[(size_t)(row0 + q) * D + 768 + h * 64 + d] = (bf16)f2bf(o / ll); }
        __syncthreads();
    }
}
template <class Epi> __device__ __forceinline__ void small_piece(const bf16* A, const bf16* Bt, int K, int w, int lane, const Epi& epi) {
    const int rb = w >> 1, cb = w & 1, l15 = lane & 15, lq = lane >> 4;
    const bf16* ap = A + (size_t)(16 * rb + l15) * K + 8 * lq;
    const bf16* bp0 = Bt + (size_t)(32 * cb + l15) * K + 8 * lq; const bf16* bp1 = bp0 + (size_t)16 * K;
    f32x4 acc0 = (f32x4){0.f, 0.f, 0.f, 0.f}, acc1 = (f32x4){0.f, 0.f, 0.f, 0.f};
    const int ng = K / 256;
    bf16x8 xa[8], wa0[8], wa1[8], xb[8], wb0[8], wb1[8];
#define SP_LOAD(X, W0, W1, gi) do { const int o_ = 256 * (gi); _Pragma("unroll") for (int j = 0; j < 8; ++j) { X[j] = *(const GAS bf16x8*)(ap + o_ + 32 * j); W0[j] = *(const GAS bf16x8*)(bp0 + o_ + 32 * j); W1[j] = *(const GAS bf16x8*)(bp1 + o_ + 32 * j); } } while (0)
#define SP_MMA(X, W0, W1) do { _Pragma("unroll") for (int j = 0; j < 8; ++j) { acc0 = mma16(W0[j], X[j], acc0); acc1 = mma16(W1[j], X[j], acc1); } } while (0)
    SP_LOAD(xa, wa0, wa1, 0);
    int g = 0;
#pragma unroll 1
    for (; g + 1 < ng; g += 2) {
        SP_LOAD(xb, wb0, wb1, g + 1);
        SP_MMA(xa, wa0, wa1);
        SP_LOAD(xa, wa0, wa1, (g + 2 < ng ? g + 2 : ng - 1));
        SP_MMA(xb, wb0, wb1);
    }
    if (g < ng) SP_MMA(xa, wa0, wa1);
#undef SP_LOAD
#undef SP_MMA
    epi(acc0, acc1, 16 * rb + l15, 32 * cb + 4 * lq, cb, lq);
}
__device__ __forceinline__ void out_sample_piece(Frame& F) {
    const int p = blockIdx.x; if (p >= 256) return; const int pr = p >> 4, pc = p & 15;
    auto epi = [&](const f32x4& a0, const f32x4& a1, int r, int c, int cb, int lq) {
        const int rs = 64 * pr + r, col = 64 * pc + c; const float* xr = F.x_sample + (size_t)rs * D + col; bf16* xo = F.XN + (size_t)(TP + rs) * D + col;
        const f32x4 v0 = a0 + *(const GAS f32x4*)xr, v1 = a1 + *(const GAS f32x4*)(xr + 16);
        *(GAS u32x2v*)xo = (u32x2v){pk2(v0[0], v0[1]), pk2(v0[2], v0[3])}; *(GAS u32x2v*)(xo + 16) = (u32x2v){pk2(v1[0], v1[1]), pk2(v1[2], v1[3])};
        float ss = ((v0[0] * v0[0] + v0[1] * v0[1]) + (v0[2] * v0[2] + v0[3] * v0[3])) + ((v1[0] * v1[0] + v1[1] * v1[1]) + (v1[2] * v1[2] + v1[3] * v1[3]));
        ss += __shfl_xor(ss, 16); ss += __shfl_xor(ss, 32);
        if (lq == 0) F.ROWSS_S[(size_t)rs * 32 + pc * 2 + cb] = ss; };
    small_piece(F.MIX + (size_t)(TP + 64 * pr) * D, F.WOUT + (size_t)(64 * pc) * D, D, F.wave, F.lane, epi);
}
__device__ __forceinline__ void down_sample_piece(Frame& F) {
    const int p = blockIdx.x; if (p >= 256) return; const int pr = p >> 4, pc = p & 15;
    auto epi = [&](const f32x4& a0, const f32x4& a1, int r, int c, int cb, int lq) {
        float* yo = F.y + (size_t)(TP + 64 * pr + r) * D + 64 * pc + c; const bf16* xi = F.XN + (size_t)(TP + 64 * pr + r) * D + 64 * pc + c;
        const u32x2v b0 = *(const GAS u32x2v*)xi, b1 = *(const GAS u32x2v*)(xi + 16);
        const f32x4 r0 = (f32x4){__builtin_bit_cast(float, b0.x << 16), __builtin_bit_cast(float, b0.x & 0xffff0000u), __builtin_bit_cast(float, b0.y << 16), __builtin_bit_cast(float, b0.y & 0xffff0000u)};
        const f32x4 r1 = (f32x4){__builtin_bit_cast(float, b1.x << 16), __builtin_bit_cast(float, b1.x & 0xffff0000u), __builtin_bit_cast(float, b1.y << 16), __builtin_bit_cast(float, b1.y & 0xffff0000u)};
        const f32x4 v0 = a0 + r0, v1 = a1 + r1;
        *(GAS f32x4*)yo = v0; *(GAS f32x4*)(yo + 16) = v1; };
    small_piece(F.PB + (size_t)(TP + 64 * pr) * DFF, F.WDN + (size_t)(64 * pc) * DFF, DFF, F.wave, F.lane, epi);
}
__global__ void __launch_bounds__(NWAVES * 64, 2) mk_fwd(Args args) {
    extern __shared__ __attribute__((aligned(16))) unsigned char lds[];
    Frame F;
    F.lds = (LAS unsigned char*)lds;
    F.tid = threadIdx.x; F.lane = F.tid & 63; F.wave = __builtin_amdgcn_readfirstlane(F.tid >> 6); F.G = gridDim.x;
    volatile LAS unsigned* MISC = (volatile LAS unsigned*)(F.lds + MISC_OFF);
    unsigned char* ws = args.ws;
    gu32* ctl = (gu32*)(ws + WS_CTL);
    F.x_prompt = args.in[0]; F.x_sample = args.in[1]; F.mem_prompt = args.in[2]; F.state_pool = args.in[3]; F.state_hgrn = args.in[4]; F.state_conv = args.in[5];
    F.cache_k = args.in[6]; F.cache_v = args.in[7]; F.ln1_g = args.in[8]; F.w_in = args.in[9]; F.pool_w = args.in[10]; F.pool_scale = args.in[11]; F.lb_logits = args.in[12];
    F.onorm_g = args.in[13]; F.mem_norm_g = args.in[14]; F.w_mem_kv = args.in[15]; F.w_out = args.in[16]; F.ln2_g = args.in[17]; F.w_up = args.in[18]; F.conv_w = args.in[19];
    F.conv_b = args.in[20]; F.w_down = args.in[21]; F.lnf_g = args.in[22];
    float* out = args.out;
    F.y = out; F.o_pool_p = out + (size_t)MT * D; F.o_hgrn_p = F.o_pool_p + 8 * 15 * 256; F.o_conv_p = F.o_hgrn_p + 8 * 4 * 128 * 128; F.o_mk = F.o_conv_p + 8 * 2 * DFF;
    F.o_mv = F.o_mk + MEMR * 256; F.o_pool_s = F.o_mv + MEMR * 256; F.o_hgrn_s = F.o_pool_s + 128 * 15 * 256; F.o_conv_s = F.o_hgrn_s + (size_t)128 * 4 * 128 * 128;
    F.WIN = (bf16*)(ws + WS_WIN); F.WKV = (bf16*)(ws + WS_WKV); F.WOUT = (bf16*)(ws + WS_WOUT); F.WUP = (bf16*)(ws + WS_WUP); F.WDN = (bf16*)(ws + WS_WDN);
    F.XN = (bf16*)(ws + WS_XN); F.XNM = (bf16*)(ws + WS_XNM); F.KVB = (bf16*)(ws + WS_KVB); F.MIX = (bf16*)(ws + WS_MIX);
    F.U = (float*)(ws + WS_U); F.Q = (bf16*)(ws + WS_Q); F.LOGF = (float*)(ws + WS_LOGF); F.KK = (bf16*)(ws + WS_KK); F.V = (bf16*)(ws + WS_V); F.GS = (bf16*)(ws + WS_G); F.QX = (bf16*)(ws + WS_QX);
    F.PA = (bf16*)(ws + WS_PA); F.PB = (bf16*)(ws + WS_PB); F.EA = (float*)(ws + WS_EA); F.EB = (float*)(ws + WS_EB); F.ROWSS = (float*)(ws + WS_ROWSS); F.ROWSS_S = (float*)(ws + WS_ROWSS_S);
    for (int u = F.tid; u < (LDS_BYTES - LDSCTL_OFF) / 4; u += NWAVES * 64) ((LAS unsigned*)(F.lds + LDSCTL_OFF))[u] = 0u;
    __syncthreads();
    const int lo = args.ph_lo, hi = args.ph_hi;
    XcdBarrier bar; bar.bar = (unsigned*)(ctl + CW_BAR); bar.x = 0; bar.st = nullptr;
    if (hi - lo > 1) bar = xcd_barrier_post((unsigned*)(ctl + CW_BAR), MISC + 8);
#define IN(k) (lo <= (k) && (k) < hi)
#if defined(PROBE_A)
    volatile LAS unsigned long long* TSW = (volatile LAS unsigned long long*)(F.lds + LDSCTL_OFF + 512);
    if (blockIdx.x == 0 && F.tid == 0) TSW[0] = __builtin_amdgcn_s_memrealtime();
#define SEAM(k) do { if (IN(k) && IN((k) + 1)) xcd_barrier(bar); if (blockIdx.x == 0 && F.tid == 0) TSW[(k) + 1] = __builtin_amdgcn_s_memrealtime(); } while (0)
#else
#define SEAM(k) do { if (IN(k) && IN((k) + 1)) xcd_barrier(bar); } while (0)
#endif

    if (IN(0)) { p0_prologue(F); p0_late(F, (int)blockIdx.x * NWAVES + F.wave, F.G * NWAVES); } SEAM(0);
    if (IN(1)) {
        { pg8::Gemm g{F.XN, F.WIN, MT, DIN, D}; pg8::StaticOrder S; S.init(MT, DIN, F.G, (int)blockIdx.x);
          pg8::EpiIn E{F.U, F.Q, F.LOGF, F.KK, F.V, F.GS, F.QX, F.lb_logits};
          pg8::gemm_phase<pg8::EpiIn, pg8::StaticOrder, true, true>(F.lds, g, S, E); }
        { pg8::Gemm g{F.XNM, F.WKV, MEMR, 512, D}; pg8::StaticOrder S; S.init(MEMR, 512, F.G, (int)((blockIdx.x + F.G - 168 % F.G) % F.G));
          pg8::EpiKV E{F.o_mk, F.o_mv, F.KVB};
          pg8::gemm_phase<pg8::EpiKV, pg8::StaticOrder, true, true>(F.lds, g, S, E); }
    } SEAM(1);
#if defined(PROBE_A)
#define SUBSTAMP(k) do { if (blockIdx.x == 0 && F.tid == 0) TSW[k] = __builtin_amdgcn_s_memrealtime(); } while (0)
#else
#define SUBSTAMP(k) do { } while (0)
#endif
    if (IN(2)) { pool_phase(F); SUBSTAMP(26); hgrn_passA(F, (f32x4*)(ws + WS_HU), (float*)(ws + WS_HD)); SUBSTAMP(27); hgrn_sample(F); SUBSTAMP(28); xattn_prompt(F); SUBSTAMP(29); xattn_sample(F); SUBSTAMP(30); } SEAM(2);
    if (IN(3)) { hgrn_passC(F, (const f32x4*)(ws + WS_HU), (const float*)(ws + WS_HD)); } SEAM(3);
    if (IN(4)) {
        pg8::Gemm g{F.MIX, F.WOUT, TP, D, D}; pg8::StaticOrder S; S.init(TP, D, F.G, (int)blockIdx.x);
        pg8::EpiOut2 E{F.x_prompt, F.x_sample, TP, F.y, F.XN, F.ROWSS};
        const bool piece_first = ((blockIdx.x >> 3) & 1) != 0;
        if (piece_first) out_sample_piece(F);
        pg8::gemm_phase<pg8::EpiOut2, pg8::StaticOrder, true, true>(F.lds, g, S, E);
#if defined(PROBE_A)
        if (blockIdx.x == 0 && F.tid == 0) TSW[20] = __builtin_amdgcn_s_memrealtime();
        if (F.tid == 0) atomicMax((unsigned long long*)(ws + WS_CTL + 32768 + 128), (unsigned long long)__builtin_amdgcn_s_memrealtime());
#endif
        if (!piece_first) out_sample_piece(F);
#if defined(PROBE_A)
        if (F.tid == 0) atomicMax((unsigned long long*)(ws + WS_CTL + 32768 + 192), (unsigned long long)__builtin_amdgcn_s_memrealtime());
#endif
    } SEAM(4);
    if (IN(5)) {
        pg8::Gemm g{F.XN, F.WUP, MT, 2 * DFF, D}; pg8::StaticOrder S; S.init(MT, 2 * DFF, F.G, (int)blockIdx.x);
        pg8::EpiUpConv E{F.ROWSS, F.ROWSS_S, F.conv_w, F.conv_b, F.state_conv, F.PB, F.EA, F.EB, F.o_conv_p, F.o_conv_s, (LAS float*)(F.lds + RING_BYTES + 4096)};
        pg8::gemm_phase<pg8::EpiUpConv, pg8::StaticOrder, true, true>(F.lds, g, S, E);
    } SEAM(5);
    if (IN(6)) { conv_fixup_phase(F); } SEAM(6);
    if (IN(7)) {
        pg8::Gemm g{F.PB, F.WDN, TP, D, DFF}; pg8::StaticOrder S; S.init(TP, D, F.G, (int)blockIdx.x);
        pg8::EpiResB E{F.XN, F.y};
        const bool piece_first = ((blockIdx.x >> 3) & 1) != 0;
        if (piece_first) down_sample_piece(F);
        pg8::gemm_phase<pg8::EpiResB, pg8::StaticOrder, true, true>(F.lds, g, S, E);
#if defined(PROBE_A)
        if (blockIdx.x == 0 && F.tid == 0) TSW[21] = __builtin_amdgcn_s_memrealtime();
        if (F.tid == 0) atomicMax((unsigned long long*)(ws + WS_CTL + 32768), (unsigned long long)__builtin_amdgcn_s_memrealtime());
#endif
        if (!piece_first) down_sample_piece(F);
#if defined(PROBE_A)
        if (F.tid == 0) atomicMax((unsigned long long*)(ws + WS_CTL + 32768 + 64), (unsigned long long)__builtin_amdgcn_s_memrealtime());
#endif
    } SEAM(7);
    if (IN(8)) { final_norm_phase(F); }
#if defined(PROBE_A)
    __syncthreads();
    if (blockIdx.x == 0 && F.tid == 0) { TSW[NPHASE] = __builtin_amdgcn_s_memrealtime();
        TSW[22] = __hip_atomic_load((unsigned long long*)(ws + WS_CTL + 32768), __ATOMIC_RELAXED, __HIP_MEMORY_SCOPE_AGENT); TSW[23] = __hip_atomic_load((unsigned long long*)(ws + WS_CTL + 32768 + 64), __ATOMIC_RELAXED, __HIP_MEMORY_SCOPE_AGENT); TSW[24] = __hip_atomic_load((unsigned long long*)(ws + WS_CTL + 32768 + 128), __ATOMIC_RELAXED, __HIP_MEMORY_SCOPE_AGENT); TSW[25] = __hip_atomic_load((unsigned long long*)(ws + WS_CTL + 32768 + 192), __ATOMIC_RELAXED, __HIP_MEMORY_SCOPE_AGENT);
        const unsigned long long wait = (TSW[PROBE_B] - TSW[PROBE_A]) * 512ull, t0 = __builtin_amdgcn_s_memrealtime();
        while (__builtin_amdgcn_s_memrealtime() - t0 < wait) __builtin_amdgcn_s_sleep(32); }
#endif
#undef IN
#undef SEAM
}

extern "C" void kernel_launch(void* const* d_in, const int* in_sizes, int n_in, void* d_out, int out_size, void* d_ws, size_t ws_size, hipStream_t stream) {
    static int grid = 0;
    if (grid == 0) {
        if (n_in != 23 || ws_size < WS_END) { fprintf(stderr, "kernel_launch: unexpected n_in %d / ws_size %zu\n", n_in, ws_size); grid = -1; return; }
        int dev = 0, cus = 0, per_cu = 0;
        if (hipGetDevice(&dev) != hipSuccess || hipDeviceGetAttribute(&cus, hipDeviceAttributeMultiprocessorCount, dev) != hipSuccess) { grid = -1; return; }
        if (hipFuncSetAttribute((const void*)mk_fwd, hipFuncAttributeMaxDynamicSharedMemorySize, LDS_BYTES) != hipSuccess) { fprintf(stderr, "kernel_launch: hipFuncSetAttribute failed\n"); grid = -1; return; }
        if (hipOccupancyMaxActiveBlocksPerMultiprocessor(&per_cu, (const void*)mk_fwd, NWAVES * 64, LDS_BYTES) != hipSuccess || per_cu < 1) { fprintf(stderr, "kernel_launch: occupancy query says %d blocks/CU\n", per_cu); }
        (void)hipGetLastError();
        grid = cus;
    }
    if (grid < 0) return;
    (void)hipMemsetAsync((char*)d_ws + WS_CTL, 0, CTL_ZERO_BYTES, stream);
    Args a{};
    for (int i = 0; i < 23; ++i) a.in[i] = (const float*)d_in[i];
    a.out = (float*)d_out; a.ws = (unsigned char*)d_ws;
#if MK_PER_PHASE
    for (int p = 0; p < NPHASE; ++p) { a.ph_lo = p; a.ph_hi = p + 1; hipLaunchKernelGGL(mk_fwd, dim3(grid), dim3(NWAVES * 64), LDS_BYTES, stream, a); }
#else
    a.ph_lo = 0; a.ph_hi = NPHASE;
    hipLaunchKernelGGL(mk_fwd, dim3(grid), dim3(NWAVES * 64), LDS_BYTES, stream, a);
#endif
}
```
